# Optimizing an MI355X kernel written in HIP

```python
import jax, jax.numpy as jnp
from jax import lax
import numpy as np


D_MODEL = 1024
BATCH = 4
SEQ = 8192
DEPTH = 2

CONV_CH = D_MODEL // 2
CONV_K = 3
N_HEADS = 8
HEAD_DIM = 64
ATTN_W = N_HEADS * HEAD_DIM
Q_BLOCK = 128
IN_WIDTH = 3 * CONV_CH + 3 * ATTN_W + 2 * D_MODEL
N_EXPERTS = 16
N_GROUPS = 4
EXPERTS_PER_GROUP = N_EXPERTS // N_GROUPS
TOP_K = 2
EXPERT_FF = 512
MOE_BLOCK = 128
LN_EPS = 1e-5
DN_ALPHA = (2 * DEPTH) ** 0.25
DN_BETA = (8 * DEPTH) ** -0.25

kernel_name = 'hybrid_conv_stickbreak_groupmoe_deepnorm_adaln'


def layer_norm(h, g, b):
    hf = h.astype(jnp.float32)
    mu = jnp.mean(hf, axis=-1, keepdims=True)
    var = jnp.mean(jnp.square(hf - mu), axis=-1, keepdims=True)
    y = (hf - mu) * lax.rsqrt(var + LN_EPS) * g.astype(jnp.float32) + b.astype(jnp.float32)
    return y.astype(h.dtype)


def causal_dwconv(h, w):
    S = h.shape[1]
    hp = jnp.pad(h, ((0, 0), (CONV_K - 1, 0), (0, 0)))
    out = w[CONV_K - 1] * h
    for j in range(CONV_K - 1):
        out = out + w[j] * hp[:, j:j + S]
    return out


def stick_breaking_attention(q, k, v):
    S = q.shape[2]
    scale = HEAD_DIM ** -0.5
    outs = []
    for i in range(S // Q_BLOCK):
        q0 = i * Q_BLOCK
        end = q0 + Q_BLOCK
        qb = q[:, :, q0:end]
        kb = k[:, :, :end]
        vb = v[:, :, :end]
        z = jnp.einsum('bhqd,bhkd->bhqk', qb, kb, preferred_element_type=jnp.float32) * scale
        t_idx = q0 + jnp.arange(Q_BLOCK)[:, None]
        s_idx = jnp.arange(end)[None, :]
        mask = s_idx < t_idx
        log1m = jnp.where(mask, jax.nn.log_sigmoid(-z), 0.0)
        between = lax.cumsum(log1m, axis=3, reverse=True) - log1m
        attn = jnp.where(mask, jnp.exp(jax.nn.log_sigmoid(z) + between), 0.0)
        outs.append(jnp.einsum('bhqk,bhkd->bhqd', attn.astype(vb.dtype), vb))
    return jnp.concatenate(outs, axis=2)


def token_mixer(u, w_in, w_conv, w_a, w_b, w_o):
    Bn, Sn, _ = u.shape
    proj = u @ w_in
    cuts = np.cumsum([CONV_CH, CONV_CH, CONV_CH, ATTN_W, ATTN_W, ATTN_W, D_MODEL])
    cb, cc, cx, q, k, v, ga, gb = jnp.split(proj, cuts, axis=-1)
    y_a = (cb * causal_dwconv(cc * cx, w_conv)) @ w_a
    heads = lambda t: t.reshape(Bn, Sn, N_HEADS, HEAD_DIM).transpose(0, 2, 1, 3)
    o = stick_breaking_attention(heads(q), heads(k), heads(v))
    y_b = o.transpose(0, 2, 1, 3).reshape(Bn, Sn, ATTN_W) @ w_b
    merged = jax.nn.sigmoid(ga) * y_a + jax.nn.sigmoid(gb) * y_b
    return merged @ w_o


def moe_ffn(u, w_router, b_router, w_gate, w_up, w_down):
    Bn, Sn, D = u.shape
    N = Bn * Sn
    xf = u.reshape(N, D)
    aff = jax.nn.sigmoid((xf @ w_router).astype(jnp.float32))
    sel = (aff + b_router.astype(jnp.float32)).reshape(N, N_GROUPS, EXPERTS_PER_GROUP)
    grp_score = lax.top_k(sel, TOP_K)[0].sum(-1)
    g_idx = jnp.argmax(grp_score, axis=-1)
    in_grp = jnp.take_along_axis(sel, g_idx[:, None, None], axis=1)[:, 0]
    _, local = lax.top_k(in_grp, TOP_K)
    e_idx = g_idx[:, None] * EXPERTS_PER_GROUP + local
    gates = jnp.take_along_axis(aff, e_idx, axis=1)
    gates = gates / jnp.sum(gates, axis=-1, keepdims=True)
    A = N * TOP_K
    flat_e = e_idx.reshape(A).astype(jnp.int32)
    flat_tok = jnp.repeat(jnp.arange(N, dtype=jnp.int32), TOP_K)
    flat_w = gates.reshape(A)
    order = jnp.argsort(flat_e)
    s_e = flat_e[order]
    s_tok = flat_tok[order]
    s_w = flat_w[order]
    counts = jnp.bincount(flat_e, length=N_EXPERTS)
    pad_counts = (counts + MOE_BLOCK - 1) // MOE_BLOCK * MOE_BLOCK
    pad_end = jnp.cumsum(pad_counts)
    pad_start = pad_end - pad_counts
    start = jnp.cumsum(counts) - counts
    dest = pad_start[s_e] + (jnp.arange(A, dtype=jnp.int32) - start[s_e])
    n_blocks = -(-A // MOE_BLOCK) + N_EXPERTS
    P = n_blocks * MOE_BLOCK
    row_tok = jnp.full((P,), N, dtype=jnp.int32).at[dest].set(s_tok)
    x_ext = jnp.concatenate([xf, jnp.zeros((1, D), xf.dtype)], axis=0)
    x_blocks = x_ext[row_tok].reshape(n_blocks, MOE_BLOCK, D)
    block_start = jnp.arange(n_blocks, dtype=jnp.int32) * MOE_BLOCK
    block_exp = jnp.clip(jnp.searchsorted(pad_end, block_start, side='right'), 0, N_EXPERTS - 1)

    def expert_block(args):
        xb, e = args
        h = jax.nn.silu(xb @ w_gate[e]) * (xb @ w_up[e])
        return h @ w_down[e]

    y_blocks = lax.map(expert_block, (x_blocks, block_exp))
    y_sorted = y_blocks.reshape(P, D)[dest]
    out = jax.ops.segment_sum(y_sorted.astype(jnp.float32) * s_w[:, None], s_tok, num_segments=N)
    return out.astype(u.dtype).reshape(Bn, Sn, D)


def setup_inputs(seed: int = 0) -> dict:
    key = jax.random.key(seed)
    ks = jax.random.split(key, 20)
    nrm = lambda k, shape: jax.random.normal(k, shape, jnp.float32)
    col_scale = jnp.concatenate([
        jnp.ones((2 * CONV_CH,), jnp.float32), jnp.full((CONV_CH,), DN_BETA, jnp.float32),
        jnp.ones((2 * ATTN_W,), jnp.float32), jnp.full((ATTN_W,), DN_BETA, jnp.float32),
        jnp.ones((2 * D_MODEL,), jnp.float32)])
    return {
        'x': nrm(ks[0], (BATCH, SEQ, D_MODEL)),
        'c': nrm(ks[1], (BATCH, D_MODEL)),
        'w_ada': nrm(ks[2], (DEPTH, D_MODEL, 6 * D_MODEL)) * D_MODEL ** -0.5,
        'b_ada': 0.02 * nrm(ks[3], (DEPTH, 6 * D_MODEL)),
        'w_in': nrm(ks[4], (DEPTH, D_MODEL, IN_WIDTH)) * D_MODEL ** -0.5 * col_scale,
        'w_conv': nrm(ks[5], (DEPTH, CONV_K, CONV_CH)) * CONV_K ** -0.5,
        'w_a': nrm(ks[6], (DEPTH, CONV_CH, D_MODEL)) * CONV_CH ** -0.5,
        'w_b': nrm(ks[7], (DEPTH, ATTN_W, D_MODEL)) * ATTN_W ** -0.5,
        'w_o': nrm(ks[8], (DEPTH, D_MODEL, D_MODEL)) * D_MODEL ** -0.5 * DN_BETA,
        'ln1_g': 1.0 + 0.02 * nrm(ks[9], (DEPTH, D_MODEL)),
        'ln1_b': 0.02 * nrm(ks[10], (DEPTH, D_MODEL)),
        'w_router': nrm(ks[11], (D_MODEL, N_EXPERTS)) * D_MODEL ** -0.5,
        'b_router': 0.01 * nrm(ks[12], (N_EXPERTS,)),
        'w_gate': nrm(ks[13], (DEPTH, N_EXPERTS, D_MODEL, EXPERT_FF)) * D_MODEL ** -0.5,
        'w_up': nrm(ks[14], (DEPTH, N_EXPERTS, D_MODEL, EXPERT_FF)) * D_MODEL ** -0.5,
        'w_down': nrm(ks[15], (DEPTH, N_EXPERTS, EXPERT_FF, D_MODEL)) * EXPERT_FF ** -0.5 * DN_BETA,
        'ln2_g': 1.0 + 0.02 * nrm(ks[16], (DEPTH, D_MODEL)),
        'ln2_b': 0.02 * nrm(ks[17], (DEPTH, D_MODEL)),
    }


def reference(x, c, w_ada, b_ada, w_in, w_conv, w_a, w_b, w_o, ln1_g, ln1_b,
              w_router, b_router, w_gate, w_up, w_down, ln2_g, ln2_b):
    for l in range(DEPTH):
        mod = jax.nn.silu(c) @ w_ada[l] + b_ada[l]
        sh1, sc1, g1, sh2, sc2, g2 = [m[:, None, :] for m in jnp.split(mod, 6, axis=-1)]
        u = x * (1.0 + sc1) + sh1
        mix = token_mixer(u, w_in[l], w_conv[l], w_a[l], w_b[l], w_o[l])
        x = layer_norm(DN_ALPHA * x + g1 * mix, ln1_g[l], ln1_b[l])
        u2 = x * (1.0 + sc2) + sh2
        ffn = moe_ffn(u2, w_router, b_router, w_gate[l], w_up[l], w_down[l])
        x = layer_norm(DN_ALPHA * x + g2 * ffn, ln2_g[l], ln2_b[l])
    return x
```

```cpp
#include <hip/hip_runtime.h>
#include <cstdint>
#include <cstdio>

constexpr int D = 1024, BATCH = 4, SEQ = 8192, NTOK = BATCH * SEQ, DEPTH = 2;
constexpr int CONV_CH = 512, ATTN_W = 512, NH = 8, HD = 64, IN_W = 5120;
constexpr int NE = 16, FF = 512;
constexpr float LN_EPS = 1e-5f;
constexpr float DN_ALPHA = 1.41421356237309515f;

__global__ void k_mod(const float* c, const float* w_ada, const float* b_ada, float* mod) {
    int idx = blockIdx.x * blockDim.x + threadIdx.x;
    if (idx >= DEPTH * BATCH * 6 * D) return;
    int j = idx % (6 * D), b = (idx / (6 * D)) % BATCH, l = idx / (6 * D * BATCH);
    const float* w = w_ada + (size_t)l * D * 6 * D;
    float acc = 0.f;
    for (int k = 0; k < D; ++k) { float cv = c[b * D + k]; float s = cv / (1.f + expf(-cv)); acc += s * w[(size_t)k * 6 * D + j]; }
    mod[idx] = acc + b_ada[l * 6 * D + j];
}

struct ALoadPlain { const float* A; int lda; int M;
    __device__ float4 load4(int row, int k) const { if (row >= M) return make_float4(0, 0, 0, 0); return *(const float4*)(A + (size_t)row * lda + k); } };
struct ALoadMod { const float* x; const float* sc; const float* sh;
    __device__ float4 load4(int row, int k) const { int b = row / SEQ; float4 v = *(const float4*)(x + (size_t)row * D + k);
        float4 s = *(const float4*)(sc + b * 6 * D + k), h = *(const float4*)(sh + b * 6 * D + k);
        return make_float4(v.x * (1.f + s.x) + h.x, v.y * (1.f + s.y) + h.y, v.z * (1.f + s.z) + h.z, v.w * (1.f + s.w) + h.w); } };
struct ALoadGather { const float* A; const int* list; const int* cnt; int lda; int e;
    __device__ float4 load4(int row, int k) const { if (row >= cnt[e]) return make_float4(0, 0, 0, 0); int tok = list[e * NTOK + row] >> 1; return *(const float4*)(A + (size_t)tok * lda + k); } };
struct ALoadSlots { const float* A; const int* offs; const int* cnt; int lda; int e;
    __device__ float4 load4(int row, int k) const { if (row >= cnt[e]) return make_float4(0, 0, 0, 0); return *(const float4*)(A + (size_t)(offs[e] + row) * lda + k); } };

struct EpiStore { float* C; int ldc; int pad; __device__ void operator()(int row, int col, float v) const { C[(size_t)row * ldc + col] = v; } };
struct EpiSigMul { float* Y; int ldc; int pad; __device__ void operator()(int row, int col, float v) const { float s = 1.f / (1.f + expf(-v)); Y[(size_t)row * ldc + col] *= s; } };
struct EpiSigMulAdd { float* Y; const float* Z; int ldc; int pad; __device__ void operator()(int row, int col, float v) const { float s = 1.f / (1.f + expf(-v)); Y[(size_t)row * ldc + col] += s * Z[(size_t)row * ldc + col]; } };
struct EpiH1 { const float* xin; float* xout; const float* g; __device__ void operator()(int row, int col, float v) const { int b = row / SEQ; xout[(size_t)row * D + col] = DN_ALPHA * xin[(size_t)row * D + col] + g[b * 6 * D + col] * v; } };
struct EpiSilu { float* H; const int* offs; const int* cnt; int e; int pad; __device__ void operator()(int row, int col, float v) const { if (row >= cnt[e]) return; H[(size_t)(offs[e] + row) * FF + col] = v / (1.f + expf(-v)); } };
struct EpiMul { float* H; const int* offs; const int* cnt; int e; int pad; __device__ void operator()(int row, int col, float v) const { if (row >= cnt[e]) return; H[(size_t)(offs[e] + row) * FF + col] *= v; } };
struct EpiDown { float* ffn; const int* list; const float* gates; const int* cnt; int e; int pad;
    __device__ void operator()(int row, int col, float v) const { if (row >= cnt[e]) return; int a = list[e * NTOK + row]; atomicAdd(&ffn[(size_t)(a >> 1) * D + col], v * gates[a]); } };

template <class AL, class EP>
__global__ void __launch_bounds__(256) k_gemm(const float* B, const int* cnt, AL al, EP ep, int Mrows, int N, int K, int ldb, int e, int pad) {
    __shared__ float As[8][132];
    __shared__ float Bs[8][132];
    const int t = threadIdx.x, m0 = blockIdx.y * 128, n0 = blockIdx.x * 128;
    if (cnt && m0 >= cnt[e]) return;
    if (m0 >= Mrows) return;
    const int ty = t / 16, tx = t % 16;
    float acc[8][8];
#pragma unroll
    for (int i = 0; i < 8; ++i)
#pragma unroll
        for (int j = 0; j < 8; ++j) acc[i][j] = 0.f;
    const int ar = t / 2, ak = (t % 2) * 4;
    const int bk = t / 32, bc = (t % 32) * 4;
    for (int k0 = 0; k0 < K; k0 += 8) {
        float4 av = al.load4(m0 + ar, k0 + ak);
        float4 bv = *(const float4*)(B + (size_t)(k0 + bk) * ldb + n0 + bc);
        As[ak + 0][ar] = av.x; As[ak + 1][ar] = av.y; As[ak + 2][ar] = av.z; As[ak + 3][ar] = av.w;
        *(float4*)&Bs[bk][bc] = bv;
        __syncthreads();
#pragma unroll
        for (int kk = 0; kk < 8; ++kk) {
            float a[8], b[8];
            float4 a0 = *(const float4*)&As[kk][ty * 4], a1 = *(const float4*)&As[kk][64 + ty * 4];
            float4 b0 = *(const float4*)&Bs[kk][tx * 4], b1 = *(const float4*)&Bs[kk][64 + tx * 4];
            a[0] = a0.x; a[1] = a0.y; a[2] = a0.z; a[3] = a0.w; a[4] = a1.x; a[5] = a1.y; a[6] = a1.z; a[7] = a1.w;
            b[0] = b0.x; b[1] = b0.y; b[2] = b0.z; b[3] = b0.w; b[4] = b1.x; b[5] = b1.y; b[6] = b1.z; b[7] = b1.w;
#pragma unroll
            for (int i = 0; i < 8; ++i)
#pragma unroll
                for (int j = 0; j < 8; ++j) acc[i][j] += a[i] * b[j];
        }
        __syncthreads();
    }
#pragma unroll
    for (int i = 0; i < 8; ++i)
#pragma unroll
        for (int j = 0; j < 8; ++j) {
            int row = m0 + (i < 4 ? ty * 4 + i : 64 + ty * 4 + i - 4), col = n0 + (j < 4 ? tx * 4 + j : 64 + tx * 4 + j - 4);
            if (row < Mrows) ep(row, col, acc[i][j]);
        }
}
template <class AL, class EP>
static void gemm(hipStream_t s, int M, int N, int K, const float* B, int ldb, AL al, EP ep) {
    k_gemm<AL, EP><<<dim3(N / 128, M / 128, 1), 256, 0, s>>>(B, nullptr, al, ep, M, N, K, ldb, 0, 0);
}

__global__ void k_conv(const float* cbccx  , const float* wc  , float* a_in  ) {
    size_t idx = (size_t)blockIdx.x * blockDim.x + threadIdx.x;
    if (idx >= (size_t)NTOK * CONV_CH) return;
    int ch = idx % CONV_CH; int row = idx / CONV_CH; int t = row % SEQ;
    const float* r0 = cbccx + (size_t)row * 1536;
    float p0 = r0[512 + ch] * r0[1024 + ch];
    float p1 = 0.f, p2 = 0.f;
    if (t >= 1) { const float* r1 = r0 - 1536; p1 = r1[512 + ch] * r1[1024 + ch]; }
    if (t >= 2) { const float* r2 = r0 - 2 * 1536; p2 = r2[512 + ch] * r2[1024 + ch]; }
    float cv = wc[2 * 512 + ch] * p0 + wc[1 * 512 + ch] * p1 + wc[0 * 512 + ch] * p2;
    a_in[idx] = r0[ch] * cv;
}

__global__ void __launch_bounds__(64) k_attn(const float* qkv  , float* o  ) {
    const int lane = threadIdx.x; const int qblk = blockIdx.x; const int bh = blockIdx.y; const int b = bh / NH, h = bh % NH;
    const int t0 = qblk * 64, t = t0 + lane;
    const float* base = qkv + (size_t)b * SEQ * 1536;
    float q[HD], acc[HD];
#pragma unroll
    for (int d = 0; d < HD; ++d) { q[d] = base[(size_t)t * 1536 + h * HD + d] * 0.125f; acc[d] = 0.f; }
    float run = 0.f;
    for (int s = t0 + 62; s >= 0; --s) {
        const float* kp = base + (size_t)s * 1536 + 512 + h * HD;
        const float* vp = base + (size_t)s * 1536 + 1024 + h * HD;
        float z = 0.f;
#pragma unroll
        for (int d = 0; d < HD; ++d) z += q[d] * kp[d];
        if (s < t) {
            float sp = fmaxf(z, 0.f) + log1pf(expf(-fabsf(z)));
            float a = expf(z - sp + run);
            run -= sp;
#pragma unroll
            for (int d = 0; d < HD; ++d) acc[d] += a * vp[d];
        }
    }
#pragma unroll
    for (int d = 0; d < HD; ++d) o[(size_t)(b * SEQ + t) * ATTN_W + h * HD + d] = acc[d];
}

__device__ __forceinline__ float wave_sum(float v) {
#pragma unroll
    for (int o = 1; o < 64; o <<= 1) v += __shfl_xor(v, o);
    return v;
}
__global__ void __launch_bounds__(256) k_ln1(float* X, const float* g, const float* bta, const float* sc2, const float* sh2, float* u2,
                                             const float* w_router, const float* b_router, int* list, int* cnt, float* gates) {
    const int lane = threadIdx.x & 63, wave = threadIdx.x >> 6;
    const int row = blockIdx.x * 4 + wave; if (row >= NTOK) return;
    const int b = row / SEQ;
    float v[16]; float s = 0.f;
#pragma unroll
    for (int j = 0; j < 4; ++j) { float4 t4 = *(const float4*)(X + (size_t)row * D + j * 256 + lane * 4); v[j * 4] = t4.x; v[j * 4 + 1] = t4.y; v[j * 4 + 2] = t4.z; v[j * 4 + 3] = t4.w; s += t4.x + t4.y + t4.z + t4.w; }
    const float mu = wave_sum(s) * (1.f / D); float s2 = 0.f;
#pragma unroll
    for (int i = 0; i < 16; ++i) { v[i] -= mu; s2 += v[i] * v[i]; }
    const float rstd = rsqrtf(wave_sum(s2) * (1.f / D) + LN_EPS);
    float logit[NE];
#pragma unroll
    for (int e = 0; e < NE; ++e) logit[e] = 0.f;
#pragma unroll
    for (int j = 0; j < 4; ++j) {
        float xo[4], uo[4];
#pragma unroll
        for (int i = 0; i < 4; ++i) { int col = j * 256 + lane * 4 + i; xo[i] = v[j * 4 + i] * rstd * g[col] + bta[col]; uo[i] = xo[i] * (1.f + sc2[b * 6 * D + col]) + sh2[b * 6 * D + col];
#pragma unroll
            for (int e = 0; e < NE; ++e) logit[e] += uo[i] * w_router[col * NE + e]; }
        *(float4*)(X + (size_t)row * D + j * 256 + lane * 4) = make_float4(xo[0], xo[1], xo[2], xo[3]);
        *(float4*)(u2 + (size_t)row * D + j * 256 + lane * 4) = make_float4(uo[0], uo[1], uo[2], uo[3]);
    }
#pragma unroll
    for (int e = 0; e < NE; ++e) logit[e] = wave_sum(logit[e]);
    if (lane == 0) {
        float aff[NE], sel[NE];
#pragma unroll
        for (int e = 0; e < NE; ++e) { aff[e] = 1.f / (1.f + expf(-logit[e])); sel[e] = aff[e] + b_router[e]; }
        int gbest = 0; float gs_best = -1e30f;
#pragma unroll
        for (int gi = 0; gi < 4; ++gi) {
            float m1 = -1e30f, m2 = -1e30f;
#pragma unroll
            for (int i = 0; i < 4; ++i) { float x = sel[gi * 4 + i]; if (x > m1) { m2 = m1; m1 = x; } else if (x > m2) m2 = x; }
            float gsc = m1 + m2; if (gsc > gs_best) { gs_best = gsc; gbest = gi; }
        }
        int i1 = 0; float v1 = -1e30f;
#pragma unroll
        for (int i = 0; i < 4; ++i) { float x = sel[gbest * 4 + i]; if (x > v1) { v1 = x; i1 = i; } }
        int i2 = 0; float v2 = -1e30f;
#pragma unroll
        for (int i = 0; i < 4; ++i) { float x = sel[gbest * 4 + i]; if (i != i1 && x > v2) { v2 = x; i2 = i; } }
        const int e1 = gbest * 4 + i1, e2 = gbest * 4 + i2;
        float a1 = 0.f, a2 = 0.f;
#pragma unroll
        for (int e = 0; e < NE; ++e) { if (e == e1) a1 = aff[e]; if (e == e2) a2 = aff[e]; }
        const float inv = 1.f / (a1 + a2);
        gates[row * 2] = a1 * inv; gates[row * 2 + 1] = a2 * inv;
        int p1 = atomicAdd(&cnt[e1], 1); list[e1 * NTOK + p1] = row * 2;
        int p2 = atomicAdd(&cnt[e2], 1); list[e2 * NTOK + p2] = row * 2 + 1;
    }
}
__global__ void k_offs(const int* cnt, int* offs) { if (threadIdx.x == 0) { int a = 0; for (int e = 0; e < NE; ++e) { offs[e] = a; a += cnt[e]; } } }
__global__ void __launch_bounds__(256) k_ln2(float* X, const float* ffn, const float* g2, const float* g, const float* bta) {
    const int lane = threadIdx.x & 63, wave = threadIdx.x >> 6;
    const int row = blockIdx.x * 4 + wave; if (row >= NTOK) return;
    const int b = row / SEQ;
    float v[16]; float s = 0.f;
#pragma unroll
    for (int j = 0; j < 4; ++j) {
        float4 t4 = *(const float4*)(X + (size_t)row * D + j * 256 + lane * 4), f4 = *(const float4*)(ffn + (size_t)row * D + j * 256 + lane * 4), g4 = *(const float4*)(g2 + b * 6 * D + j * 256 + lane * 4);
        v[j * 4] = DN_ALPHA * t4.x + g4.x * f4.x; v[j * 4 + 1] = DN_ALPHA * t4.y + g4.y * f4.y; v[j * 4 + 2] = DN_ALPHA * t4.z + g4.z * f4.z; v[j * 4 + 3] = DN_ALPHA * t4.w + g4.w * f4.w;
        s += v[j * 4] + v[j * 4 + 1] + v[j * 4 + 2] + v[j * 4 + 3]; }
    const float mu = wave_sum(s) * (1.f / D); float s2 = 0.f;
#pragma unroll
    for (int i = 0; i < 16; ++i) { v[i] -= mu; s2 += v[i] * v[i]; }
    const float rstd = rsqrtf(wave_sum(s2) * (1.f / D) + LN_EPS);
#pragma unroll
    for (int j = 0; j < 4; ++j) { float o[4];
#pragma unroll
        for (int i = 0; i < 4; ++i) { int col = j * 256 + lane * 4 + i; o[i] = v[j * 4 + i] * rstd * g[col] + bta[col]; }
        *(float4*)(X + (size_t)row * D + j * 256 + lane * 4) = make_float4(o[0], o[1], o[2], o[3]); }
}

extern "C" void kernel_launch(void* const* d_in, const int* in_sizes, int n_in, void* d_out, int out_size, void* d_ws, size_t ws_size, hipStream_t stream) {
    const float* x = (const float*)d_in[0]; const float* c = (const float*)d_in[1]; const float* w_ada = (const float*)d_in[2]; const float* b_ada = (const float*)d_in[3];
    const float* w_in = (const float*)d_in[4]; const float* w_conv = (const float*)d_in[5]; const float* w_a = (const float*)d_in[6]; const float* w_b = (const float*)d_in[7];
    const float* w_o = (const float*)d_in[8]; const float* ln1_g = (const float*)d_in[9]; const float* ln1_b = (const float*)d_in[10]; const float* w_router = (const float*)d_in[11];
    const float* b_router = (const float*)d_in[12]; const float* w_gate = (const float*)d_in[13]; const float* w_up = (const float*)d_in[14]; const float* w_down = (const float*)d_in[15];
    const float* ln2_g = (const float*)d_in[16]; const float* ln2_b = (const float*)d_in[17];
    float* X = (float*)d_out;
    char* ws = (char*)d_ws; const size_t MiB = 1u << 20;
    float* bufA = (float*)(ws + 0 * MiB);
    float* a_in = (float*)(ws + 192 * MiB);
    float* o    = (float*)(ws + 256 * MiB);
    float* Y    = (float*)(ws + 320 * MiB);
    float* mod  = (float*)(ws + 448 * MiB);
    int* list   = (int*)(ws + 449 * MiB);
    int* cnt    = (int*)(ws + 452 * MiB);
    int* offs   = cnt + 64;
    float* gates = (float*)(ws + 453 * MiB);
    float* Z = bufA; float* u2 = bufA; float* ffn = a_in; float* H = Y;
    if (ws_size < 460 * MiB) { fprintf(stderr, "ws too small\n"); return; }

    k_mod<<<(DEPTH * BATCH * 6 * D + 255) / 256, 256, 0, stream>>>(c, w_ada, b_ada, mod);
    for (int l = 0; l < DEPTH; ++l) {
        const float* xin = (l == 0) ? x : X;
        const float* m = mod + (size_t)l * BATCH * 6 * D;
        const float* wi = w_in + (size_t)l * D * IN_W;
        ALoadMod alm{xin, m + D, m};
        gemm(stream, NTOK, 1536, D, wi, IN_W, alm, EpiStore{bufA, 1536, 0});
        k_conv<<<(NTOK * CONV_CH + 255) / 256, 256, 0, stream>>>(bufA, w_conv + (size_t)l * 3 * 512, a_in);
        gemm(stream, NTOK, 1536, D, wi + 1536, IN_W, alm, EpiStore{bufA, 1536, 0});
        k_attn<<<dim3(SEQ / 64, BATCH * NH), 64, 0, stream>>>(bufA, o);
        gemm(stream, NTOK, D, CONV_CH, w_a + (size_t)l * CONV_CH * D, D, ALoadPlain{a_in, CONV_CH, NTOK}, EpiStore{Y, D, 0});
        gemm(stream, NTOK, D, ATTN_W, w_b + (size_t)l * ATTN_W * D, D, ALoadPlain{o, ATTN_W, NTOK}, EpiStore{Z, D, 0});
        gemm(stream, NTOK, D, D, wi + 3072, IN_W, alm, EpiSigMul{Y, D, 0});
        gemm(stream, NTOK, D, D, wi + 4096, IN_W, alm, EpiSigMulAdd{Y, Z, D, 0});
        gemm(stream, NTOK, D, D, w_o + (size_t)l * D * D, D, ALoadPlain{Y, D, NTOK}, EpiH1{xin, X, m + 2 * D});
        (void)hipMemsetAsync(cnt, 0, 64 * sizeof(int), stream);
        k_ln1<<<NTOK / 4, 256, 0, stream>>>(X, ln1_g + l * D, ln1_b + l * D, m + 4 * D, m + 3 * D, u2, w_router, b_router, list, cnt, gates);
        k_offs<<<1, 64, 0, stream>>>(cnt, offs);
        (void)hipMemsetAsync(ffn, 0, (size_t)NTOK * D * sizeof(float), stream);
        for (int e = 0; e < NE; ++e) {
            const float* wg = w_gate + ((size_t)l * NE + e) * D * FF; const float* wu = w_up + ((size_t)l * NE + e) * D * FF; const float* wd = w_down + ((size_t)l * NE + e) * FF * D;
            ALoadGather alg{u2, list, cnt, D, e};
            k_gemm<ALoadGather, EpiSilu><<<dim3(FF / 128, NTOK / 128, 1), 256, 0, stream>>>(wg, cnt, alg, EpiSilu{H, offs, cnt, e, 0}, NTOK, FF, D, FF, e, 0);
            k_gemm<ALoadGather, EpiMul><<<dim3(FF / 128, NTOK / 128, 1), 256, 0, stream>>>(wu, cnt, alg, EpiMul{H, offs, cnt, e, 0}, NTOK, FF, D, FF, e, 0);
            k_gemm<ALoadSlots, EpiDown><<<dim3(D / 128, NTOK / 128, 1), 256, 0, stream>>>(wd, cnt, ALoadSlots{H, offs, cnt, FF, e}, EpiDown{ffn, list, gates, cnt, e, 0}, NTOK, D, FF, D, e, 0);
        }
        k_ln2<<<NTOK / 4, 256, 0, stream>>>(X, ffn, m + 5 * D, ln2_g + l * D, ln2_b + l * D);
    }
}
```

```cpp
#include <hip/hip_runtime.h>
#include <hip/hip_bf16.h>
#include <cstdio>
#include <cstdint>

constexpr int DM = 1024, BATCH = 4, SEQ = 8192, M_TOK = BATCH * SEQ, DEPTH = 2;
constexpr int CONV_CH = 512, ATT_W = 512, NHEAD = 8, HDIM = 64, IN_W = 5120;
constexpr int NEXP = 16, FFD = 512;
constexpr int PMAX = 2 * M_TOK + NEXP * 256;
constexpr int NTILE_MAX = PMAX / 256;
constexpr float LN_EPS = 1e-5f;
constexpr float DN_ALPHA = 1.41421356237309515f;
constexpr float LOG2E = 1.4426950408889634f;
constexpr float QSCALE = 0.125f * LOG2E;
constexpr int NWAVES = 8, NTHREADS = 512;

namespace pg8 {
#define PG8_LAS __attribute__((address_space(3)))
typedef unsigned short bf16_t;
typedef short bf16x8 __attribute__((ext_vector_type(8)));
typedef float f32x4 __attribute__((ext_vector_type(4)));
typedef unsigned u32x4 __attribute__((ext_vector_type(4)));
typedef unsigned u32x2 __attribute__((ext_vector_type(2)));
constexpr int BM = 256, BK = 64, HALF = 128, HTB = HALF * BK * 2  , STAGE_BYTES = 8 * HTB, NXCD = 8, WGM = 8;

__host__ __device__ __forceinline__ int lds_byte(int r, int c) { const int st = (r >> 4) * 2 + (c >> 5), rr = r & 15, cc = c & 31, ob = rr * 64 + cc * 2; return st * 1024 + (ob ^ (((ob >> 9) & 1) << 5)); }
__host__ __device__ __forceinline__ void stage_rc(int b, int& R, int& C) { const int st = b / 1024, sb = b % 1024, swz = sb ^ (((sb >> 9) & 1) << 5); R = (st >> 1) * 16 + swz / 64; C = (st & 1) * 32 + (swz % 64) / 2; }
__host__ __device__ __forceinline__ int perm32(int rho) { const int n = rho >> 4, i = rho & 15; return 8 * (i >> 2) + 4 * n + (i & 3); }

struct Unit { int pm, pn, pe; };
struct Gemm { const bf16_t* A; const bf16_t* Bt; int M, N, K; size_t estride; };

__host__ __device__ __forceinline__ int xcd_remap(int wgid, int nwg) { const int q = nwg / NXCD, r = nwg % NXCD, xcd = wgid % NXCD, off = wgid / NXCD; return (xcd < r ? xcd * (q + 1) : r * (q + 1) + (xcd - r) * q) + off; }

struct StaticOrder {
    int nM, nN, nwg, G, c;
    __host__ __device__ void init(int M, int N, int G_, int c_) { nM = M / BM; nN = N / BM; nwg = nM * nN; G = G_; c = c_; }
    __host__ __device__ bool next(int i, Unit& u) const {
        const long L = (long)i * G + c; if (L >= nwg) return false;
        const int wgid = xcd_remap((int)L, nwg);
        const int nig = WGM * nN, gid = wgid / nig, fm = gid * WGM, gsz = (nM - fm) < WGM ? (nM - fm) : WGM;
        u.pm = fm + ((wgid % nig) % gsz); u.pn = (wgid % nig) / gsz; u.pe = 0; return true;
    }
    __device__ __forceinline__ void a_ready(const Unit&) const {}
    __device__ __forceinline__ void done(const Unit&) const {}
};
struct GroupedOrder {
    const PG8_LAS int* tab;
    __device__ __forceinline__ bool next(int i, Unit& u) const {
        const int n = __builtin_amdgcn_readfirstlane(tab[0]); if (i >= n) return false;
        u.pm = __builtin_amdgcn_readfirstlane(tab[1 + 3 * i]); u.pn = __builtin_amdgcn_readfirstlane(tab[2 + 3 * i]); u.pe = __builtin_amdgcn_readfirstlane(tab[3 + 3 * i]); return true;
    }
    __device__ __forceinline__ void a_ready(const Unit&) const {}
    __device__ __forceinline__ void done(const Unit&) const {}
};

__device__ __forceinline__ unsigned cvt_pk_bf16(float lo, float hi) { unsigned r; asm volatile("v_cvt_pk_bf16_f32 %0, %1, %2" : "=v"(r) : "v"(lo), "v"(hi)); return r; }
__device__ __forceinline__ float bf_lo(unsigned w) { return __uint_as_float(w << 16); }
__device__ __forceinline__ float bf_hi(unsigned w) { return __uint_as_float(w & 0xffff0000u); }
__device__ __forceinline__ float sigmoidf_fast(float x) { return __builtin_amdgcn_rcpf(1.0f + __builtin_amdgcn_exp2f(-LOG2E * x)); }


struct EpiProj {
    static constexpr bool PERM = true, AFTER_DRAIN = false;
    bf16_t* proj;
    __device__ __forceinline__ void operator()(const f32x4 (&acc)[2][2][4][2], const Unit& u, int wr, int wc, int fr, int fq) const {
        const int row0 = u.pm * BM + wr * 64 + fr; const int pn = u.pn;
        bf16_t* base; int ldc, colt;
        if (pn < 12) { base = proj + (size_t)(pn >> 1) * ((size_t)M_TOK * 512); ldc = 512; colt = (pn & 1) * 256; }
        else { base = proj + (size_t)6 * M_TOK * 512 + (size_t)((pn - 12) >> 2) * ((size_t)M_TOK * 1024); ldc = 1024; colt = ((pn - 12) & 3) * 256; }
        const int col0 = colt + wc * 32 + 8 * fq;
#pragma unroll
        for (int ai = 0; ai < 2; ++ai)
#pragma unroll
            for (int m = 0; m < 4; ++m) { bf16_t* rowp = base + (size_t)(row0 + ai * HALF + m * 16) * ldc + col0;
#pragma unroll
                for (int bj = 0; bj < 2; ++bj) { const f32x4 v0 = acc[ai][bj][m][0], v1 = acc[ai][bj][m][1];
                    u32x4 w; w.x = cvt_pk_bf16(v0[0], v0[1]); w.y = cvt_pk_bf16(v0[2], v0[3]); w.z = cvt_pk_bf16(v1[0], v1[1]); w.w = cvt_pk_bf16(v1[2], v1[3]);
                    *(u32x4*)(rowp + bj * HALF) = w; } }
    }
};
template <bool ADD> struct EpiGate {
    static constexpr bool PERM = true, AFTER_DRAIN = false;
    const bf16_t* gate; bf16_t* out;
    __device__ __forceinline__ void operator()(const f32x4 (&acc)[2][2][4][2], const Unit& u, int wr, int wc, int fr, int fq) const {
        const int row0 = u.pm * BM + wr * 64 + fr, col0 = u.pn * BM + wc * 32 + 8 * fq;
#pragma unroll
        for (int ai = 0; ai < 2; ++ai)
#pragma unroll
            for (int m = 0; m < 4; ++m) {
#pragma unroll
                for (int bj = 0; bj < 2; ++bj) { const size_t off = (size_t)(row0 + ai * HALF + m * 16) * 1024 + col0 + bj * HALF;
                    const u32x4 g = *(const u32x4*)(gate + off); const f32x4 v0 = acc[ai][bj][m][0], v1 = acc[ai][bj][m][1];
                    float r[8];
                    r[0] = sigmoidf_fast(bf_lo(g.x)) * v0[0]; r[1] = sigmoidf_fast(bf_hi(g.x)) * v0[1]; r[2] = sigmoidf_fast(bf_lo(g.y)) * v0[2]; r[3] = sigmoidf_fast(bf_hi(g.y)) * v0[3];
                    r[4] = sigmoidf_fast(bf_lo(g.z)) * v1[0]; r[5] = sigmoidf_fast(bf_hi(g.z)) * v1[1]; r[6] = sigmoidf_fast(bf_lo(g.w)) * v1[2]; r[7] = sigmoidf_fast(bf_hi(g.w)) * v1[3];
                    if (ADD) { const u32x4 p = *(const u32x4*)(out + off);
                        r[0] += bf_lo(p.x); r[1] += bf_hi(p.x); r[2] += bf_lo(p.y); r[3] += bf_hi(p.y); r[4] += bf_lo(p.z); r[5] += bf_hi(p.z); r[6] += bf_lo(p.w); r[7] += bf_hi(p.w); }
                    u32x4 w; w.x = cvt_pk_bf16(r[0], r[1]); w.y = cvt_pk_bf16(r[2], r[3]); w.z = cvt_pk_bf16(r[4], r[5]); w.w = cvt_pk_bf16(r[6], r[7]);
                    *(u32x4*)(out + off) = w; } }
    }
};
struct EpiH1 {
    static constexpr bool PERM = false, AFTER_DRAIN = false;
    const float* xin; float* X; const float* g1;
    __device__ __forceinline__ void operator()(const f32x4 (&acc)[2][2][4][2], const Unit& u, int wr, int wc, int fr, int fq) const {
        const int row0 = u.pm * BM + wr * 64 + fr, col0 = u.pn * BM + wc * 32 + 4 * fq; const int b = (u.pm * BM) / SEQ;
        f32x4 gv[2][2];
#pragma unroll
        for (int bj = 0; bj < 2; ++bj)
#pragma unroll
            for (int n = 0; n < 2; ++n) gv[bj][n] = *(const f32x4*)(g1 + (size_t)b * 6 * DM + col0 + bj * HALF + n * 16);
#pragma unroll
        for (int ai = 0; ai < 2; ++ai)
#pragma unroll
            for (int m = 0; m < 4; ++m) { const size_t off = (size_t)(row0 + ai * HALF + m * 16) * DM + col0;
#pragma unroll
                for (int bj = 0; bj < 2; ++bj)
#pragma unroll
                    for (int n = 0; n < 2; ++n) { const f32x4 xv = *(const f32x4*)(xin + off + bj * HALF + n * 16);
                        *(f32x4*)(X + off + bj * HALF + n * 16) = xv * DN_ALPHA + gv[bj][n] * acc[ai][bj][m][n]; }
                if (m & 1) asm volatile("" ::: "memory"); }
    }
};
struct EpiGU {
    static constexpr bool PERM = true, AFTER_DRAIN = false;
    bf16_t* H;
    __device__ __forceinline__ void operator()(const f32x4 (&acc)[2][2][4][2], const Unit& u, int wr, int wc, int fr, int fq) const {
        const int row0 = u.pm * BM + wr * 64 + fr, hcol0 = u.pn * 128 + wc * 16 + 4 * fq;
#pragma unroll
        for (int ai = 0; ai < 2; ++ai)
#pragma unroll
            for (int m = 0; m < 4; ++m) { bf16_t* rowp = H + (size_t)(row0 + ai * HALF + m * 16) * FFD + hcol0;
#pragma unroll
                for (int bj = 0; bj < 2; ++bj) { const f32x4 v0 = acc[ai][bj][m][0], v1 = acc[ai][bj][m][1];
                    const float h0 = v0[0] * sigmoidf_fast(v0[0]) * v0[1], h1 = v0[2] * sigmoidf_fast(v0[2]) * v0[3], h2 = v1[0] * sigmoidf_fast(v1[0]) * v1[1], h3 = v1[2] * sigmoidf_fast(v1[2]) * v1[3];
                    u32x2 w; w.x = cvt_pk_bf16(h0, h1); w.y = cvt_pk_bf16(h2, h3);
                    *(u32x2*)(rowp + bj * 64) = w; } }
    }
};
struct EpiDown {
    static constexpr bool PERM = true, AFTER_DRAIN = false;
    bf16_t* Y; const float* gw;
    __device__ __forceinline__ void operator()(const f32x4 (&acc)[2][2][4][2], const Unit& u, int wr, int wc, int fr, int fq) const {
        const int row0 = u.pm * BM + wr * 64 + fr, col0 = u.pn * BM + wc * 32 + 8 * fq;
#pragma unroll
        for (int ai = 0; ai < 2; ++ai)
#pragma unroll
            for (int m = 0; m < 4; ++m) { const int row = row0 + ai * HALF + m * 16; const float s = gw[row]; bf16_t* rowp = Y + (size_t)row * DM + col0;
#pragma unroll
                for (int bj = 0; bj < 2; ++bj) { const f32x4 v0 = acc[ai][bj][m][0] * s, v1 = acc[ai][bj][m][1] * s;
                    u32x4 w; w.x = cvt_pk_bf16(v0[0], v0[1]); w.y = cvt_pk_bf16(v0[2], v0[3]); w.z = cvt_pk_bf16(v1[0], v1[1]); w.w = cvt_pk_bf16(v1[2], v1[3]);
                    *(u32x4*)(rowp + bj * HALF) = w; } }
    }
};

template <class Epi, class Sched, bool ALIGN_EPI = false, bool SP2 = false>
__device__ __forceinline__ void gemm_phase(PG8_LAS unsigned char* lds, const Gemm g, const Sched& S, const Epi& E) {
    int tid_ = threadIdx.x; asm volatile("" : "+v"(tid_)); const int tid = tid_, wid = __builtin_amdgcn_readfirstlane(tid >> 6), lane = tid & 63, wr = wid >> 2, wc = wid & 3, fr = lane & 15, fq = lane >> 4;
    const int K = g.K, nt = K / BK;
    unsigned voffA[2], voffB[2];
#pragma unroll
    for (int i = 0; i < 2; ++i) { int R, C; stage_rc(tid * 16 + i * 8192, R, C); const int Rb = Epi::PERM ? ((R & ~31) + perm32(R & 31)) : R;
        voffA[i] = (unsigned)(R * K + C) * 2u; voffB[i] = (unsigned)(Rb * K + C) * 2u; }
    const size_t kstep = (size_t)(BK * 2);
    const size_t hstep = (size_t)HALF * K * 2;
    const size_t tstep = 2 * hstep;
    const unsigned ldsw = (unsigned)wid * 1024u;
    const int aoff = lds_byte(wr * 64 + fr, fq * 8), boff = lds_byte(wc * 32 + fr, fq * 8);
#define PG8_SA(b, h) (((b) * 2 + (h)) * HTB)
#define PG8_SB(b, h) ((4 + (b) * 2 + (h)) * HTB)
#define PG8_STAGE(bufoff, gbase, voff) do { _Pragma("unroll") for (int _i = 0; _i < 2; ++_i) \
        __builtin_amdgcn_global_load_lds((const unsigned*)((const char*)(gbase) + (voff)[_i]), (PG8_LAS unsigned*)(lds + (bufoff) + ldsw + _i * 8192), 16, 0, 0); } while (0)
#define PG8_LDA(dst, b, h) do { _Pragma("unroll") for (int m = 0; m < 4; ++m) _Pragma("unroll") for (int k = 0; k < 2; ++k) dst[m][k] = *(const PG8_LAS bf16x8*)(lds + PG8_SA(b, h) + aoff + m * 2048 + k * 1024); } while (0)
#define PG8_LDB(dst, b, h) do { _Pragma("unroll") for (int n = 0; n < 2; ++n) _Pragma("unroll") for (int k = 0; k < 2; ++k) dst[n][k] = *(const PG8_LAS bf16x8*)(lds + PG8_SB(b, h) + boff + n * 2048 + k * 1024); } while (0)
#define PG8_MMA(ai, bj, At, Bt) do { __builtin_amdgcn_s_setprio(1); _Pragma("unroll") for (int m = 0; m < 4; ++m) _Pragma("unroll") for (int n = 0; n < 2; ++n) _Pragma("unroll") for (int k = 0; k < 2; ++k) \
        acc[ai][bj][m][n] = __builtin_amdgcn_mfma_f32_16x16x32_bf16(Bt[n][k], At[m][k], acc[ai][bj][m][n], 0, 0, 0); __builtin_amdgcn_s_setprio(0); } while (0)
#define PG8_WAIT_V(n) asm volatile("s_waitcnt vmcnt(" #n ")" ::: "memory")
#define PG8_WAIT_L(n) asm volatile("s_waitcnt lgkmcnt(" #n ")" ::: "memory")
#define PG8_BAR __builtin_amdgcn_s_barrier()
#define PG8_SCHED __builtin_amdgcn_sched_barrier(0)
    Unit cur, nxt; int ui = 0;
    if (!S.next(0, cur)) return;
    f32x4 acc[2][2][4][2];
#pragma unroll
    for (int a = 0; a < 2; ++a)
#pragma unroll
        for (int b = 0; b < 2; ++b)
#pragma unroll
            for (int m = 0; m < 4; ++m)
#pragma unroll
                for (int n = 0; n < 2; ++n) acc[a][b][m][n] = (f32x4){0.f, 0.f, 0.f, 0.f};
    bf16x8 At[4][2], B0[2][2], B1[2][2];
    const char* cA = (const char*)g.A + (size_t)cur.pm * tstep; const char* cB = (const char*)g.Bt + (size_t)cur.pe * g.estride + (size_t)cur.pn * tstep;
    S.a_ready(cur);
    if constexpr (SP2) {
        PG8_STAGE(PG8_SB(0, 0), cB, voffB); PG8_STAGE(PG8_SB(0, 1), cB + hstep, voffB); PG8_STAGE(PG8_SA(0, 0), cA, voffA); PG8_STAGE(PG8_SA(0, 1), cA + hstep, voffA);
        if (wr == 1) PG8_BAR;
        PG8_WAIT_V(2); PG8_BAR;
        PG8_STAGE(PG8_SB(1, 0), cB + kstep, voffB); PG8_STAGE(PG8_SA(1, 0), cA + kstep, voffA); PG8_STAGE(PG8_SB(1, 1), cB + hstep + kstep, voffB);
        PG8_WAIT_V(6); PG8_BAR;
    } else {
        PG8_STAGE(PG8_SB(0, 0), cB, voffB); PG8_STAGE(PG8_SA(0, 0), cA, voffA); PG8_STAGE(PG8_SB(0, 1), cB + hstep, voffB); PG8_STAGE(PG8_SA(0, 1), cA + hstep, voffA);
        if (wr == 1) PG8_BAR;
        PG8_WAIT_V(4); PG8_BAR;
        PG8_STAGE(PG8_SB(1, 0), cB + kstep, voffB); PG8_STAGE(PG8_SA(1, 0), cA + kstep, voffA); PG8_STAGE(PG8_SB(1, 1), cB + hstep + kstep, voffB);
        PG8_WAIT_V(6); PG8_BAR;
    }
    for (;;) {
        const bool has_next = S.next(ui + 1, nxt);
        const char* nA = has_next ? (const char*)g.A + (size_t)nxt.pm * tstep : cA; const char* nB = has_next ? (const char*)g.Bt + (size_t)nxt.pe * g.estride + (size_t)nxt.pn * tstep : cB;
        for (int t = 0; t < nt; t += 2) {
            const bool last = (t == nt - 2);
            const char* a1 = cA + (size_t)(t + 1) * kstep;
            const char* a2 = last ? nA : cA + (size_t)(t + 2) * kstep; const char* b2 = last ? nB : cB + (size_t)(t + 2) * kstep;
            const char* a3 = a2 + kstep; const char* b3 = b2 + kstep;
            if (last && has_next) S.a_ready(nxt);
            if constexpr (SP2) {
            PG8_LDB(B0, 0, 0); PG8_LDB(B1, 0, 1); PG8_SCHED; PG8_LDA(At, 0, 0); PG8_STAGE(PG8_SA(1, 1), a1 + hstep, voffA);
            PG8_WAIT_V(8); PG8_WAIT_L(0); PG8_BAR; PG8_MMA(0, 0, At, B0); PG8_MMA(0, 1, At, B1); PG8_BAR; PG8_SCHED;
            PG8_LDA(At, 0, 1); PG8_STAGE(PG8_SB(0, 0), b2, voffB); PG8_STAGE(PG8_SB(0, 1), b2 + hstep, voffB); PG8_STAGE(PG8_SA(0, 0), a2, voffA);
            PG8_WAIT_V(8); PG8_WAIT_L(0); PG8_BAR; PG8_MMA(1, 0, At, B0); PG8_MMA(1, 1, At, B1); PG8_BAR; PG8_SCHED;
            PG8_LDB(B0, 1, 0); PG8_LDB(B1, 1, 1); PG8_SCHED; PG8_LDA(At, 1, 0); PG8_STAGE(PG8_SA(0, 1), a2 + hstep, voffA);
            PG8_WAIT_V(8); PG8_WAIT_L(0); PG8_BAR; PG8_MMA(0, 0, At, B0); PG8_MMA(0, 1, At, B1); PG8_BAR; PG8_SCHED;
            PG8_LDA(At, 1, 1); PG8_STAGE(PG8_SB(1, 0), b3, voffB); PG8_STAGE(PG8_SB(1, 1), b3 + hstep, voffB); PG8_STAGE(PG8_SA(1, 0), a3, voffA);
            PG8_WAIT_V(8); PG8_WAIT_L(0); PG8_BAR; PG8_MMA(1, 0, At, B0); PG8_MMA(1, 1, At, B1); PG8_BAR; PG8_SCHED;
            } else {
            PG8_LDB(B0, 0, 0); PG8_SCHED; PG8_LDA(At, 0, 0); PG8_STAGE(PG8_SA(1, 1), a1 + hstep, voffA);
            PG8_WAIT_L(8); PG8_BAR; PG8_WAIT_L(0); PG8_MMA(0, 0, At, B0); PG8_BAR; PG8_SCHED;
            PG8_LDB(B1, 0, 1); PG8_STAGE(PG8_SB(0, 0), b2, voffB);
            PG8_BAR; PG8_WAIT_L(0); PG8_MMA(0, 1, At, B1); PG8_BAR;
            PG8_LDA(At, 0, 1); PG8_STAGE(PG8_SA(0, 0), a2, voffA);
            PG8_BAR; PG8_WAIT_L(0); PG8_MMA(1, 0, At, B0); PG8_BAR; PG8_SCHED;
            PG8_STAGE(PG8_SB(0, 1), b2 + hstep, voffB);
            PG8_WAIT_V(6); PG8_BAR; PG8_MMA(1, 1, At, B1); PG8_BAR;
            PG8_LDB(B0, 1, 0); PG8_SCHED; PG8_LDA(At, 1, 0); PG8_STAGE(PG8_SA(0, 1), a2 + hstep, voffA);
            PG8_WAIT_L(8); PG8_BAR; PG8_WAIT_L(0); PG8_MMA(0, 0, At, B0); PG8_BAR; PG8_SCHED;
            PG8_LDB(B1, 1, 1); PG8_STAGE(PG8_SB(1, 0), b3, voffB);
            PG8_BAR; PG8_WAIT_L(0); PG8_MMA(0, 1, At, B1); PG8_BAR;
            PG8_LDA(At, 1, 1); PG8_STAGE(PG8_SA(1, 0), a3, voffA);
            PG8_BAR; PG8_WAIT_L(0); PG8_MMA(1, 0, At, B0); PG8_BAR; PG8_SCHED;
            PG8_STAGE(PG8_SB(1, 1), b3 + hstep, voffB);
            PG8_WAIT_V(6); PG8_BAR; PG8_MMA(1, 1, At, B1); PG8_BAR;
            }
        }
        if constexpr (ALIGN_EPI) { if (wr == 0) PG8_BAR; }
        if constexpr (!Epi::AFTER_DRAIN) { E(acc, cur, wr, wc, fr, fq); S.done(cur); }
        if (!has_next) break;
#pragma unroll
        for (int a = 0; a < 2; ++a)
#pragma unroll
            for (int b = 0; b < 2; ++b)
#pragma unroll
                for (int m = 0; m < 4; ++m)
#pragma unroll
                    for (int n = 0; n < 2; ++n) acc[a][b][m][n] = (f32x4){0.f, 0.f, 0.f, 0.f};
        cur = nxt; cA = nA; cB = nB; ++ui;
        if constexpr (ALIGN_EPI) { if (wr == 1) PG8_BAR; }
    }
    PG8_WAIT_V(0);
    if constexpr (!ALIGN_EPI) { if (wr == 0) PG8_BAR; }
    PG8_BAR;
    if constexpr (Epi::AFTER_DRAIN) { E.fused(acc, cur, wr, wc, fr, fq, lds, wid, lane); S.done(cur); }
#undef PG8_SA
#undef PG8_SB
#undef PG8_STAGE
#undef PG8_LDA
#undef PG8_LDB
#undef PG8_MMA
#undef PG8_WAIT_V
#undef PG8_WAIT_L
#undef PG8_BAR
#undef PG8_SCHED
}
}

namespace sba {
using bf16x8 = __attribute__((ext_vector_type(8))) short;
using s16x4 = __attribute__((ext_vector_type(4))) short;
using f32x16 = __attribute__((ext_vector_type(16))) float;
typedef unsigned short bf16_t;
constexpr int PITCH = 512, QB = 256, KVBLK = 64, SLOTB = 8192;
constexpr int LDS_K = 0, LDS_V = 2 * SLOTB, LDS_FLAGS = 4 * SLOTB, LDS_BYTES = 4 * SLOTB + 64;
constexpr float R_DONE = -150.0f;
typedef __attribute__((address_space(3))) const char* lds_cptr;
typedef short v4i16_t __attribute__((ext_vector_type(4)));
#define SBA_MFMA(a, b, c) __builtin_amdgcn_mfma_f32_32x32x16_bf16(a, b, c, 0, 0, 0)
__device__ __forceinline__ int crow(int r, int hi) { return (r & 3) + 8 * (r >> 2) + 4 * hi; }
__device__ __forceinline__ void glds16(const void* gsrc, unsigned lds_dst) { unsigned keep;
    asm volatile("s_mov_b32 %0, m0\n\ts_mov_b32 m0, %2\n\ts_nop 0\n\tglobal_load_lds_dwordx4 %1, off\n\ts_mov_b32 m0, %0" : "=&s"(keep) : "v"(gsrc), "s"(lds_dst) : "memory"); }
typedef float f32x2_t __attribute__((ext_vector_type(2))); typedef __bf16 bf16x2_t __attribute__((ext_vector_type(2)));
__device__ __forceinline__ unsigned cvtpk(float lo, float hi) { f32x2_t v = {lo, hi}; bf16x2_t b = __builtin_convertvector(v, bf16x2_t); return __builtin_bit_cast(unsigned, b); }
__device__ __forceinline__ s16x4 vtr(lds_cptr p) { return __builtin_bit_cast(s16x4, __builtin_amdgcn_ds_read_tr16_b64_v4i16((__attribute__((address_space(3))) v4i16_t*)p)); }
__device__ __forceinline__ bf16x8 pack8(const f32x16& v, int b0) {
    typedef unsigned u32x4 __attribute__((ext_vector_type(4)));
    u32x4 w; w.x = cvtpk(v[b0], v[b0 + 1]); w.y = cvtpk(v[b0 + 2], v[b0 + 3]); w.z = cvtpk(v[b0 + 4], v[b0 + 5]); w.w = cvtpk(v[b0 + 6], v[b0 + 7]); return __builtin_bit_cast(bf16x8, w); }

template <bool DIAG> __device__ __forceinline__ void tile(f32x16 (&o)[2], f32x16& R, const bf16x8 (&qr)[4], const bf16x8 (&tri)[2], const bf16x8 ones, lds_cptr kp, lds_cptr vp, int qrel, int hi) {
    f32x16 z0 = {}, z1 = {};
#pragma unroll
    for (int d0 = 0; d0 < 4; ++d0) {
        const bf16x8 k0 = *(const __attribute__((address_space(3))) bf16x8*)(kp + d0 * 2048);
        const bf16x8 k1 = *(const __attribute__((address_space(3))) bf16x8*)(kp + d0 * 2048 + 512);
        z0 = SBA_MFMA(k0, qr[d0], z0); z1 = SBA_MFMA(k1, qr[d0], z1); }
    f32x16 sp;
#pragma unroll
    for (int r = 0; r < 16; ++r) { const float zc = __builtin_fminf(z1[r], 126.0f); float s = __builtin_amdgcn_logf(1.0f + __builtin_amdgcn_exp2f(zc));
        if (DIAG) { if (!(32 + crow(r, hi) < qrel)) s = 0.f; }
        sp[r] = s; z1[r] = (zc - s) + R[r]; }
    const bf16x8 x1a = pack8(sp, 0), x1b = pack8(sp, 8);
    f32x16 S = SBA_MFMA(ones, x1a, R); S = SBA_MFMA(ones, x1b, S);
    z1 = SBA_MFMA(tri[0], x1a, z1); z1 = SBA_MFMA(tri[1], x1b, z1);
#pragma unroll
    for (int r = 0; r < 16; ++r) { const float zc = __builtin_fminf(z0[r], 126.0f); float s = __builtin_amdgcn_logf(1.0f + __builtin_amdgcn_exp2f(zc));
        if (DIAG) { if (!(crow(r, hi) < qrel)) s = 0.f; }
        sp[r] = s; z0[r] = (zc - s) + S[r]; }
    const bf16x8 x0a = pack8(sp, 0), x0b = pack8(sp, 8);
    z0 = SBA_MFMA(tri[0], x0a, z0); z0 = SBA_MFMA(tri[1], x0b, z0);
    R = SBA_MFMA(ones, x0a, S); R = SBA_MFMA(ones, x0b, R);
#pragma unroll
    for (int r = 0; r < 16; ++r) { float a0 = __builtin_amdgcn_exp2f(z0[r]), a1 = __builtin_amdgcn_exp2f(z1[r]);
        if (DIAG) { if (!(crow(r, hi) < qrel)) a0 = 0.f; if (!(32 + crow(r, hi) < qrel)) a1 = 0.f; }
        z0[r] = a0; z1[r] = a1; }
    const bf16x8 p0 = pack8(z0, 0), p1 = pack8(z0, 8), p2 = pack8(z1, 0), p3 = pack8(z1, 8);
#pragma unroll
    for (int d0 = 0; d0 < 2; ++d0) {
        s16x4 lo[4], hh[4];
#pragma unroll
        for (int ks = 0; ks < 4; ++ks) { lo[ks] = vtr(vp + d0 * 4096 + ks * 1024); hh[ks] = vtr(vp + d0 * 4096 + ks * 1024 + 512); }
#define SBA_PK(k) (bf16x8){lo[k][0], lo[k][1], lo[k][2], lo[k][3], hh[k][0], hh[k][1], hh[k][2], hh[k][3]}
        o[d0] = SBA_MFMA(p0, SBA_PK(0), o[d0]); o[d0] = SBA_MFMA(p1, SBA_PK(1), o[d0]); o[d0] = SBA_MFMA(p2, SBA_PK(2), o[d0]); o[d0] = SBA_MFMA(p3, SBA_PK(3), o[d0]);
#undef SBA_PK
    }
}

#define SBA_WAIT_BAR() asm volatile("s_waitcnt vmcnt(0) lgkmcnt(0)\n\ts_barrier" ::: "memory")
__device__ __forceinline__ void attn_unit(int b, int h, int qb, const bf16_t* Q, const bf16_t* K, const bf16_t* V, bf16_t* O, char* shm) {
    int tid_ = threadIdx.x; asm volatile("" : "+v"(tid_)); const int tid = tid_, lane = tid & 63, r32 = lane & 31, hi = lane >> 5; const int wid = __builtin_amdgcn_readfirstlane(tid >> 6);
    const long rowbase = (long)b * SEQ; const int q0 = qb * QB;
    const bf16_t* Qw = Q + (rowbase + q0 + wid * 32) * PITCH + h * HDIM;
    const bf16_t* Kh = K + rowbase * PITCH + h * HDIM; const bf16_t* Vh = V + rowbase * PITCH + h * HDIM;
    const unsigned lds0 = (unsigned)(uintptr_t)shm;
    const bf16_t* ksrc = Kh + (long)lane * PITCH + wid * 8;
    const bf16_t* vsrc = Vh + (long)(16 * (wid & 3) + (lane >> 2)) * PITCH + (wid >> 2) * 32 + (lane & 3) * 8;
    const unsigned kdst = lds0 + LDS_K + wid * 1024, vdst = lds0 + LDS_V + wid * 1024;
#define SBA_DMA(t, slot) do { glds16(ksrc + (long)(t) * KVBLK * PITCH, (unsigned)__builtin_amdgcn_readfirstlane(kdst + (slot))); glds16(vsrc + (long)(t) * KVBLK * PITCH, (unsigned)__builtin_amdgcn_readfirstlane(vdst + (slot))); } while (0)
    const lds_cptr shm3 = (lds_cptr)shm;
    const lds_cptr kp0 = shm3 + LDS_K + hi * 1024 + r32 * 16;
    const lds_cptr vp0 = shm3 + LDS_V + ((lane >> 4) & 1) * 32 + (lane & 3) * 8 + (4 * hi + ((lane & 15) >> 2)) * 64;
    volatile __attribute__((address_space(3))) unsigned* flags = (volatile __attribute__((address_space(3))) unsigned*)(shm3 + LDS_FLAGS);
    const int jtop = 4 * qb + 3, jd = 4 * qb + (wid >> 1), qrel = 32 * (wid & 1) + r32;
    SBA_DMA(jtop, 0);
    bf16x8 qr[4];
#pragma unroll
    for (int d0 = 0; d0 < 4; ++d0) qr[d0] = *reinterpret_cast<const bf16x8*>(&Qw[(long)r32 * PITCH + d0 * 16 + hi * 8]);
    bf16x8 tri[2]; bf16x8 ones;
#pragma unroll
    for (int s = 0; s < 2; ++s)
#pragma unroll
        for (int j = 0; j < 8; ++j) tri[s][j] = ((16 * s + 8 * (j >> 2) + 4 * hi + (j & 3)) > r32) ? (short)0xBF80 : (short)0;
#pragma unroll
    for (int j = 0; j < 8; ++j) ones[j] = (short)0xBF80;
    f32x16 o[2]; o[0] = f32x16{}; o[1] = f32x16{}; f32x16 R = f32x16{};
    bool mydone = false;
    for (int j = jtop, it = 0; j >= 0; --j, ++it) {
        SBA_WAIT_BAR();
        if (it > 0) { const int pf = ((it - 1) & 1) * 8; unsigned all = 1u;
#pragma unroll
            for (int w = 0; w < 8; ++w) all &= flags[pf + w];
            if (__builtin_amdgcn_readfirstlane(all)) break; }
        const int cur = (it & 1) * SLOTB, oth = SLOTB - cur;
        if (j > 0) SBA_DMA(j - 1, oth);
        if (!mydone && j <= jd) {
            if (j == jd) tile<true>(o, R, qr, tri, ones, kp0 + cur, vp0 + cur, qrel, hi);
            else tile<false>(o, R, qr, tri, ones, kp0 + cur, vp0 + cur, qrel, hi);
            mydone = __all(R[0] < R_DONE) != 0;
        }
        if (lane == 0) flags[(it & 1) * 8 + wid] = mydone ? 1u : 0u;
    }
    SBA_WAIT_BAR();
    bf16_t* Ow = O + (rowbase + q0 + wid * 32) * PITCH + h * HDIM;
#pragma unroll
    for (int r = 0; r < 16; ++r) { const int orow = crow(r, hi);
#pragma unroll
        for (int d0 = 0; d0 < 2; ++d0) { const unsigned w = cvtpk(o[d0][r], 0.f); Ow[(long)orow * PITCH + d0 * 32 + r32] = (bf16_t)(w & 0xffffu); } }
#undef SBA_DMA
}
#undef SBA_WAIT_BAR
#undef SBA_MFMA
}


constexpr size_t MiB = 1u << 20, KiB = 1u << 10;
constexpr size_t WS_CTL = 0, CTL_ZERO_BYTES = 64 * KiB;
constexpr size_t WS_TAB = 1 * MiB;
constexpr size_t TB_MOD = WS_TAB;
constexpr size_t TB_HIST = WS_TAB + 192 * KiB;
constexpr size_t TB_TILE = WS_TAB + 208 * KiB;
constexpr size_t TB_EIDX = WS_TAB + 256 * KiB;
constexpr size_t TB_GATE = WS_TAB + 512 * KiB;
constexpr size_t TB_SLOT = WS_TAB + 768 * KiB;
constexpr size_t TB_GW = WS_TAB + 1024 * KiB;
constexpr size_t TB_PAR = WS_TAB + 1408 * KiB;
constexpr int PAR_WCONV = 0, PAR_LN1G = PAR_WCONV + DEPTH * 3 * CONV_CH, PAR_LN1B = PAR_LN1G + DEPTH * DM, PAR_LN2G = PAR_LN1B + DEPTH * DM, PAR_LN2B = PAR_LN2G + DEPTH * DM,
              PAR_BR = PAR_LN2B + DEPTH * DM, PAR_WR = PAR_BR + NEXP, PAR_TOTAL = PAR_WR + DM * NEXP;
static_assert(TB_PAR + (size_t)PAR_TOTAL * 4 <= 3 * MiB, "tables");
constexpr size_t WS_W = 3 * MiB;
constexpr size_t W_IN = WS_W, W_IN_L = (size_t)IN_W * DM * 2;
constexpr size_t W_A = W_IN + DEPTH * W_IN_L, W_A_L = (size_t)DM * CONV_CH * 2;
constexpr size_t W_B = W_A + DEPTH * W_A_L, W_B_L = W_A_L;
constexpr size_t W_O = W_B + DEPTH * W_B_L, W_O_L = (size_t)DM * DM * 2;
constexpr size_t W_GU = W_O + DEPTH * W_O_L, W_GU_E = (size_t)2 * FFD * DM * 2;
constexpr size_t W_DN = W_GU + (size_t)DEPTH * NEXP * W_GU_E, W_DN_E = (size_t)DM * FFD * 2;
constexpr size_t WS_ACT = W_DN + (size_t)DEPTH * NEXP * W_DN_E;
constexpr size_t WS_PROJ = WS_ACT + (size_t)M_TOK * DM * 2;
constexpr size_t PJ_T512 = (size_t)M_TOK * 512 * 2, PJ_GA = 6 * PJ_T512, PJ_GB = PJ_GA + (size_t)M_TOK * DM * 2;
constexpr size_t PJ_XS = 0, PJ_HS = (size_t)PMAX * DM * 2;
constexpr size_t WS_END = WS_PROJ + (size_t)M_TOK * IN_W * 2;
static_assert(WS_ACT == 127 * MiB && WS_END == 511 * MiB, "d_ws map");
static_assert(PJ_HS + (size_t)PMAX * FFD * 2 <= (size_t)M_TOK * IN_W * 2, "MoE overlay fits the proj region");
constexpr int CW_BAR = 4096;

constexpr int RING_OFF = 0, RING_BYTES = 131072;
constexpr int LDSCTL_OFF = RING_BYTES, MISC_OFF = LDSCTL_OFF + 320;
constexpr int LDS_BYTES = 147456;
static_assert(MISC_OFF + 128 <= LDS_BYTES, "LDS map");

#define GAS __attribute__((address_space(1)))
#define LAS __attribute__((address_space(3)))
typedef unsigned short bf16;
typedef unsigned v4u __attribute__((ext_vector_type(4)));
typedef unsigned v2u __attribute__((ext_vector_type(2)));
typedef float f32x4 __attribute__((ext_vector_type(4)));
typedef GAS unsigned gu32;
#define RLX_AGENT __ATOMIC_RELAXED, __HIP_MEMORY_SCOPE_AGENT
#define LDS_WAIT() asm volatile("s_waitcnt lgkmcnt(0)" ::: "memory")
#define VM_WAIT() asm volatile("s_waitcnt vmcnt(0)" ::: "memory")
__device__ __forceinline__ unsigned f2bf(float f) { unsigned u = __builtin_bit_cast(unsigned, f); return (u + 0x7fffu + ((u >> 16) & 1u)) >> 16; }
__device__ __forceinline__ unsigned pk2(float lo, float hi) { return f2bf(lo) | (f2bf(hi) << 16); }
__device__ __forceinline__ float bflo(unsigned w) { return __uint_as_float(w << 16); }
__device__ __forceinline__ float bfhi(unsigned w) { return __uint_as_float(w & 0xffff0000u); }


#define XB_TMO      128
#define XB_XCNT(j)  (256  + 64 * (j))
#define XB_XSUB(j)  (1280 + 64 * (j))
#define XB_XGEN(j)  (2304 + 64 * (j))
#define XB_TOP      3328
#define XB_TOPGEN   3392
#define XCD_BAR_WORDS 3456
#define XB_SPIN_CAP (1u << 18)

__device__ __forceinline__ unsigned xb_ld(unsigned* p)              { return __hip_atomic_load(p, __ATOMIC_RELAXED, __HIP_MEMORY_SCOPE_AGENT); }
__device__ __forceinline__ unsigned xb_add(unsigned* p, unsigned v) { return __hip_atomic_fetch_add(p, v, __ATOMIC_RELAXED, __HIP_MEMORY_SCOPE_AGENT); }
__device__ __forceinline__ unsigned xb_xcc_id() { return (unsigned)__builtin_amdgcn_s_getreg((3 << 11) | 20) & 0xFu; }
#define XB_SPIN(cond, bar) do { unsigned _sp = 0; while (cond) { __builtin_amdgcn_s_sleep(1); \
    if ((++_sp & 255u) == 0u) { if (xb_ld(&(bar)[XB_TMO])) break; if (_sp > XB_SPIN_CAP) { atomicAdd(&(bar)[XB_TMO], 1u); break; } } } } while (0)

struct XcdBarrier {
    unsigned* bar; unsigned x;
    volatile LAS unsigned* st;
};

__device__ __forceinline__ XcdBarrier xcd_barrier_post(unsigned* bar, volatile LAS unsigned* st) {
    XcdBarrier b; b.bar = bar; b.x = xb_xcc_id(); b.st = st;
    if (threadIdx.x == 0) (void)xb_add(&bar[XB_XCNT(b.x)], 1u);
    return b;
}
__device__ __forceinline__ void xcd_barrier_complete(unsigned* bar, unsigned x, unsigned& nloc, unsigned& nx) {
    const unsigned G = gridDim.x * gridDim.y * gridDim.z;
    unsigned sum, cnt, mine, sp = 0u;
    for (;;) {
        sum = 0u; cnt = 0u; mine = 0u;
#pragma unroll
        for (unsigned j = 0; j < 16; ++j) { const unsigned c = xb_ld(&bar[XB_XCNT(j)]); sum += c; cnt += (c > 0u) ? 1u : 0u; mine = (j == x) ? c : mine; }
        if (sum == G) break;
        __builtin_amdgcn_s_sleep(1);
        if ((++sp & 255u) == 0u) { if (xb_ld(&bar[XB_TMO])) break; if (sp > XB_SPIN_CAP) { atomicAdd(&bar[XB_TMO], 1u); break; } }
    }
    nloc = mine > 0u ? mine : 1u; nx = cnt > 0u ? cnt : 1u;
}

__device__ __forceinline__ void xcd_barrier(const XcdBarrier& b) {
    asm volatile("s_waitcnt vmcnt(0)" ::: "memory");
    __syncthreads();
    if (threadIdx.x == 0) {
        unsigned* bar = b.bar;
        __builtin_amdgcn_s_waitcnt(0);
        unsigned nloc = b.st[0], nx = b.st[1];
        if (nloc == 0u) { xcd_barrier_complete(bar, b.x, nloc, nx); b.st[0] = nloc; b.st[1] = nx; }
        const unsigned old = xb_add(&bar[XB_XSUB(b.x)], 1u);
        const unsigned gen = old / nloc;
        if (old + 1u == (gen + 1u) * nloc) {
            __builtin_amdgcn_fence(__ATOMIC_RELEASE, "agent");
            asm volatile("s_waitcnt vmcnt(0)" ::: "memory");
            const unsigned og = xb_add(&bar[XB_TOP], 1u);
            const unsigned tg = og / nx;
            if (og + 1u == (tg + 1u) * nx) xb_add(&bar[XB_TOPGEN], 1u);
            else XB_SPIN(xb_ld(&bar[XB_TOPGEN]) == tg, bar);
            __builtin_amdgcn_fence(__ATOMIC_ACQUIRE, "agent");
            xb_add(&bar[XB_XGEN(b.x)], 1u);
            asm volatile("s_waitcnt vmcnt(0)" ::: "memory");
        } else {
            XB_SPIN(xb_ld(&bar[XB_XGEN(b.x)]) == gen, bar);
            __builtin_amdgcn_fence(__ATOMIC_ACQUIRE, "agent");
            asm volatile("s_waitcnt vmcnt(0)" ::: "memory");
        }
    }
    __syncthreads();
}


struct Frame {
    LAS unsigned char* lds;
    volatile LAS unsigned* MISC;
    gu32* ctl;
    unsigned char* ws;
    const float* x; float* out;
    int tid, lane, wave;
    int vcu, G;
};
struct Args { const float* in[18]; float* out; unsigned char* ws; int ph_lo, ph_hi; };

__device__ __forceinline__ float wave_sum(float v) {
#pragma unroll
    for (int o = 1; o < 64; o <<= 1) v += __shfl_xor(v, o);
    return v;
}

__device__ __forceinline__ void p0_transpose_item(const float* W, int K, int N, bf16* WT, int row_off, int row_mul, float scale, int sc_n0, int sc_n1, LAS float* scr, int item, int lane) {
    const int nblk = N / 32, kb = item / nblk, nb = item % nblk, k0 = 64 * kb, n0 = 32 * nb;
#pragma unroll 8
    for (int i = 0; i < 32; ++i) { const int kk = 2 * i + (lane >> 5); scr[kk * 33 + (lane & 31)] = W[(size_t)(k0 + kk) * N + n0 + (lane & 31)]; }
    LDS_WAIT(); asm volatile("" ::: "memory");
    const float sc = (n0 >= sc_n0 && n0 < sc_n1) ? scale : 1.0f;
    const int c = lane & 7;
#pragma unroll
    for (int j = 0; j < 4; ++j) { const int n = (lane >> 3) + 8 * j; const LAS float* s = scr + (8 * c) * 33 + n;
        v4u o; o.x = pk2(s[0 * 33] * sc, s[1 * 33] * sc); o.y = pk2(s[2 * 33] * sc, s[3 * 33] * sc); o.z = pk2(s[4 * 33] * sc, s[5 * 33] * sc); o.w = pk2(s[6 * 33] * sc, s[7 * 33] * sc);
        *(GAS v4u*)(WT + (size_t)(row_off + (n0 + n) * row_mul) * K + k0 + 8 * c) = o; }
    LDS_WAIT(); asm volatile("" ::: "memory");
}
__device__ __forceinline__ void p0a_prologue(Frame& F, const Args& a) {
    const float* c = a.in[1]; const float* w_ada = a.in[2]; const float* b_ada = a.in[3];
    if (F.vcu < 192) {
        LAS float* sl = (LAS float*)(F.lds);
        LAS float* red = (LAS float*)(F.lds + 16384);
        for (int i = F.tid; i < BATCH * DM; i += NTHREADS) { const float cv = c[i]; sl[i] = cv / (1.f + __expf(-cv)); }
        __syncthreads();
        const int l = F.vcu / 96, cb = F.vcu % 96, col = cb * 64 + F.lane;
        const float* w = w_ada + (size_t)l * DM * 6 * DM + col;
        float acc[BATCH] = {0.f, 0.f, 0.f, 0.f};
        const int kbeg = F.wave * 128;
#pragma unroll 8
        for (int k = kbeg; k < kbeg + 128; ++k) { const float wv = w[(size_t)k * 6 * DM];
#pragma unroll
            for (int b = 0; b < BATCH; ++b) acc[b] += sl[b * DM + k] * wv; }
#pragma unroll
        for (int b = 0; b < BATCH; ++b) red[(F.wave * BATCH + b) * 64 + F.lane] = acc[b];
        __syncthreads();
        if (F.wave < BATCH) { float s = 0.f;
#pragma unroll
            for (int w8 = 0; w8 < 8; ++w8) s += red[(w8 * BATCH + F.wave) * 64 + F.lane];
            float* mod = (float*)(F.ws + TB_MOD);
            mod[((size_t)l * BATCH + F.wave) * 6 * DM + col] = s + b_ada[l * 6 * DM + col]; }
        __syncthreads();
    }
    { const int gt = F.vcu * NTHREADS + F.tid, NGT = F.G * NTHREADS; float* par = (float*)(F.ws + TB_PAR);
      for (int i = gt; i < PAR_TOTAL; i += NGT) { float v;
          if (i < PAR_LN1G) v = a.in[5][i - PAR_WCONV];
          else if (i < PAR_LN1B) v = a.in[9][i - PAR_LN1G];
          else if (i < PAR_LN2G) v = a.in[10][i - PAR_LN1B];
          else if (i < PAR_LN2B) v = a.in[16][i - PAR_LN2G];
          else if (i < PAR_BR) v = a.in[17][i - PAR_LN2B];
          else if (i < PAR_WR) v = a.in[12][i - PAR_BR];
          else v = a.in[11][i - PAR_WR];
          par[i] = v; } }
    LAS float* scr = (LAS float*)(F.lds + RING_OFF + F.wave * 16384);
    const int gw = F.vcu * NWAVES + F.wave, NGW = F.G * NWAVES;
    constexpr int I_IN = (DM / 64) * (IN_W / 32), I_AB = (CONV_CH / 64) * (DM / 32), I_O = (DM / 64) * (DM / 32), I_G = (DM / 64) * (FFD / 32), I_D = (FFD / 64) * (DM / 32);
    constexpr int PER_L = I_IN + 2 * I_AB + I_O + NEXP * (2 * I_G + I_D), NITEMS = DEPTH * PER_L;
    for (int it = gw; it < NITEMS; it += NGW) {
        const int l = it / PER_L; int r = it % PER_L;
        if (r < I_IN) { p0_transpose_item(a.in[4] + (size_t)l * DM * IN_W, DM, IN_W, (bf16*)(F.ws + W_IN + l * W_IN_L), 0, 1, QSCALE, 3 * CONV_CH, 3 * CONV_CH + ATT_W, scr, r, F.lane); continue; } r -= I_IN;
        if (r < I_AB) { p0_transpose_item(a.in[6] + (size_t)l * CONV_CH * DM, CONV_CH, DM, (bf16*)(F.ws + W_A + l * W_A_L), 0, 1, 1.f, 0, 0, scr, r, F.lane); continue; } r -= I_AB;
        if (r < I_AB) { p0_transpose_item(a.in[7] + (size_t)l * ATT_W * DM, ATT_W, DM, (bf16*)(F.ws + W_B + l * W_B_L), 0, 1, 1.f, 0, 0, scr, r, F.lane); continue; } r -= I_AB;
        if (r < I_O) { p0_transpose_item(a.in[8] + (size_t)l * DM * DM, DM, DM, (bf16*)(F.ws + W_O + l * W_O_L), 0, 1, 1.f, 0, 0, scr, r, F.lane); continue; } r -= I_O;
        const int e = r / (2 * I_G + I_D); r %= (2 * I_G + I_D); const size_t le = (size_t)l * NEXP + e;
        if (r < I_G) { p0_transpose_item(a.in[13] + le * DM * FFD, DM, FFD, (bf16*)(F.ws + W_GU + le * W_GU_E), 0, 2, 1.f, 0, 0, scr, r, F.lane); continue; } r -= I_G;
        if (r < I_G) { p0_transpose_item(a.in[14] + le * DM * FFD, DM, FFD, (bf16*)(F.ws + W_GU + le * W_GU_E), 1, 2, 1.f, 0, 0, scr, r, F.lane); continue; } r -= I_G;
        p0_transpose_item(a.in[15] + le * FFD * DM, FFD, DM, (bf16*)(F.ws + W_DN + le * W_DN_E), 0, 1, 1.f, 0, 0, scr, r, F.lane);
    }
}
__device__ __forceinline__ void p0b_u0(Frame& F) {
    const float* x = F.x; const float* mod = (const float*)(F.ws + TB_MOD); bf16* U = (bf16*)(F.ws + WS_ACT);
    const int gw = F.vcu * NWAVES + F.wave, NGW = F.G * NWAVES;
    for (int m = gw; m < M_TOK; m += NGW) { const int b = m / SEQ; const float* mb = mod + (size_t)b * 6 * DM;
#pragma unroll
        for (int j = 0; j < 4; ++j) { const int col = j * 256 + F.lane * 4; const f32x4 v = *(const f32x4*)(x + (size_t)m * DM + col), sh = *(const f32x4*)(mb + col), sc = *(const f32x4*)(mb + DM + col);
            const f32x4 u = v * (sc + 1.0f) + sh; v2u o; o.x = pk2(u[0], u[1]); o.y = pk2(u[2], u[3]); *(v2u*)(U + (size_t)m * DM + col) = o; } }
}
__device__ __forceinline__ void p2_conv(Frame& F, int l) {
    bf16* cb = (bf16*)(F.ws + WS_PROJ); const bf16* cc = cb + (size_t)M_TOK * 512; const bf16* cx = cc + (size_t)M_TOK * 512;
    const float* wc = (const float*)(F.ws + TB_PAR) + PAR_WCONV + (size_t)l * 3 * CONV_CH;
    const int gw = F.vcu * NWAVES + F.wave, NGW = F.G * NWAVES; const int ch = F.lane * 8;
    float w0[8], w1[8], w2[8];
#pragma unroll
    for (int i = 0; i < 8; ++i) { w0[i] = wc[ch + i]; w1[i] = wc[CONV_CH + ch + i]; w2[i] = wc[2 * CONV_CH + ch + i]; }
    for (int chunk = gw; chunk < M_TOK / 16; chunk += NGW) {
        const int row0 = chunk * 16; const int t0 = row0 % SEQ;
        float pm2[8], pm1[8];
#pragma unroll
        for (int i = 0; i < 8; ++i) { pm2[i] = 0.f; pm1[i] = 0.f; }
        if (t0 >= 2) {
            const v4u c2 = *(const v4u*)(cc + (size_t)(row0 - 2) * 512 + ch), x2 = *(const v4u*)(cx + (size_t)(row0 - 2) * 512 + ch), c1 = *(const v4u*)(cc + (size_t)(row0 - 1) * 512 + ch), x1 = *(const v4u*)(cx + (size_t)(row0 - 1) * 512 + ch);
#pragma unroll
            for (int i = 0; i < 4; ++i) { pm2[2 * i] = bflo(c2[i]) * bflo(x2[i]); pm2[2 * i + 1] = bfhi(c2[i]) * bfhi(x2[i]); pm1[2 * i] = bflo(c1[i]) * bflo(x1[i]); pm1[2 * i + 1] = bfhi(c1[i]) * bfhi(x1[i]); }
        }
        for (int r = 0; r < 16; ++r) { const size_t off = (size_t)(row0 + r) * 512 + ch;
            const v4u c0 = *(const v4u*)(cc + off), x0 = *(const v4u*)(cx + off), bb = *(const v4u*)(cb + off);
            float p0[8], o[8];
#pragma unroll
            for (int i = 0; i < 4; ++i) { p0[2 * i] = bflo(c0[i]) * bflo(x0[i]); p0[2 * i + 1] = bfhi(c0[i]) * bfhi(x0[i]); }
#pragma unroll
            for (int i = 0; i < 8; ++i) o[i] = w2[i] * p0[i] + w1[i] * pm1[i] + w0[i] * pm2[i];
            v4u ov;
#pragma unroll
            for (int i = 0; i < 4; ++i) ov[i] = pk2(bflo(bb[i]) * o[2 * i], bfhi(bb[i]) * o[2 * i + 1]);
            *(v4u*)(cb + off) = ov;
#pragma unroll
            for (int i = 0; i < 8; ++i) { pm2[i] = pm1[i]; pm1[i] = p0[i]; } }
    }
}
__device__ __forceinline__ void p2_attn(Frame& F, unsigned char* lds_generic) {
    const sba::bf16_t* Q = (const sba::bf16_t*)(F.ws + WS_PROJ + 3 * PJ_T512); const sba::bf16_t* K = (const sba::bf16_t*)(F.ws + WS_PROJ + 4 * PJ_T512); const sba::bf16_t* V = (const sba::bf16_t*)(F.ws + WS_PROJ + 5 * PJ_T512);
    sba::bf16_t* O = (sba::bf16_t*)(F.ws + WS_PROJ + 3 * PJ_T512);
    constexpr int NQB = SEQ / 256, NUNITS = BATCH * NHEAD * NQB;
    if (F.G == 256) {
        const int bh = F.vcu >> 3, s = F.vcu & 7;
        for (int i = 0; i < 4; ++i) { const int qb = (i == 0) ? s : (i == 1) ? 15 - s : (i == 2) ? 16 + s : 31 - s; sba::attn_unit(bh / NHEAD, bh % NHEAD, qb, Q, K, V, O, (char*)lds_generic); }
    } else {
        for (int u = F.vcu; u < NUNITS; u += F.G) { const int bh = u / NQB, qb = u % NQB; sba::attn_unit(bh / NHEAD, bh % NHEAD, qb, Q, K, V, O, (char*)lds_generic); }
    }
}
__device__ __forceinline__ void p5_ln1(Frame& F, int l) {
    float* X = F.out; const float* mod = (const float*)(F.ws + TB_MOD) + (size_t)l * BATCH * 6 * DM; const float* par = (const float*)(F.ws + TB_PAR);
    const float* g = par + PAR_LN1G + l * DM; const float* bta = par + PAR_LN1B + l * DM; const float* w_router = par + PAR_WR; const float* b_router = par + PAR_BR;
    bf16* U2 = (bf16*)(F.ws + WS_ACT); int* eidx = (int*)(F.ws + TB_EIDX); float* gate = (float*)(F.ws + TB_GATE); int* bhist = (int*)(F.ws + TB_HIST);
    LAS float* wl = (LAS float*)(F.lds);
    LAS int* hist = (LAS int*)(F.lds + 65536);
    for (int idx = F.tid; idx < DM * NEXP; idx += NTHREADS) { const int ee = idx & 3, ln = (idx >> 2) & 63, e4 = (idx >> 8) & 3, ji = idx >> 10; const int col = (ji >> 2) * 256 + ln * 4 + (ji & 3);
        wl[idx] = w_router[col * NEXP + e4 * 4 + ee]; }
    if (F.tid < NEXP) hist[F.tid] = 0;
    __syncthreads();
    float br[NEXP];
#pragma unroll
    for (int e = 0; e < NEXP; ++e) br[e] = b_router[e];
    const int blk = blockIdx.x;
    for (int i = 0; i < 16; ++i) {
        const int row = blk * 128 + F.wave * 16 + i; const int b = row / SEQ; const float* mb = mod + (size_t)b * 6 * DM;
        f32x4 v[4]; float s = 0.f;
#pragma unroll
        for (int j = 0; j < 4; ++j) { v[j] = *(const f32x4*)(X + (size_t)row * DM + j * 256 + F.lane * 4); s += (v[j][0] + v[j][1]) + (v[j][2] + v[j][3]); }
        const float mean = wave_sum(s) * (1.f / DM); float s2 = 0.f;
#pragma unroll
        for (int j = 0; j < 4; ++j) { v[j] = v[j] - mean; s2 += (v[j][0] * v[j][0] + v[j][1] * v[j][1]) + (v[j][2] * v[j][2] + v[j][3] * v[j][3]); }
        const float rstd = 1.f / sqrtf(wave_sum(s2) * (1.f / DM) + LN_EPS);
        float lg[NEXP];
#pragma unroll
        for (int e = 0; e < NEXP; ++e) lg[e] = 0.f;
#pragma unroll
        for (int j = 0; j < 4; ++j) { const int col = j * 256 + F.lane * 4;
            const f32x4 gg = *(const f32x4*)(g + col), bb = *(const f32x4*)(bta + col), sc = *(const f32x4*)(mb + 4 * DM + col), sh = *(const f32x4*)(mb + 3 * DM + col);
            const f32x4 xo = v[j] * rstd * gg + bb; *(f32x4*)(X + (size_t)row * DM + col) = xo;
            const f32x4 uo = xo * (sc + 1.0f) + sh; v2u o; o.x = pk2(uo[0], uo[1]); o.y = pk2(uo[2], uo[3]); *(v2u*)(U2 + (size_t)row * DM + col) = o;
#pragma unroll
            for (int ii = 0; ii < 4; ++ii)
#pragma unroll
                for (int e4 = 0; e4 < 4; ++e4) { const f32x4 wv = *(const LAS f32x4*)(wl + ((((j * 4 + ii) * 4 + e4) * 64 + F.lane) * 4));
                    lg[e4 * 4 + 0] += uo[ii] * wv[0]; lg[e4 * 4 + 1] += uo[ii] * wv[1]; lg[e4 * 4 + 2] += uo[ii] * wv[2]; lg[e4 * 4 + 3] += uo[ii] * wv[3]; } }
        float h8[8], h4[4], h2[2], h1;
        { const bool up = (F.lane & 32) != 0;
#pragma unroll
          for (int k = 0; k < 8; ++k) { const float send = up ? lg[k] : lg[k + 8], keep = up ? lg[k + 8] : lg[k]; h8[k] = keep + __shfl_xor(send, 32); } }
        { const bool up = (F.lane & 16) != 0;
#pragma unroll
          for (int k = 0; k < 4; ++k) { const float send = up ? h8[k] : h8[k + 4], keep = up ? h8[k + 4] : h8[k]; h4[k] = keep + __shfl_xor(send, 16); } }
        { const bool up = (F.lane & 8) != 0;
#pragma unroll
          for (int k = 0; k < 2; ++k) { const float send = up ? h4[k] : h4[k + 2], keep = up ? h4[k + 2] : h4[k]; h2[k] = keep + __shfl_xor(send, 8); } }
        { const bool up = (F.lane & 4) != 0; const float send = up ? h2[0] : h2[1], keep = up ? h2[1] : h2[0]; h1 = keep + __shfl_xor(send, 4); }
        h1 += __shfl_xor(h1, 2); h1 += __shfl_xor(h1, 1);
        float aff[NEXP], sel[NEXP];
#pragma unroll
        for (int e = 0; e < NEXP; ++e) { const float z = __shfl(h1, e << 2); aff[e] = 1.f / (1.f + __expf(-z)); sel[e] = aff[e] + br[e]; }
        int gbest = 0; float gs_best = -1e30f;
#pragma unroll
        for (int gi = 0; gi < 4; ++gi) { float m1 = -1e30f, m2 = -1e30f;
#pragma unroll
            for (int k = 0; k < 4; ++k) { const float xv = sel[gi * 4 + k]; if (xv > m1) { m2 = m1; m1 = xv; } else if (xv > m2) m2 = xv; }
            const float gsc = m1 + m2; if (gsc > gs_best) { gs_best = gsc; gbest = gi; } }
        float sg[4], ag[4];
#pragma unroll
        for (int k = 0; k < 4; ++k) { sg[k] = gbest == 0 ? sel[k] : gbest == 1 ? sel[4 + k] : gbest == 2 ? sel[8 + k] : sel[12 + k]; ag[k] = gbest == 0 ? aff[k] : gbest == 1 ? aff[4 + k] : gbest == 2 ? aff[8 + k] : aff[12 + k]; }
        int i1 = 0; float v1 = sg[0];
#pragma unroll
        for (int k = 1; k < 4; ++k) if (sg[k] > v1) { v1 = sg[k]; i1 = k; }
        int i2 = -1; float v2 = -1e30f;
#pragma unroll
        for (int k = 0; k < 4; ++k) if (k != i1 && sg[k] > v2) { v2 = sg[k]; i2 = k; }
        const float a1 = i1 == 0 ? ag[0] : i1 == 1 ? ag[1] : i1 == 2 ? ag[2] : ag[3], a2 = i2 == 0 ? ag[0] : i2 == 1 ? ag[1] : i2 == 2 ? ag[2] : ag[3];
        const float inv = 1.f / (a1 + a2);
        if (F.lane == 0) { const int e1 = gbest * 4 + i1, e2 = gbest * 4 + i2;
            eidx[row * 2] = e1; eidx[row * 2 + 1] = e2; gate[row * 2] = a1 * inv; gate[row * 2 + 1] = a2 * inv;
            __hip_atomic_fetch_add(&hist[e1], 1, __ATOMIC_RELAXED, __HIP_MEMORY_SCOPE_WORKGROUP); __hip_atomic_fetch_add(&hist[e2], 1, __ATOMIC_RELAXED, __HIP_MEMORY_SCOPE_WORKGROUP); }
    }
    __syncthreads();
    if (F.tid < NEXP) bhist[blk * NEXP + F.tid] = hist[F.tid];
}
__device__ __forceinline__ void p6_scan_permute(Frame& F, int l) {
    const int* bhist = (const int*)(F.ws + TB_HIST); const int* eidx = (const int*)(F.ws + TB_EIDX); const float* gate = (const float*)(F.ws + TB_GATE);
    int* slot = (int*)(F.ws + TB_SLOT); float* gws = (float*)(F.ws + TB_GW); int* tilet = (int*)(F.ws + TB_TILE) + l * 512;
    const bf16* U2 = (const bf16*)(F.ws + WS_ACT); bf16* XS = (bf16*)(F.ws + WS_PROJ + PJ_XS);
    LAS int* H = (LAS int*)(F.lds);
    LAS int* tot = H + 256 * 16; LAS int* pre = tot + 16; LAS int* base = pre + 16; LAS int* pst = base + 16;
    LAS int* eb = pst + 32; LAS int* sl = eb + 256;
    const int blk = blockIdx.x;
    if (F.tid < 256) { const v4u* src = (const v4u*)(bhist + F.tid * 16); LAS v4u* dst = (LAS v4u*)(H + F.tid * 16); dst[0] = src[0]; dst[1] = src[1]; dst[2] = src[2]; dst[3] = src[3]; }
    __syncthreads();
    if (F.tid < NEXP) { int t = 0, p = 0; for (int k = 0; k < 256; ++k) { const int v = H[k * 16 + F.tid]; if (k < blk) p += v; t += v; } tot[F.tid] = t; pre[F.tid] = p; }
    __syncthreads();
    if (F.tid == 0) { int acc = 0; for (int e = 0; e < NEXP; ++e) { pst[e] = acc; base[e] = acc + pre[e]; acc += ((tot[e] + 255) >> 8) << 8; } pst[NEXP] = acc; }
    __syncthreads();
    if (blk == 0 && F.tid <= NTILE_MAX) {
        if (F.tid == 0) tilet[0] = pst[NEXP] >> 8;
        else { const int ti = F.tid - 1; int e = NEXP - 1;
            for (int k = 0; k < NEXP; ++k) if (ti * 256 >= pst[k] && ti * 256 < pst[k + 1]) e = k;
            tilet[1 + ti] = e; } }
    if (F.tid < 128) { const int tok = blk * 128 + F.tid; eb[F.tid * 2] = eidx[tok * 2]; eb[F.tid * 2 + 1] = eidx[tok * 2 + 1]; }
    __syncthreads();
    if (F.tid < 128) { const int tok = blk * 128 + F.tid; const int e0 = eb[F.tid * 2], e1 = eb[F.tid * 2 + 1]; int r0 = 0, r1 = 0;
        for (int k = 0; k < F.tid; ++k) { const int a0 = eb[k * 2], a1 = eb[k * 2 + 1]; r0 += (a0 == e0 || a1 == e0) ? 1 : 0; r1 += (a0 == e1 || a1 == e1) ? 1 : 0; }
        const int s0 = base[e0] + r0, s1 = base[e1] + r1; sl[F.tid * 2] = s0; sl[F.tid * 2 + 1] = s1;
        slot[tok * 2] = s0; slot[tok * 2 + 1] = s1; gws[s0] = gate[tok * 2]; gws[s1] = gate[tok * 2 + 1]; }
    __syncthreads();
    for (int k = 0; k < 16; ++k) { const int i = F.wave * 16 + k, tok = blk * 128 + i; const int s0 = sl[i * 2], s1 = sl[i * 2 + 1];
        const v4u a0 = *(const v4u*)(U2 + (size_t)tok * DM + F.lane * 8), a1 = *(const v4u*)(U2 + (size_t)tok * DM + 512 + F.lane * 8);
        *(v4u*)(XS + (size_t)s0 * DM + F.lane * 8) = a0; *(v4u*)(XS + (size_t)s0 * DM + 512 + F.lane * 8) = a1;
        *(v4u*)(XS + (size_t)s1 * DM + F.lane * 8) = a0; *(v4u*)(XS + (size_t)s1 * DM + 512 + F.lane * 8) = a1; }
}
__device__ __forceinline__ void build_group_table(Frame& F, int l) {
    LAS int* tab = (LAS int*)(F.lds + LDSCTL_OFF);
    if (F.tid == 0) { const int* tilet = (const int*)(F.ws + TB_TILE) + l * 512; const int ntiles = tilet[0], nunits = ntiles * 4; int n = 0;
        for (int i = 0; i < 8; ++i) { const int L = i * F.G + (int)blockIdx.x; if (L >= nunits) break; const int wgid = pg8::xcd_remap(L, nunits); const int ti = wgid >> 2;
            tab[1 + 3 * n] = ti; tab[2 + 3 * n] = wgid & 3; tab[3 + 3 * n] = tilet[1 + ti]; ++n; }
        tab[0] = n; }
    __syncthreads();
}
__device__ __forceinline__ void p9_ln2(Frame& F, int l) {
    float* X = F.out; const float* modl = (const float*)(F.ws + TB_MOD) + (size_t)l * BATCH * 6 * DM; const float* modn = modl + (size_t)BATCH * 6 * DM; const float* par = (const float*)(F.ws + TB_PAR);
    const float* g = par + PAR_LN2G + l * DM; const float* bta = par + PAR_LN2B + l * DM; const int* slot = (const int*)(F.ws + TB_SLOT);
    const bf16* YS = (const bf16*)(F.ws + WS_PROJ + PJ_XS); bf16* U = (bf16*)(F.ws + WS_ACT);
    const int gw = F.vcu * NWAVES + F.wave, NGW = F.G * NWAVES;
    for (int m = gw; m < M_TOK; m += NGW) { const int b = m / SEQ; const float* mb = modl + (size_t)b * 6 * DM;
        const int s0 = slot[m * 2], s1 = slot[m * 2 + 1];
        f32x4 v[4]; float s = 0.f;
#pragma unroll
        for (int j = 0; j < 4; ++j) { const int col = j * 256 + F.lane * 4; const f32x4 xv = *(const f32x4*)(X + (size_t)m * DM + col), g2 = *(const f32x4*)(mb + 5 * DM + col);
            const v2u y0 = *(const v2u*)(YS + (size_t)s0 * DM + col), y1 = *(const v2u*)(YS + (size_t)s1 * DM + col);
            f32x4 f; f[0] = bflo(y0.x) + bflo(y1.x); f[1] = bfhi(y0.x) + bfhi(y1.x); f[2] = bflo(y0.y) + bflo(y1.y); f[3] = bfhi(y0.y) + bfhi(y1.y);
            v[j] = xv * DN_ALPHA + g2 * f; s += (v[j][0] + v[j][1]) + (v[j][2] + v[j][3]); }
        const float mean = wave_sum(s) * (1.f / DM); float s2 = 0.f;
#pragma unroll
        for (int j = 0; j < 4; ++j) { v[j] = v[j] - mean; s2 += (v[j][0] * v[j][0] + v[j][1] * v[j][1]) + (v[j][2] * v[j][2] + v[j][3] * v[j][3]); }
        const float rstd = 1.f / sqrtf(wave_sum(s2) * (1.f / DM) + LN_EPS);
#pragma unroll
        for (int j = 0; j < 4; ++j) { const int col = j * 256 + F.lane * 4; const f32x4 gg = *(const f32x4*)(g + col), bb = *(const f32x4*)(bta + col);
            const f32x4 xo = v[j] * rstd * gg + bb; *(f32x4*)(X + (size_t)m * DM + col) = xo;
            if (l + 1 < DEPTH) { const float* mn = modn + (size_t)b * 6 * DM; const f32x4 sh = *(const f32x4*)(mn + col), sc = *(const f32x4*)(mn + DM + col);
                const f32x4 u = xo * (sc + 1.0f) + sh; v2u o; o.x = pk2(u[0], u[1]); o.y = pk2(u[2], u[3]); *(v2u*)(U + (size_t)m * DM + col) = o; } } }
}

constexpr int PH_PER_LAYER = 9, N_PHASES = 2 + DEPTH * PH_PER_LAYER;
__global__ void __launch_bounds__(NTHREADS, 2) mega_fwd(Args args) {
    extern __shared__ __attribute__((aligned(16))) unsigned char lds[];
    Frame F;
    F.lds = (LAS unsigned char*)lds;
    F.MISC = (volatile LAS unsigned*)(F.lds + MISC_OFF);
    F.tid = threadIdx.x; F.lane = F.tid & 63; F.wave = __builtin_amdgcn_readfirstlane(F.tid >> 6);
    F.G = gridDim.x; { const int bx = blockIdx.x; F.vcu = (F.G % 8 == 0) ? (bx % 8) * (F.G / 8) + bx / 8 : bx; }
    F.ws = args.ws; F.ctl = (gu32*)(args.ws + WS_CTL); F.x = args.in[0]; F.out = args.out;
    for (int u = F.tid; u < (LDS_BYTES - LDSCTL_OFF) / 4; u += NTHREADS) ((LAS unsigned*)(F.lds + LDSCTL_OFF))[u] = 0u;
    __syncthreads();
    const int lo = args.ph_lo, hi = args.ph_hi;
    XcdBarrier bar; bar.bar = (unsigned*)(F.ctl + CW_BAR); bar.x = 0; bar.st = nullptr;
    if (hi - lo > 1) bar = xcd_barrier_post((unsigned*)(F.ctl + CW_BAR), F.MISC + 8);
#define IN(k) (lo <= (k) && (k) < hi)
#define FRESH() do { asm volatile("" : "+v"(F.tid), "+v"(F.lane)); asm volatile("" : "+s"(F.ws), "+s"(F.wave), "+s"(F.vcu)); } while (0)
#define SEAM(k) do { if (IN(k) && IN((k) + 1)) xcd_barrier(bar); } while (0)
    if (IN(0)) { FRESH(); p0a_prologue(F, args); SEAM(0); }
    if (IN(1)) { FRESH(); p0b_u0(F); SEAM(1); }
#pragma unroll 1
    for (int l = 0; l < DEPTH; ++l) {
        const int pb = 2 + l * PH_PER_LAYER;
        const float* modl = (const float*)(F.ws + TB_MOD) + (size_t)l * BATCH * 6 * DM;
        if (IN(pb + 0)) {
            FRESH();
            pg8::Gemm g{(const pg8::bf16_t*)(F.ws + WS_ACT), (const pg8::bf16_t*)(F.ws + W_IN + l * W_IN_L), M_TOK, IN_W, DM, 0};
            pg8::StaticOrder S; S.init(M_TOK, IN_W, F.G, (int)blockIdx.x);
            pg8::EpiProj E{(pg8::bf16_t*)(F.ws + WS_PROJ)};
            pg8::gemm_phase<pg8::EpiProj, pg8::StaticOrder, true, true>(F.lds + RING_OFF, g, S, E);
            SEAM(pb + 0); }
        if (IN(pb + 1)) { FRESH(); p2_conv(F, l); FRESH(); p2_attn(F, lds + RING_OFF); SEAM(pb + 1); }
        if (IN(pb + 2)) {
            FRESH();
            pg8::StaticOrder S; S.init(M_TOK, DM, F.G, (int)blockIdx.x);
            { pg8::Gemm g{(const pg8::bf16_t*)(F.ws + WS_PROJ), (const pg8::bf16_t*)(F.ws + W_A + l * W_A_L), M_TOK, DM, CONV_CH, 0};
              pg8::EpiGate<false> E{(const pg8::bf16_t*)(F.ws + WS_PROJ + PJ_GA), (pg8::bf16_t*)(F.ws + WS_ACT)};
              pg8::gemm_phase<pg8::EpiGate<false>, pg8::StaticOrder, true, true>(F.lds + RING_OFF, g, S, E); }
            VM_WAIT(); __syncthreads(); FRESH();
            { pg8::Gemm g{(const pg8::bf16_t*)(F.ws + WS_PROJ + 3 * PJ_T512), (const pg8::bf16_t*)(F.ws + W_B + l * W_B_L), M_TOK, DM, ATT_W, 0};
              pg8::EpiGate<true> E{(const pg8::bf16_t*)(F.ws + WS_PROJ + PJ_GB), (pg8::bf16_t*)(F.ws + WS_ACT)};
              pg8::gemm_phase<pg8::EpiGate<true>, pg8::StaticOrder, true, true>(F.lds + RING_OFF, g, S, E); }
            SEAM(pb + 2); }
        if (IN(pb + 3)) {
            FRESH();
            pg8::Gemm g{(const pg8::bf16_t*)(F.ws + WS_ACT), (const pg8::bf16_t*)(F.ws + W_O + l * W_O_L), M_TOK, DM, DM, 0};
            pg8::StaticOrder S; S.init(M_TOK, DM, F.G, (int)blockIdx.x);
            pg8::EpiH1 E{l == 0 ? F.x : (const float*)F.out, F.out, modl + 2 * DM};
            pg8::gemm_phase<pg8::EpiH1, pg8::StaticOrder, true, true>(F.lds + RING_OFF, g, S, E);
            SEAM(pb + 3); }
        if (IN(pb + 4)) { FRESH(); p5_ln1(F, l); SEAM(pb + 4); }
        if (IN(pb + 5)) { FRESH(); p6_scan_permute(F, l); SEAM(pb + 5); }
        if (IN(pb + 6)) {
            FRESH(); build_group_table(F, l);
            pg8::Gemm g{(const pg8::bf16_t*)(F.ws + WS_PROJ + PJ_XS), (const pg8::bf16_t*)(F.ws + W_GU + (size_t)l * NEXP * W_GU_E), PMAX, 2 * FFD, DM, W_GU_E};
            pg8::GroupedOrder S{(const PG8_LAS int*)(F.lds + LDSCTL_OFF)};
            pg8::EpiGU E{(pg8::bf16_t*)(F.ws + WS_PROJ + PJ_HS)};
            pg8::gemm_phase<pg8::EpiGU, pg8::GroupedOrder, true, true>(F.lds + RING_OFF, g, S, E);
            SEAM(pb + 6); }
        if (IN(pb + 7)) {
            FRESH(); build_group_table(F, l);
            pg8::Gemm g{(const pg8::bf16_t*)(F.ws + WS_PROJ + PJ_HS), (const pg8::bf16_t*)(F.ws + W_DN + (size_t)l * NEXP * W_DN_E), PMAX, DM, FFD, W_DN_E};
            pg8::GroupedOrder S{(const PG8_LAS int*)(F.lds + LDSCTL_OFF)};
            pg8::EpiDown E{(pg8::bf16_t*)(F.ws + WS_PROJ + PJ_XS), (const float*)(F.ws + TB_GW)};
            pg8::gemm_phase<pg8::EpiDown, pg8::GroupedOrder, true, true>(F.lds + RING_OFF, g, S, E);
            SEAM(pb + 7); }
        if (IN(pb + 8)) { FRESH(); p9_ln2(F, l); SEAM(pb + 8); }
    }
#undef IN
#undef FRESH
#undef SEAM
}

#ifndef MK_PER_PHASE
#define MK_PER_PHASE 0
#endif
extern "C" void kernel_launch(void* const* d_in, const int* in_sizes, int n_in, void* d_out, int out_size, void* d_ws, size_t ws_size, hipStream_t stream) {
    static int grid = 0;
    if (grid == 0) {
        if (n_in != 18 || in_sizes[0] != M_TOK * DM || out_size != M_TOK * DM || ws_size < WS_END) { fprintf(stderr, "kernel_launch: unexpected shapes / workspace (%d inputs, ws %zu)\n", n_in, ws_size); grid = -1; return; }
        int dev = 0, cus = 0;
        if (hipGetDevice(&dev) != hipSuccess || hipDeviceGetAttribute(&cus, hipDeviceAttributeMultiprocessorCount, dev) != hipSuccess) { grid = -1; return; }
        if (hipFuncSetAttribute((const void*)mega_fwd, hipFuncAttributeMaxDynamicSharedMemorySize, LDS_BYTES) != hipSuccess) { fprintf(stderr, "kernel_launch: hipFuncSetAttribute failed\n"); grid = -1; return; }
        int per_cu = 0;
        if (hipOccupancyMaxActiveBlocksPerMultiprocessor(&per_cu, (const void*)mega_fwd, NTHREADS, LDS_BYTES) != hipSuccess || per_cu < 1) { fprintf(stderr, "kernel_launch: occupancy query says %d blocks/CU\n", per_cu); }
        (void)hipGetLastError();
        grid = cus;
        if (grid != 256) fprintf(stderr, "kernel_launch: %d CUs: the row phases assume a 256-workgroup grid\n", grid);
    }
    if (grid < 0) return;
    (void)hipMemsetAsync((char*)d_ws + WS_CTL, 0, CTL_ZERO_BYTES, stream);
    Args a{};
    for (int i = 0; i < 18; ++i) a.in[i] = (const float*)d_in[i];
    a.out = (float*)d_out; a.ws = (unsigned char*)d_ws;
#if MK_PER_PHASE
    for (int p = 0; p < N_PHASES; ++p) { a.ph_lo = p; a.ph_hi = p + 1; hipLaunchKernelGGL(mega_fwd, dim3(grid), dim3(NTHREADS), LDS_BYTES, stream, a); }
#else
    a.ph_lo = 0; a.ph_hi = N_PHASES;
    hipLaunchKernelGGL(mega_fwd, dim3(grid), dim3(NTHREADS), LDS_BYTES, stream, a);
#endif
}
```

```cpp
#include <hip/hip_runtime.h>
#include <hip/hip_bf16.h>
#include <cstdio>
#include <cstdint>

constexpr int DM = 1024, BATCH = 4, SEQ = 8192, M_TOK = BATCH * SEQ, DEPTH = 2;
constexpr int CONV_CH = 512, ATT_W = 512, NHEAD = 8, HDIM = 64, IN_W = 5120;
constexpr int NEXP = 16, FFD = 512;
constexpr int PMAX = 2 * M_TOK + NEXP * 256;
constexpr int NTILE_MAX = PMAX / 256;
constexpr float LN_EPS = 1e-5f;
constexpr float DN_ALPHA = 1.41421356237309515f;
constexpr float LOG2E = 1.4426950408889634f;
constexpr float QSCALE = 0.125f * LOG2E;
constexpr int NWAVES = 8, NTHREADS = 512;

namespace pg8 {
#define PG8_LAS __attribute__((address_space(3)))
typedef unsigned short bf16_t;
typedef short bf16x8 __attribute__((ext_vector_type(8)));
typedef float f32x4 __attribute__((ext_vector_type(4)));
typedef unsigned u32x4 __attribute__((ext_vector_type(4)));
typedef unsigned u32x2 __attribute__((ext_vector_type(2)));
typedef int i32x4 __attribute__((ext_vector_type(4)));
constexpr int BM = 256, BK = 64, HALF = 128, HTB = HALF * BK * 2  , STAGE_BYTES = 8 * HTB, NXCD = 8, WGM = 2;

__host__ __device__ __forceinline__ int lds_byte(int r, int c) { const int st = (r >> 4) * 2 + (c >> 5), rr = r & 15, cc = c & 31, ob = rr * 64 + cc * 2; return st * 1024 + (ob ^ (((ob >> 9) & 1) << 5)); }
__host__ __device__ __forceinline__ void stage_rc(int b, int& R, int& C) { const int st = b / 1024, sb = b % 1024, swz = sb ^ (((sb >> 9) & 1) << 5); R = (st >> 1) * 16 + swz / 64; C = (st & 1) * 32 + (swz % 64) / 2; }
__host__ __device__ __forceinline__ int perm32(int rho) { const int n = rho >> 4, i = rho & 15; return 8 * (i >> 2) + 4 * n + (i & 3); }

struct Unit { int pm, pn, pe, ui; };
struct Gemm { const bf16_t* A; const bf16_t* Bt; int M, N, K; size_t estride; const bf16_t* A2; const bf16_t* Bt2; const PG8_LAS int* rowtab; };

__host__ __device__ __forceinline__ int xcd_remap(int wgid, int nwg) { const int q = nwg / NXCD, r = nwg % NXCD, xcd = wgid % NXCD, off = wgid / NXCD; return (xcd < r ? xcd * (q + 1) : r * (q + 1) + (xcd - r) * q) + off; }

struct StaticOrder {
    int nM, nN, nwg, G, c, wgm;
    __host__ __device__ void init(int M, int N, int G_, int c_, int wgm_ = WGM) { nM = M / BM; nN = N / BM; nwg = nM * nN; G = G_; c = c_; wgm = wgm_; }
    __host__ __device__ bool next(int i, Unit& u) const {
        const long L = (long)i * G + c; if (L >= nwg) return false;
        const int wgid = xcd_remap((int)L, nwg);
        const int nig = wgm * nN, gid = wgid / nig, fm = gid * wgm, gsz = (nM - fm) < wgm ? (nM - fm) : wgm;
        u.pm = fm + ((wgid % nig) % gsz); u.pn = (wgid % nig) / gsz; u.pe = 0; u.ui = 0; return true;
    }
    __device__ __forceinline__ void a_ready(const Unit&) const {}
    __device__ __forceinline__ void done(const Unit&) const {}
};
struct GroupedOrder {
    const PG8_LAS int* tab;
    __device__ __forceinline__ bool next(int i, Unit& u) const {
        const int n = __builtin_amdgcn_readfirstlane(tab[0]); if (i >= n) return false;
        u.pm = __builtin_amdgcn_readfirstlane(tab[1 + 3 * i]); u.pn = __builtin_amdgcn_readfirstlane(tab[2 + 3 * i]); u.pe = __builtin_amdgcn_readfirstlane(tab[3 + 3 * i]); u.ui = i; return true;
    }
    __device__ __forceinline__ void a_ready(const Unit&) const {}
    __device__ __forceinline__ void done(const Unit&) const {}
};

__device__ __forceinline__ f32x4 mma16(bf16x8 b, bf16x8 a, f32x4 c) { return __builtin_amdgcn_mfma_f32_16x16x32_bf16(b, a, c, 0, 0, 0); }
__device__ __forceinline__ i32x4 mma16(bf16x8 b, bf16x8 a, i32x4 c) { return __builtin_amdgcn_mfma_i32_16x16x64_i8(__builtin_bit_cast(i32x4, b), __builtin_bit_cast(i32x4, a), c, 0, 0, 0); }
typedef int i32x8 __attribute__((ext_vector_type(8)));
__device__ __forceinline__ int f8pk(float a, float b, int old, bool hi) { a = __builtin_amdgcn_fmed3f(a, -448.0f, 448.0f); b = __builtin_amdgcn_fmed3f(b, -448.0f, 448.0f); return hi ? __builtin_amdgcn_cvt_pk_fp8_f32(a, b, old, true) : __builtin_amdgcn_cvt_pk_fp8_f32(a, b, old, false); }
template <int SA, int SB> __device__ __forceinline__ f32x4 mma_f8(bf16x8 a0, bf16x8 a1, bf16x8 b0, bf16x8 b1, f32x4 c) {
    const i32x8 A = __builtin_shufflevector(__builtin_bit_cast(i32x4, a0), __builtin_bit_cast(i32x4, a1), 0, 1, 2, 3, 4, 5, 6, 7);
    const i32x8 B = __builtin_shufflevector(__builtin_bit_cast(i32x4, b0), __builtin_bit_cast(i32x4, b1), 0, 1, 2, 3, 4, 5, 6, 7);
    const int sa = SA * 0x01010101, sb = SB * 0x01010101;
    asm volatile("s_nop 1\n\tv_mfma_scale_f32_16x16x128_f8f6f4 %0, %1, %2, %0, %3, %4 op_sel_hi:[0,0,0]" : "+v"(c) : "v"(A), "v"(B), "v"(sa), "v"(sb));
    return c;
}
__device__ __forceinline__ unsigned cvt_pk_bf16(float lo, float hi) { unsigned r; asm volatile("v_cvt_pk_bf16_f32 %0, %1, %2" : "=v"(r) : "v"(lo), "v"(hi)); return r; }
__device__ __forceinline__ float bf_lo(unsigned w) { return __uint_as_float(w << 16); }
__device__ __forceinline__ float bf_hi(unsigned w) { return __uint_as_float(w & 0xffff0000u); }
__device__ __forceinline__ float sigmoidf_fast(float x) { return __builtin_amdgcn_rcpf(1.0f + __builtin_amdgcn_exp2f(-LOG2E * x)); }


struct EpiProj {
    static constexpr bool PERM = true, AFTER_DRAIN = false, DUAL = false, I8 = false, GATHER = false, FP8 = false; typedef f32x4 acc_t;
    bf16_t* proj;
    __device__ __forceinline__ void operator()(const f32x4 (&acc)[2][2][4][2], const Unit& u, int wr, int wc, int fr, int fq) const {
        const int row0 = u.pm * BM + wr * 64 + fr; const int pn = u.pn;
        bf16_t* base; int ldc, colt;
        if (pn < 12) { base = proj + (size_t)(pn >> 1) * ((size_t)M_TOK * 512); ldc = 512; colt = (pn & 1) * 256; }
        else { base = proj + (size_t)6 * M_TOK * 512 + (size_t)((pn - 12) >> 2) * ((size_t)M_TOK * 1024); ldc = 1024; colt = ((pn - 12) & 3) * 256; }
        const int col0 = colt + wc * 32 + 8 * fq;
#pragma unroll
        for (int ai = 0; ai < 2; ++ai)
#pragma unroll
            for (int m = 0; m < 4; ++m) { bf16_t* rowp = base + (size_t)(row0 + ai * HALF + m * 16) * ldc + col0;
#pragma unroll
                for (int bj = 0; bj < 2; ++bj) { const f32x4 v0 = acc[ai][bj][m][0], v1 = acc[ai][bj][m][1];
                    u32x4 w; w.x = cvt_pk_bf16(v0[0], v0[1]); w.y = cvt_pk_bf16(v0[2], v0[3]); w.z = cvt_pk_bf16(v1[0], v1[1]); w.w = cvt_pk_bf16(v1[2], v1[3]);
                    *(u32x4*)(rowp + bj * HALF) = w; } }
    }
};
struct EpiMerge {
    static constexpr bool PERM = true, AFTER_DRAIN = false, DUAL = true, I8 = false, GATHER = false, FP8 = true; typedef f32x4 acc_t;
    static constexpr int F8_SCALE_A = 127 - 1, F8_SCALE_B = 127 - 6;
    const unsigned char* ga; const unsigned char* gb; bf16_t* out;
    static __device__ __forceinline__ float by(unsigned w, int i) { return (float)((w >> (8 * i)) & 0xffu); }
    static __device__ __forceinline__ float sbq(unsigned w, int i) { return __builtin_fmaxf(by(w, i), 0.5f); }
    __device__ __forceinline__ void mid(f32x4 (&acc)[2][2][4][2], const Unit& u, int wr, int wc, int fr, int fq) const {
        int row0 = u.pm * BM + wr * 64 + fr, col0 = u.pn * BM + wc * 32 + 8 * fq;
        asm volatile("" : "+v"(row0), "+v"(col0));
#pragma unroll
        for (int ai = 0; ai < 2; ++ai) {
            u32x2 a[4][2], b[4][2];
#pragma unroll
            for (int m = 0; m < 4; ++m)
#pragma unroll
                for (int bj = 0; bj < 2; ++bj) { const size_t off = (size_t)(row0 + ai * HALF + m * 16) * 1024 + col0 + bj * HALF; a[m][bj] = *(const u32x2*)(ga + off); b[m][bj] = *(const u32x2*)(gb + off); }
#pragma unroll
            for (int m = 0; m < 4; ++m)
#pragma unroll
                for (int bj = 0; bj < 2; ++bj) { const u32x2 av = a[m][bj], bv = b[m][bj]; f32x4 r0, r1;
#pragma unroll
                    for (int i = 0; i < 4; ++i) { r0[i] = by(av.x, i) * __builtin_amdgcn_rcpf(sbq(bv.x, i)); r1[i] = by(av.y, i) * __builtin_amdgcn_rcpf(sbq(bv.y, i)); }
                    acc[ai][bj][m][0] = acc[ai][bj][m][0] * r0; acc[ai][bj][m][1] = acc[ai][bj][m][1] * r1; }
            asm volatile("" ::: "memory"); }
    }
    __device__ __forceinline__ void operator()(const f32x4 (&acc)[2][2][4][2], const Unit& u, int wr, int wc, int fr, int fq) const {
        const int row0 = u.pm * BM + wr * 64 + fr, col0 = u.pn * BM + wc * 32 + 8 * fq;
#pragma unroll
        for (int ai = 0; ai < 2; ++ai) {
            u32x2 b[4][2];
#pragma unroll
            for (int m = 0; m < 4; ++m)
#pragma unroll
                for (int bj = 0; bj < 2; ++bj) b[m][bj] = *(const u32x2*)(gb + (size_t)(row0 + ai * HALF + m * 16) * 1024 + col0 + bj * HALF);
#pragma unroll
            for (int m = 0; m < 4; ++m)
#pragma unroll
                for (int bj = 0; bj < 2; ++bj) { const size_t off = (size_t)(row0 + ai * HALF + m * 16) * 1024 + col0 + bj * HALF;
                    const u32x2 bv = b[m][bj]; const f32x4 v0 = acc[ai][bj][m][0] * (8.0f / 255.0f), v1 = acc[ai][bj][m][1] * (8.0f / 255.0f);
                    int w0 = f8pk(sbq(bv.x, 0) * v0[0], sbq(bv.x, 1) * v0[1], 0, false); w0 = f8pk(sbq(bv.x, 2) * v0[2], sbq(bv.x, 3) * v0[3], w0, true);
                    int w1 = f8pk(sbq(bv.y, 0) * v1[0], sbq(bv.y, 1) * v1[1], 0, false); w1 = f8pk(sbq(bv.y, 2) * v1[2], sbq(bv.y, 3) * v1[3], w1, true);
                    u32x2 w; w.x = (unsigned)w0; w.y = (unsigned)w1;
                    *(u32x2*)((unsigned char*)out + off) = w; }
            asm volatile("" ::: "memory"); }
    }
};
template <bool XIN_F32> struct EpiH1 {
    static constexpr bool PERM = true, AFTER_DRAIN = false, DUAL = false, I8 = false, GATHER = false, FP8 = true; typedef f32x4 acc_t;
    static constexpr int F8_SCALE_A = 127 - 3, F8_SCALE_B = 127 - 6;
    const void* xin; bf16_t* XB; const float* g1;
    __device__ __forceinline__ void operator()(const f32x4 (&acc)[2][2][4][2], const Unit& u, int wr, int wc, int fr, int fq) const {
        const int row0 = u.pm * BM + wr * 64 + fr, col0 = u.pn * BM + wc * 32 + 8 * fq; const int b = (u.pm * BM) / SEQ;
        f32x4 gv[2][2];
#pragma unroll
        for (int bj = 0; bj < 2; ++bj)
#pragma unroll
            for (int n = 0; n < 2; ++n) gv[bj][n] = *(const f32x4*)(g1 + (size_t)b * 6 * DM + col0 + bj * HALF + n * 4);
#pragma unroll
        for (int am = 0; am < 4; ++am) { const int ai = am >> 1, mb = (am & 1) * 2;
            u32x4 p[2][2]; f32x4 x0[2][2], x1[2][2];
#pragma unroll
            for (int mm = 0; mm < 2; ++mm)
#pragma unroll
                for (int bj = 0; bj < 2; ++bj) { const size_t off = (size_t)(row0 + ai * HALF + (mb + mm) * 16) * DM + col0 + bj * HALF;
                    if (XIN_F32) { x0[mm][bj] = *(const f32x4*)((const float*)xin + off); x1[mm][bj] = *(const f32x4*)((const float*)xin + off + 4); }
                    else p[mm][bj] = *(const u32x4*)((const bf16_t*)xin + off); }
#pragma unroll
            for (int mm = 0; mm < 2; ++mm)
#pragma unroll
                for (int bj = 0; bj < 2; ++bj) { const int m = mb + mm; const size_t off = (size_t)(row0 + ai * HALF + m * 16) * DM + col0 + bj * HALF;
                    f32x4 a0, a1;
                    if (XIN_F32) { a0 = x0[mm][bj]; a1 = x1[mm][bj]; }
                    else { const u32x4 q = p[mm][bj]; a0 = (f32x4){bf_lo(q.x), bf_hi(q.x), bf_lo(q.y), bf_hi(q.y)}; a1 = (f32x4){bf_lo(q.z), bf_hi(q.z), bf_lo(q.w), bf_hi(q.w)}; }
                    const f32x4 v0 = a0 * DN_ALPHA + gv[bj][0] * acc[ai][bj][m][0], v1 = a1 * DN_ALPHA + gv[bj][1] * acc[ai][bj][m][1];
                    u32x4 w; w.x = cvt_pk_bf16(v0[0], v0[1]); w.y = cvt_pk_bf16(v0[2], v0[3]); w.z = cvt_pk_bf16(v1[0], v1[1]); w.w = cvt_pk_bf16(v1[2], v1[3]);
                    *(u32x4*)(XB + off) = w; }
            asm volatile("" ::: "memory"); }
    }
};
struct EpiGU {
    static constexpr bool PERM = true, AFTER_DRAIN = false, DUAL = false, I8 = false, GATHER = false, FP8 = false; typedef f32x4 acc_t;
    bf16_t* H;
    __device__ __forceinline__ void operator()(const f32x4 (&acc)[2][2][4][2], const Unit& u, int wr, int wc, int fr, int fq) const {
        const int row0 = u.pm * BM + wr * 64 + fr, hcol0 = u.pn * 128 + wc * 16 + 4 * fq;
#pragma unroll
        for (int ai = 0; ai < 2; ++ai)
#pragma unroll
            for (int m = 0; m < 4; ++m) { bf16_t* rowp = H + (size_t)(row0 + ai * HALF + m * 16) * FFD + hcol0;
#pragma unroll
                for (int bj = 0; bj < 2; ++bj) { const f32x4 v0 = acc[ai][bj][m][0], v1 = acc[ai][bj][m][1];
                    const float h0 = v0[0] * sigmoidf_fast(v0[0]) * v0[1], h1 = v0[2] * sigmoidf_fast(v0[2]) * v0[3], h2 = v1[0] * sigmoidf_fast(v1[0]) * v1[1], h3 = v1[2] * sigmoidf_fast(v1[2]) * v1[3];
                    u32x2 w; w.x = cvt_pk_bf16(h0, h1); w.y = cvt_pk_bf16(h2, h3);
                    *(u32x2*)(rowp + bj * 64) = w; } }
    }
};
struct EpiDown {
    static constexpr bool PERM = true, AFTER_DRAIN = false, DUAL = false, I8 = false, GATHER = false, FP8 = true; typedef f32x4 acc_t;
    static constexpr int F8_SCALE_A = 127 - 3, F8_SCALE_B = 127 - 1;
    bf16_t* Y;
    __device__ __forceinline__ void operator()(const f32x4 (&acc)[2][2][4][2], const Unit& u, int wr, int wc, int fr, int fq) const {
        const int row0 = u.pm * BM + wr * 64 + fr, col0 = u.pn * BM + wc * 32 + 8 * fq;
#pragma unroll
        for (int ai = 0; ai < 2; ++ai)
#pragma unroll
            for (int m = 0; m < 4; ++m) { const int row = row0 + ai * HALF + m * 16; unsigned char* rowp = (unsigned char*)Y + (size_t)row * DM + col0;
#pragma unroll
                for (int bj = 0; bj < 2; ++bj) { const f32x4 v0 = acc[ai][bj][m][0], v1 = acc[ai][bj][m][1];
                    int w0 = f8pk(v0[0], v0[1], 0, false); w0 = f8pk(v0[2], v0[3], w0, true); int w1 = f8pk(v1[0], v1[1], 0, false); w1 = f8pk(v1[2], v1[3], w1, true);
                    u32x2 w; w.x = (unsigned)w0; w.y = (unsigned)w1; *(u32x2*)(rowp + bj * HALF) = w; } }
    }
};
struct EpiProjI8 {
    static constexpr bool PERM = true, AFTER_DRAIN = false, DUAL = false, I8 = true, GATHER = false, FP8 = false; typedef i32x4 acc_t;
    bf16_t* proj; const float* sA; const float* sB;
    static __device__ __forceinline__ unsigned q8(float v) { return (unsigned)__builtin_rintf(sigmoidf_fast(v) * 255.0f); }
    static __device__ __forceinline__ unsigned q8n(float t) { return __float_as_uint(__builtin_amdgcn_rcpf(__builtin_amdgcn_exp2f(t) + 1.0f / 255.0f) + 8388608.0f) & 0xffu; }
    __device__ __forceinline__ void operator()(const i32x4 (&acc)[2][2][4][2], const Unit& u, int wr, int wc, int fr, int fq) const {
        const int row0 = u.pm * BM + wr * 64 + fr; const int pn = u.pn;
        const int bcol0 = pn * BM + wc * 32 + 8 * fq;
        f32x4 sb[2][2];
#pragma unroll
        for (int bj = 0; bj < 2; ++bj)
#pragma unroll
            for (int n = 0; n < 2; ++n) sb[bj][n] = *(const f32x4*)(sB + bcol0 + bj * HALF + 4 * n);
        if (pn >= 2 && pn < 6) {
            bf16_t* base = proj + (size_t)M_TOK * 512; const int col0 = (pn - 2) * 128 + wc * 16 + 4 * fq;
#pragma unroll
            for (int ai = 0; ai < 2; ++ai)
#pragma unroll
                for (int m = 0; m < 4; ++m) { const int row = row0 + ai * HALF + m * 16; const float sa = sA[row]; bf16_t* rowp = base + (size_t)row * 512 + col0;
#pragma unroll
                    for (int bj = 0; bj < 2; ++bj) { const f32x4 v0 = __builtin_convertvector(acc[ai][bj][m][0], f32x4) * sb[bj][0] * sa, v1 = __builtin_convertvector(acc[ai][bj][m][1], f32x4) * sb[bj][1] * sa;
                        u32x2 w; w.x = cvt_pk_bf16(v0[0] * v0[1], v0[2] * v0[3]); w.y = cvt_pk_bf16(v1[0] * v1[1], v1[2] * v1[3]);
                        *(u32x2*)(rowp + bj * 64) = w; } }
        } else if (pn < 12) {
            bf16_t* base = proj + (size_t)(pn >> 1) * ((size_t)M_TOK * 512); const int col0 = (pn & 1) * 256 + wc * 32 + 8 * fq;
#pragma unroll
            for (int ai = 0; ai < 2; ++ai)
#pragma unroll
                for (int m = 0; m < 4; ++m) { const int row = row0 + ai * HALF + m * 16; const float sa = sA[row]; bf16_t* rowp = base + (size_t)row * 512 + col0;
#pragma unroll
                    for (int bj = 0; bj < 2; ++bj) { const f32x4 v0 = __builtin_convertvector(acc[ai][bj][m][0], f32x4) * sb[bj][0] * sa, v1 = __builtin_convertvector(acc[ai][bj][m][1], f32x4) * sb[bj][1] * sa;
                        u32x4 w; w.x = cvt_pk_bf16(v0[0], v0[1]); w.y = cvt_pk_bf16(v0[2], v0[3]); w.z = cvt_pk_bf16(v1[0], v1[1]); w.w = cvt_pk_bf16(v1[2], v1[3]);
                        *(u32x4*)(rowp + bj * HALF) = w; } }
        } else {
            unsigned char* base = (unsigned char*)proj + (size_t)6 * M_TOK * 512 * 2 + (size_t)((pn - 12) >> 2) * ((size_t)M_TOK * 1024 * 2); const int col0 = ((pn - 12) & 3) * 256 + wc * 32 + 8 * fq;
#pragma unroll
            for (int ai = 0; ai < 2; ++ai) { int r0 = row0; asm volatile("" : "+v"(r0));
#pragma unroll
                for (int m = 0; m < 4; ++m) { const int row = r0 + ai * HALF + m * 16; const float sa = sA[row] * (-LOG2E); unsigned char* rowp = base + (size_t)row * 1024 + col0;
#pragma unroll
                    for (int bj = 0; bj < 2; ++bj) { const f32x4 v0 = __builtin_convertvector(acc[ai][bj][m][0], f32x4) * sb[bj][0] * sa - 7.994353436858858f, v1 = __builtin_convertvector(acc[ai][bj][m][1], f32x4) * sb[bj][1] * sa - 7.994353436858858f;
                        u32x2 w; w.x = q8n(v0[0]) | (q8n(v0[1]) << 8) | (q8n(v0[2]) << 16) | (q8n(v0[3]) << 24); w.y = q8n(v1[0]) | (q8n(v1[1]) << 8) | (q8n(v1[2]) << 16) | (q8n(v1[3]) << 24);
                        *(u32x2*)(rowp + bj * HALF) = w; } } }
        }
    }
};
struct EpiGUI8 {
    static constexpr bool PERM = true, AFTER_DRAIN = false, DUAL = false, I8 = true, GATHER = true, FP8 = false; typedef i32x4 acc_t;
    bf16_t* H; const PG8_LAS float* sAtab; const char* sBbase; size_t estride;
    __device__ __forceinline__ void operator()(const i32x4 (&acc)[2][2][4][2], const Unit& u, int wr, int wc, int fr, int fq) const {
        const int rl0 = wr * 64 + fr, row0 = u.pm * BM + rl0, hcol0 = u.pn * 128 + wc * 16 + 4 * fq, bcol0 = u.pn * BM + wc * 32 + 8 * fq;
        const float* sB = (const float*)(sBbase + (size_t)u.pe * estride);
        f32x4 sb[2][2];
#pragma unroll
        for (int bj = 0; bj < 2; ++bj)
#pragma unroll
            for (int n = 0; n < 2; ++n) sb[bj][n] = *(const f32x4*)(sB + bcol0 + bj * HALF + 4 * n);
#pragma unroll
        for (int ai = 0; ai < 2; ++ai)
#pragma unroll
            for (int m = 0; m < 4; ++m) { const int row = row0 + ai * HALF + m * 16; const float sa = sAtab[u.ui * 256 + rl0 + ai * HALF + m * 16]; unsigned char* rowp = (unsigned char*)H + (size_t)row * FFD + hcol0;
                const f32x4 sv = {sa * (-LOG2E), sa * (-8.0f * 0.6931471805599453f), sa * (-LOG2E), sa * (-8.0f * 0.6931471805599453f)};
#pragma unroll
                for (int bj = 0; bj < 2; ++bj) { const f32x4 v0 = __builtin_convertvector(acc[ai][bj][m][0], f32x4) * sb[bj][0] * sv, v1 = __builtin_convertvector(acc[ai][bj][m][1], f32x4) * sb[bj][1] * sv;
                    const float h0 = v0[0] * __builtin_amdgcn_rcpf(1.0f + __builtin_amdgcn_exp2f(v0[0])) * v0[1], h1 = v0[2] * __builtin_amdgcn_rcpf(1.0f + __builtin_amdgcn_exp2f(v0[2])) * v0[3],
                                h2 = v1[0] * __builtin_amdgcn_rcpf(1.0f + __builtin_amdgcn_exp2f(v1[0])) * v1[1], h3 = v1[2] * __builtin_amdgcn_rcpf(1.0f + __builtin_amdgcn_exp2f(v1[2])) * v1[3];
                    int w = f8pk(h0, h1, 0, false); w = f8pk(h2, h3, w, true);
                    *(int*)(rowp + bj * 64) = w; } }
    }
};
template <class Epi, class Sched, bool ALIGN_EPI = false, bool SP2 = false>
__device__ __forceinline__ void gemm_phase(PG8_LAS unsigned char* lds, const Gemm g, const Sched& S, const Epi& E) {
    int tid_ = threadIdx.x; asm volatile("" : "+v"(tid_)); const int tid = tid_, wid = __builtin_amdgcn_readfirstlane(tid >> 6), lane = tid & 63, wr = wid >> 2, wc = wid & 3, fr = lane & 15, fq = lane >> 4;
    const int Kp = Epi::DUAL ? g.K / 2 : g.K  , pitchB = (Epi::I8 || Epi::FP8) ? Kp : 2 * Kp  , nt = ((Epi::I8 || Epi::FP8) ? g.K : 2 * g.K) / 128  , nt1 = Epi::DUAL ? nt / 2 : nt;
    unsigned voffA[2], voffB[2];
#pragma unroll
    for (int i = 0; i < 2; ++i) { int R, C; stage_rc(tid * 16 + i * 8192, R, C); const int Rb = Epi::PERM ? ((R & ~31) + perm32(R & 31)) : R;
        voffA[i] = (unsigned)(R * pitchB + 2 * C); voffB[i] = (unsigned)(Rb * pitchB + 2 * C); }
    const size_t kstep = (size_t)(BK * 2);
    const size_t hstep = (size_t)HALF * pitchB;
    const size_t tstep = 2 * hstep;
    const size_t hstepA = Epi::GATHER ? 0 : hstep;
    const unsigned ldsw = (unsigned)wid * 1024u;
    const int aoff = Epi::FP8 ? lds_byte(wr * 64 + fr, fq * 16) : lds_byte(wr * 64 + fr, fq * 8), boff = Epi::FP8 ? lds_byte(wc * 32 + fr, fq * 16) : lds_byte(wc * 32 + fr, fq * 8);
    constexpr int KSUB = Epi::FP8 ? 16 : 1024;
#define PG8_SA(b, h) (((b) * 2 + (h)) * HTB)
#define PG8_SB(b, h) ((4 + (b) * 2 + (h)) * HTB)
#define PG8_STAGE(bufoff, gbase, voff) do { _Pragma("unroll") for (int _i = 0; _i < 2; ++_i) \
        __builtin_amdgcn_global_load_lds((const unsigned*)((const char*)(gbase) + (voff)[_i]), (PG8_LAS unsigned*)(lds + (bufoff) + ldsw + _i * 8192), 16, 0, 0); } while (0)
#define PG8_LDA(dst, b, h) do { _Pragma("unroll") for (int m = 0; m < 4; ++m) _Pragma("unroll") for (int k = 0; k < 2; ++k) dst[m][k] = *(const PG8_LAS bf16x8*)(lds + PG8_SA(b, h) + aoff + m * 2048 + k * KSUB); } while (0)
#define PG8_LDB(dst, b, h) do { _Pragma("unroll") for (int n = 0; n < 2; ++n) _Pragma("unroll") for (int k = 0; k < 2; ++k) dst[n][k] = *(const PG8_LAS bf16x8*)(lds + PG8_SB(b, h) + boff + n * 2048 + k * KSUB); } while (0)
#define PG8_MMA(ai, bj, At, Bt) do { __builtin_amdgcn_s_setprio(1); _Pragma("unroll") for (int m = 0; m < 4; ++m) _Pragma("unroll") for (int n = 0; n < 2; ++n) _Pragma("unroll") for (int k = 0; k < 2; ++k) \
        { if constexpr (Epi::FP8) { if (k == 0) acc[ai][bj][m][n] = mma_f8<Epi::F8_SCALE_B, Epi::F8_SCALE_A>(Bt[n][0], Bt[n][1], At[m][0], At[m][1], acc[ai][bj][m][n]); } else acc[ai][bj][m][n] = mma16(Bt[n][k], At[m][k], acc[ai][bj][m][n]); } __builtin_amdgcn_s_setprio(0); } while (0)
#define PG8_WAIT_V(n) asm volatile("s_waitcnt vmcnt(" #n ")" ::: "memory")
#define PG8_WAIT_L(n) asm volatile("s_waitcnt lgkmcnt(" #n ")" ::: "memory")
#define PG8_BAR __builtin_amdgcn_s_barrier()
#define PG8_SCHED __builtin_amdgcn_sched_barrier(0)
    Unit cur, nxt; int ui = 0;
    if (!S.next(0, cur)) return;
    typename Epi::acc_t acc[2][2][4][2];
#pragma unroll
    for (int a = 0; a < 2; ++a)
#pragma unroll
        for (int b = 0; b < 2; ++b)
#pragma unroll
            for (int m = 0; m < 4; ++m)
#pragma unroll
                for (int n = 0; n < 2; ++n) acc[a][b][m][n] = typename Epi::acc_t{};
    bf16x8 At[4][2], B0[2][2], B1[2][2];
    int gR[2], gC[2];
#pragma unroll
    for (int i = 0; i < 2; ++i) stage_rc(tid * 16 + i * 8192, gR[i], gC[i]);
    unsigned vA0[2], vA1[2], nA0[2], nA1[2];
#pragma unroll
    for (int i = 0; i < 2; ++i) { if constexpr (Epi::GATHER) { vA0[i] = (unsigned)(g.rowtab[cur.ui * 256 + gR[i]] * pitchB + 2 * gC[i]); vA1[i] = (unsigned)(g.rowtab[cur.ui * 256 + 128 + gR[i]] * pitchB + 2 * gC[i]); } else { vA0[i] = voffA[i]; vA1[i] = voffA[i]; } nA0[i] = vA0[i]; nA1[i] = vA1[i]; }
    const char* cA = Epi::GATHER ? (const char*)g.A : (const char*)g.A + (size_t)cur.pm * tstep; const char* cB = (const char*)g.Bt + (size_t)cur.pe * g.estride + (size_t)cur.pn * tstep;
    const char* cA2 = Epi::DUAL ? (const char*)g.A2 + (size_t)cur.pm * tstep : cA; const char* cB2 = Epi::DUAL ? (const char*)g.Bt2 + (size_t)cur.pn * tstep : cB;
    S.a_ready(cur);
    if constexpr (SP2) {
        PG8_STAGE(PG8_SB(0, 0), cB, voffB); PG8_STAGE(PG8_SB(0, 1), cB + hstep, voffB); PG8_STAGE(PG8_SA(0, 0), cA, vA0); PG8_STAGE(PG8_SA(0, 1), cA + hstepA, vA1);
        if (wr == 1) PG8_BAR;
        PG8_WAIT_V(2); PG8_BAR;
        PG8_STAGE(PG8_SB(1, 0), cB + kstep, voffB); PG8_STAGE(PG8_SA(1, 0), cA + kstep, vA0); PG8_STAGE(PG8_SB(1, 1), cB + hstep + kstep, voffB);
        PG8_WAIT_V(6); PG8_BAR;
    } else {
        PG8_STAGE(PG8_SB(0, 0), cB, voffB); PG8_STAGE(PG8_SA(0, 0), cA, vA0); PG8_STAGE(PG8_SB(0, 1), cB + hstep, voffB); PG8_STAGE(PG8_SA(0, 1), cA + hstepA, vA1);
        if (wr == 1) PG8_BAR;
        PG8_WAIT_V(4); PG8_BAR;
        PG8_STAGE(PG8_SB(1, 0), cB + kstep, voffB); PG8_STAGE(PG8_SA(1, 0), cA + kstep, vA0); PG8_STAGE(PG8_SB(1, 1), cB + hstep + kstep, voffB);
        PG8_WAIT_V(6); PG8_BAR;
    }
    for (;;) {
        const bool has_next = S.next(ui + 1, nxt);
        if constexpr (Epi::GATHER) { if (has_next) {
#pragma unroll
            for (int i = 0; i < 2; ++i) { nA0[i] = (unsigned)(g.rowtab[nxt.ui * 256 + gR[i]] * pitchB + 2 * gC[i]); nA1[i] = (unsigned)(g.rowtab[nxt.ui * 256 + 128 + gR[i]] * pitchB + 2 * gC[i]); } } }
        const char* nA = Epi::GATHER ? cA : (has_next ? (const char*)g.A + (size_t)nxt.pm * tstep : cA); const char* nB = has_next ? (const char*)g.Bt + (size_t)nxt.pe * g.estride + (size_t)nxt.pn * tstep : cB;
        for (int t = 0; t < nt; t += 2) {
            const bool last = (t == nt - 2);
            if constexpr (Epi::DUAL) { if (t == nt1) E.mid(acc, cur, wr, wc, fr, fq); }
            const char* a1 = (t < nt1) ? cA + (size_t)(t + 1) * kstep : cA2 + (size_t)(t + 1 - nt1) * kstep;
            const char* a2 = last ? nA : ((t + 2 < nt1) ? cA + (size_t)(t + 2) * kstep : cA2 + (size_t)(t + 2 - nt1) * kstep); const char* b2 = last ? nB : ((t + 2 < nt1) ? cB + (size_t)(t + 2) * kstep : cB2 + (size_t)(t + 2 - nt1) * kstep);
            const char* a3 = a2 + kstep; const char* b3 = b2 + kstep;
            unsigned wA0[2], wA1[2];
#pragma unroll
            for (int i = 0; i < 2; ++i) { wA0[i] = (Epi::GATHER && last) ? nA0[i] : vA0[i]; wA1[i] = (Epi::GATHER && last) ? nA1[i] : vA1[i]; }
            if (last && has_next) S.a_ready(nxt);
            if constexpr (SP2) {
            PG8_LDB(B0, 0, 0); PG8_LDB(B1, 0, 1); PG8_SCHED; PG8_LDA(At, 0, 0); PG8_STAGE(PG8_SA(1, 1), a1 + hstepA, vA1);
            PG8_WAIT_V(8); PG8_WAIT_L(0); PG8_BAR; PG8_MMA(0, 0, At, B0); PG8_MMA(0, 1, At, B1); PG8_BAR; PG8_SCHED;
            PG8_LDA(At, 0, 1); PG8_STAGE(PG8_SB(0, 0), b2, voffB); PG8_STAGE(PG8_SB(0, 1), b2 + hstep, voffB); PG8_STAGE(PG8_SA(0, 0), a2, wA0);
            PG8_WAIT_V(8); PG8_WAIT_L(0); PG8_BAR; PG8_MMA(1, 0, At, B0); PG8_MMA(1, 1, At, B1); PG8_BAR; PG8_SCHED;
            PG8_LDB(B0, 1, 0); PG8_LDB(B1, 1, 1); PG8_SCHED; PG8_LDA(At, 1, 0); PG8_STAGE(PG8_SA(0, 1), a2 + hstepA, wA1);
            PG8_WAIT_V(8); PG8_WAIT_L(0); PG8_BAR; PG8_MMA(0, 0, At, B0); PG8_MMA(0, 1, At, B1); PG8_BAR; PG8_SCHED;
            PG8_LDA(At, 1, 1); PG8_STAGE(PG8_SB(1, 0), b3, voffB); PG8_STAGE(PG8_SB(1, 1), b3 + hstep, voffB); PG8_STAGE(PG8_SA(1, 0), a3, wA0);
            PG8_WAIT_V(8); PG8_WAIT_L(0); PG8_BAR; PG8_MMA(1, 0, At, B0); PG8_MMA(1, 1, At, B1); PG8_BAR; PG8_SCHED;
            } else {
            PG8_LDB(B0, 0, 0); PG8_SCHED; PG8_LDA(At, 0, 0); PG8_STAGE(PG8_SA(1, 1), a1 + hstepA, vA1);
            PG8_WAIT_L(8); PG8_BAR; PG8_WAIT_L(0); PG8_MMA(0, 0, At, B0); PG8_BAR; PG8_SCHED;
            PG8_LDB(B1, 0, 1); PG8_STAGE(PG8_SB(0, 0), b2, voffB);
            PG8_BAR; PG8_WAIT_L(0); PG8_MMA(0, 1, At, B1); PG8_BAR;
            PG8_LDA(At, 0, 1); PG8_STAGE(PG8_SA(0, 0), a2, wA0);
            PG8_BAR; PG8_WAIT_L(0); PG8_MMA(1, 0, At, B0); PG8_BAR; PG8_SCHED;
            PG8_STAGE(PG8_SB(0, 1), b2 + hstep, voffB);
            PG8_WAIT_V(6); PG8_BAR; PG8_MMA(1, 1, At, B1); PG8_BAR;
            PG8_LDB(B0, 1, 0); PG8_SCHED; PG8_LDA(At, 1, 0); PG8_STAGE(PG8_SA(0, 1), a2 + hstepA, wA1);
            PG8_WAIT_L(8); PG8_BAR; PG8_WAIT_L(0); PG8_MMA(0, 0, At, B0); PG8_BAR; PG8_SCHED;
            PG8_LDB(B1, 1, 1); PG8_STAGE(PG8_SB(1, 0), b3, voffB);
            PG8_BAR; PG8_WAIT_L(0); PG8_MMA(0, 1, At, B1); PG8_BAR;
            PG8_LDA(At, 1, 1); PG8_STAGE(PG8_SA(1, 0), a3, wA0);
            PG8_BAR; PG8_WAIT_L(0); PG8_MMA(1, 0, At, B0); PG8_BAR; PG8_SCHED;
            PG8_STAGE(PG8_SB(1, 1), b3 + hstep, voffB);
            PG8_WAIT_V(6); PG8_BAR; PG8_MMA(1, 1, At, B1); PG8_BAR;
            }
        }
        if constexpr (ALIGN_EPI) { if (wr == 0) PG8_BAR; }
        if constexpr (Epi::FP8) asm volatile("s_nop 15\n\ts_nop 15" ::: "memory");
        if constexpr (!Epi::AFTER_DRAIN) { E(acc, cur, wr, wc, fr, fq); S.done(cur); }
        if (!has_next) break;
#pragma unroll
        for (int a = 0; a < 2; ++a)
#pragma unroll
            for (int b = 0; b < 2; ++b)
#pragma unroll
                for (int m = 0; m < 4; ++m)
#pragma unroll
                    for (int n = 0; n < 2; ++n) acc[a][b][m][n] = typename Epi::acc_t{};
        cur = nxt; cA = nA; cB = nB; ++ui;
#pragma unroll
        for (int i = 0; i < 2; ++i) { vA0[i] = nA0[i]; vA1[i] = nA1[i]; }
        if constexpr (Epi::DUAL) { cA2 = (const char*)g.A2 + (size_t)cur.pm * tstep; cB2 = (const char*)g.Bt2 + (size_t)cur.pn * tstep; }
        if constexpr (ALIGN_EPI) { if (wr == 1) PG8_BAR; }
    }
    PG8_WAIT_V(0);
    if constexpr (!ALIGN_EPI) { if (wr == 0) PG8_BAR; }
    PG8_BAR;
    if constexpr (Epi::AFTER_DRAIN) { E.fused(acc, cur, wr, wc, fr, fq, lds, wid, lane); S.done(cur); }
#undef PG8_SA
#undef PG8_SB
#undef PG8_STAGE
#undef PG8_LDA
#undef PG8_LDB
#undef PG8_MMA
#undef PG8_WAIT_V
#undef PG8_WAIT_L
#undef PG8_BAR
#undef PG8_SCHED
}
}

namespace sba {
using bf16x8 = __attribute__((ext_vector_type(8))) short;
using s16x4 = __attribute__((ext_vector_type(4))) short;
using f32x16 = __attribute__((ext_vector_type(16))) float;
typedef unsigned short bf16_t;
constexpr int PITCH = 512, QB = 256, KVBLK = 64, SLOTB = 8192;
constexpr int LDS_FLAGS = 8 * SLOTB, LDS_BYTES = 8 * SLOTB + 64;
constexpr float R_DONE = -40.0f;
typedef __attribute__((address_space(3))) const char* lds_cptr;
typedef short v4i16_t __attribute__((ext_vector_type(4)));
#define SBA_MFMA(a, b, c) __builtin_amdgcn_mfma_f32_32x32x16_bf16(a, b, c, 0, 0, 0)
__device__ __forceinline__ int crow(int r, int hi) { return (r & 3) + 8 * (r >> 2) + 4 * hi; }
__device__ __forceinline__ void glds16(const void* gsrc, unsigned lds_dst) { unsigned keep;
    asm volatile("s_mov_b32 %0, m0\n\ts_mov_b32 m0, %2\n\ts_nop 0\n\tglobal_load_lds_dwordx4 %1, off\n\ts_mov_b32 m0, %0" : "=&s"(keep) : "v"(gsrc), "s"(lds_dst) : "memory"); }
typedef float f32x2_t __attribute__((ext_vector_type(2))); typedef __bf16 bf16x2_t __attribute__((ext_vector_type(2)));
__device__ __forceinline__ unsigned cvtpk(float lo, float hi) { f32x2_t v = {lo, hi}; bf16x2_t b = __builtin_convertvector(v, bf16x2_t); return __builtin_bit_cast(unsigned, b); }
__device__ __forceinline__ s16x4 vtr(lds_cptr p) { return __builtin_bit_cast(s16x4, __builtin_amdgcn_ds_read_tr16_b64_v4i16((__attribute__((address_space(3))) v4i16_t*)p)); }
__device__ __forceinline__ bf16x8 pack8(const f32x16& v, int b0) {
    typedef unsigned u32x4 __attribute__((ext_vector_type(4)));
    u32x4 w; w.x = cvtpk(v[b0], v[b0 + 1]); w.y = cvtpk(v[b0 + 2], v[b0 + 3]); w.z = cvtpk(v[b0 + 4], v[b0 + 5]); w.w = cvtpk(v[b0 + 6], v[b0 + 7]); return __builtin_bit_cast(bf16x8, w); }

__device__ __forceinline__ float vmin(float a, float b) { return __builtin_amdgcn_fmed3f(a, -3.0e38f, b); }
template <bool DIAG> __device__ __forceinline__ void tile(f32x16 (&o)[2], f32x16& R, const bf16x8 (&qr)[4], const bf16x8 (&tri)[2], const bf16x8 ones, lds_cptr kp, lds_cptr vp, int qrel, int hi) {
    f32x16 z0 = {}, z1 = {};
#pragma unroll
    for (int d0 = 0; d0 < 4; ++d0) {
        const bf16x8 k0 = *(const __attribute__((address_space(3))) bf16x8*)(kp + d0 * 2048);
        const bf16x8 k1 = *(const __attribute__((address_space(3))) bf16x8*)(kp + d0 * 2048 + 512);
        z0 = SBA_MFMA(k0, qr[d0], z0); z1 = SBA_MFMA(k1, qr[d0], z1); }
    f32x16 sp;
#pragma unroll
    for (int r = 0; r < 16; ++r) { const float zc = vmin(z1[r], 126.0f); float s = __builtin_amdgcn_logf(1.0f + __builtin_amdgcn_exp2f(zc));
        if (DIAG) { if (!(32 + crow(r, hi) < qrel)) s = 0.f; }
        sp[r] = s; z1[r] = (zc - s) + R[r]; }
    const bf16x8 x1a = pack8(sp, 0), x1b = pack8(sp, 8);
    f32x16 S = SBA_MFMA(ones, x1a, R); S = SBA_MFMA(ones, x1b, S);
    z1 = SBA_MFMA(tri[0], x1a, z1); z1 = SBA_MFMA(tri[1], x1b, z1);
#pragma unroll
    for (int r = 0; r < 16; ++r) { const float zc = vmin(z0[r], 126.0f); float s = __builtin_amdgcn_logf(1.0f + __builtin_amdgcn_exp2f(zc));
        if (DIAG) { if (!(crow(r, hi) < qrel)) s = 0.f; }
        sp[r] = s; z0[r] = (zc - s) + S[r]; }
    const bf16x8 x0a = pack8(sp, 0), x0b = pack8(sp, 8);
    z0 = SBA_MFMA(tri[0], x0a, z0); z0 = SBA_MFMA(tri[1], x0b, z0);
    R = SBA_MFMA(ones, x0a, S); R = SBA_MFMA(ones, x0b, R);
#pragma unroll
    for (int r = 0; r < 16; ++r) { float a0 = __builtin_amdgcn_exp2f(z0[r]), a1 = __builtin_amdgcn_exp2f(z1[r]);
        if (DIAG) { if (!(crow(r, hi) < qrel)) a0 = 0.f; if (!(32 + crow(r, hi) < qrel)) a1 = 0.f; }
        z0[r] = a0; z1[r] = a1; }
    const bf16x8 p0 = pack8(z0, 0), p1 = pack8(z0, 8), p2 = pack8(z1, 0), p3 = pack8(z1, 8);
#pragma unroll
    for (int d0 = 0; d0 < 2; ++d0) {
        s16x4 lo[4], hh[4];
#pragma unroll
        for (int ks = 0; ks < 4; ++ks) { lo[ks] = vtr(vp + d0 * 4096 + ks * 1024); hh[ks] = vtr(vp + d0 * 4096 + ks * 1024 + 512); }
#define SBA_PK(k) (bf16x8){lo[k][0], lo[k][1], lo[k][2], lo[k][3], hh[k][0], hh[k][1], hh[k][2], hh[k][3]}
        o[d0] = SBA_MFMA(p0, SBA_PK(0), o[d0]); o[d0] = SBA_MFMA(p1, SBA_PK(1), o[d0]); o[d0] = SBA_MFMA(p2, SBA_PK(2), o[d0]); o[d0] = SBA_MFMA(p3, SBA_PK(3), o[d0]);
#undef SBA_PK
    }
}

#define SBA_WAIT_BAR() asm volatile("s_waitcnt vmcnt(0) lgkmcnt(0)\n\ts_barrier" ::: "memory")
__device__ __forceinline__ void attn_unit(int b, int h, int qb, const bf16_t* Q, const bf16_t* K, const bf16_t* V, bf16_t* O, char* shm) {
    int tid_ = threadIdx.x; asm volatile("" : "+v"(tid_)); const int tid = tid_, lane = tid & 63, r32 = lane & 31, hi = lane >> 5; const int wid = __builtin_amdgcn_readfirstlane(tid >> 6);
    const int grp = wid >> 2, w4 = wid & 3, rb = grp ? (w4 ^ 2) : w4;
    const long rowbase = (long)b * SEQ; const int q0 = qb * QB + grp * 128;
    const bf16_t* Qw = Q + (rowbase + q0 + rb * 32) * PITCH + h * HDIM;
    const bf16_t* Kh = K + rowbase * PITCH + h * HDIM; const bf16_t* Vh = V + rowbase * PITCH + h * HDIM;
    const unsigned lds0 = (unsigned)(uintptr_t)shm + (unsigned)grp * (4 * SLOTB);
    const bf16_t* ksrc0 = Kh + (long)lane * PITCH + (2 * w4) * 8; const bf16_t* ksrc1 = ksrc0 + 8;
    const int p0 = 2 * w4, p1 = 2 * w4 + 1;
    const bf16_t* vsrc0 = Vh + (long)(16 * (p0 & 3) + (lane >> 2)) * PITCH + (p0 >> 2) * 32 + (lane & 3) * 8;
    const bf16_t* vsrc1 = Vh + (long)(16 * (p1 & 3) + (lane >> 2)) * PITCH + (p1 >> 2) * 32 + (lane & 3) * 8;
    const unsigned kdst = lds0 + p0 * 1024, vdst = lds0 + 2 * SLOTB + p0 * 1024;
#define SBA_DMA(t, slot) do { const long go_ = (long)(t) * KVBLK * PITCH; \
        glds16(ksrc0 + go_, (unsigned)__builtin_amdgcn_readfirstlane(kdst + (slot))); glds16(ksrc1 + go_, (unsigned)__builtin_amdgcn_readfirstlane(kdst + 1024 + (slot))); \
        glds16(vsrc0 + go_, (unsigned)__builtin_amdgcn_readfirstlane(vdst + (slot))); glds16(vsrc1 + go_, (unsigned)__builtin_amdgcn_readfirstlane(vdst + 1024 + (slot))); } while (0)
    const lds_cptr shm3 = (lds_cptr)shm + grp * (4 * SLOTB);
    const lds_cptr kp0 = shm3 + hi * 1024 + r32 * 16;
    const lds_cptr vp0 = shm3 + 2 * SLOTB + ((lane >> 4) & 1) * 32 + (lane & 3) * 8 + (4 * hi + ((lane & 15) >> 2)) * 64;
    volatile __attribute__((address_space(3))) unsigned* flags = (volatile __attribute__((address_space(3))) unsigned*)((lds_cptr)shm + LDS_FLAGS);
    const int jtop = (q0 + 128) / KVBLK - 1, jd = q0 / KVBLK + (rb >> 1), qrel = 32 * (rb & 1) + r32;
    SBA_DMA(jtop, 0);
    bf16x8 qr[4];
#pragma unroll
    for (int d0 = 0; d0 < 4; ++d0) qr[d0] = *reinterpret_cast<const bf16x8*>(&Qw[(long)r32 * PITCH + d0 * 16 + hi * 8]);
    bf16x8 tri[2]; bf16x8 ones;
#pragma unroll
    for (int s = 0; s < 2; ++s)
#pragma unroll
        for (int j = 0; j < 8; ++j) tri[s][j] = ((16 * s + 8 * (j >> 2) + 4 * hi + (j & 3)) > r32) ? (short)0xBF80 : (short)0;
#pragma unroll
    for (int j = 0; j < 8; ++j) ones[j] = (short)0xBF80;
    f32x16 o[2]; o[0] = f32x16{}; o[1] = f32x16{}; f32x16 R = f32x16{};
    bool mydone = false;
    const int nsteps = (qb * QB + QB) / KVBLK;
    for (int it = 0; it < nsteps; ++it) {
        const int j = jtop - it;
        SBA_WAIT_BAR();
        if (it > 0) { const int pf = ((it - 1) & 1) * 8; unsigned all = 1u;
#pragma unroll
            for (int w = 0; w < 8; ++w) all &= flags[pf + w];
            if (__builtin_amdgcn_readfirstlane(all)) break; }
        const int cur = (it & 1) * SLOTB, oth = SLOTB - cur;
        if (j > 0) SBA_DMA(j - 1, oth);
        if (!mydone && j >= 0 && j <= jd) {
            if (j == jd) tile<true>(o, R, qr, tri, ones, kp0 + cur, vp0 + cur, qrel, hi);
            else tile<false>(o, R, qr, tri, ones, kp0 + cur, vp0 + cur, qrel, hi);
            mydone = __all(R[0] < R_DONE) != 0;
        }
        if (lane == 0) flags[(it & 1) * 8 + wid] = (mydone || j <= 0) ? 1u : 0u;
    }
    SBA_WAIT_BAR();
    unsigned char* Ow = (unsigned char*)O + (rowbase + q0 + rb * 32) * ATT_W + h * HDIM;
#pragma unroll
    for (int r = 0; r < 16; ++r) { const int orow = crow(r, hi);
#pragma unroll
        for (int d0 = 0; d0 < 2; ++d0) { const int w = pg8::f8pk(o[d0][r] * 2.0f, 0.f, 0, false); Ow[(long)orow * ATT_W + d0 * 32 + r32] = (unsigned char)(w & 0xff); } }
#undef SBA_DMA
}
#undef SBA_WAIT_BAR
#undef SBA_MFMA
}


constexpr size_t MiB = 1u << 20, KiB = 1u << 10;
constexpr size_t WS_CTL = 0, CTL_ZERO_BYTES = 64 * KiB;
constexpr size_t WS_TAB = 1 * MiB;
constexpr size_t TB_MOD = WS_TAB;
constexpr size_t TB_HIST = WS_TAB + 192 * KiB;
constexpr size_t TB_TILE = WS_TAB + 208 * KiB;
constexpr size_t TB_EIDX = WS_TAB + 256 * KiB;
constexpr size_t TB_GATE = WS_TAB + 512 * KiB;
constexpr size_t TB_SLOT = WS_TAB + 768 * KiB;
constexpr size_t TB_WRS = WS_TAB + 1024 * KiB;
constexpr int WR_PITCH = 1032;
constexpr size_t TB_STAMP = WS_TAB + 1400 * KiB;
constexpr size_t TB_PAR = WS_TAB + 1408 * KiB;
constexpr int PAR_WCONV = 0, PAR_LN1G = PAR_WCONV + DEPTH * 3 * CONV_CH, PAR_LN1B = PAR_LN1G + DEPTH * DM, PAR_LN2G = PAR_LN1B + DEPTH * DM, PAR_LN2B = PAR_LN2G + DEPTH * DM,
              PAR_BR = PAR_LN2B + DEPTH * DM, PAR_WR = PAR_BR + NEXP, PAR_TOTAL = PAR_WR + DM * NEXP;
static_assert(TB_PAR + (size_t)PAR_TOTAL * 4 <= 3 * MiB, "tables");
constexpr size_t WS_W = 3 * MiB;
constexpr size_t W_IN = WS_W, W_IN_L = (size_t)IN_W * DM * 2;
constexpr size_t W_A = W_IN + DEPTH * W_IN_L, W_A_L = (size_t)DM * CONV_CH * 2;
constexpr size_t W_B = W_A + DEPTH * W_A_L, W_B_L = W_A_L;
constexpr size_t W_O = W_B + DEPTH * W_B_L, W_O_L = (size_t)DM * DM * 2;
constexpr size_t W_GU = W_O + DEPTH * W_O_L, W_GU_E = (size_t)2 * FFD * DM * 2;
constexpr size_t W_DN = W_GU + (size_t)DEPTH * NEXP * W_GU_E, W_DN_E = (size_t)DM * FFD * 2;
constexpr size_t W_IN_SC = 6 * MiB;
constexpr size_t W_GU_SC = 1 * MiB + 64 * KiB;
constexpr size_t ACT_SU = 33 * MiB;
constexpr size_t ACT_LIST = 34 * MiB;
constexpr size_t WS_ACT = W_DN + (size_t)DEPTH * NEXP * W_DN_E;
constexpr size_t WS_PROJ = WS_ACT + (size_t)M_TOK * DM * 2;
constexpr size_t PJ_T512 = (size_t)M_TOK * 512 * 2, PJ_GA = 6 * PJ_T512, PJ_GB = PJ_GA + (size_t)M_TOK * DM * 2;
constexpr size_t PJ_XS = 0, PJ_HS = (size_t)PMAX * DM * 2;
constexpr size_t PJ_SXS = 69 * MiB;
constexpr size_t WS_END = WS_PROJ + (size_t)M_TOK * IN_W * 2;
static_assert(WS_ACT == 127 * MiB && WS_END == 511 * MiB, "d_ws map");
static_assert(PJ_HS + (size_t)PMAX * FFD * 2 <= (size_t)M_TOK * IN_W * 2, "MoE overlay fits the proj region");
constexpr int CW_BAR = 4096;
constexpr int CW_GCNT = 1024;

constexpr int RING_OFF = 0, RING_BYTES = 131072;
constexpr int LDSCTL_OFF = RING_BYTES, MISC_OFF = LDSCTL_OFF + 320;
constexpr int GTAB_OFF = RING_BYTES + 1024;
constexpr int LDS_BYTES = 149504;
static_assert(MISC_OFF + 128 <= GTAB_OFF && GTAB_OFF + 8 * 2048 <= LDS_BYTES, "LDS map");

#define GAS __attribute__((address_space(1)))
#define LAS __attribute__((address_space(3)))
typedef unsigned short bf16;
typedef unsigned v4u __attribute__((ext_vector_type(4)));
typedef unsigned v2u __attribute__((ext_vector_type(2)));
typedef float f32x4 __attribute__((ext_vector_type(4)));
typedef GAS unsigned gu32;
#define RLX_AGENT __ATOMIC_RELAXED, __HIP_MEMORY_SCOPE_AGENT
#define LDS_WAIT() asm volatile("s_waitcnt lgkmcnt(0)" ::: "memory")
#define VM_WAIT() asm volatile("s_waitcnt vmcnt(0)" ::: "memory")
__device__ __forceinline__ unsigned f2bf(float f) { unsigned u = __builtin_bit_cast(unsigned, f); return (u + 0x7fffu + ((u >> 16) & 1u)) >> 16; }
typedef float f32x2_r __attribute__((ext_vector_type(2))); typedef __bf16 bf16x2_r __attribute__((ext_vector_type(2)));
__device__ __forceinline__ unsigned pk2(float lo, float hi) { f32x2_r v = {lo, hi}; return __builtin_bit_cast(unsigned, __builtin_convertvector(v, bf16x2_r)); }
__device__ __forceinline__ float bflo(unsigned w) { return __uint_as_float(w << 16); }
__device__ __forceinline__ float bfhi(unsigned w) { return __uint_as_float(w & 0xffff0000u); }


#define XB_TMO      128
#define XB_XCNT(j)  (256  + 64 * (j))
#define XB_XSUB(j)  (1280 + 64 * (j))
#define XB_XGEN(j)  (2304 + 64 * (j))
#define XB_TOP      3328
#define XB_TOPGEN   3392
#define XCD_BAR_WORDS 3456
#define XB_SPIN_CAP (1u << 18)

__device__ __forceinline__ unsigned xb_ld(unsigned* p)              { return __hip_atomic_load(p, __ATOMIC_RELAXED, __HIP_MEMORY_SCOPE_AGENT); }
__device__ __forceinline__ unsigned xb_add(unsigned* p, unsigned v) { return __hip_atomic_fetch_add(p, v, __ATOMIC_RELAXED, __HIP_MEMORY_SCOPE_AGENT); }
__device__ __forceinline__ unsigned xb_xcc_id() { return (unsigned)__builtin_amdgcn_s_getreg((3 << 11) | 20) & 0xFu; }
#define XB_SPIN(cond, bar) do { unsigned _sp = 0; while (cond) { __builtin_amdgcn_s_sleep(1); \
    if ((++_sp & 255u) == 0u) { if (xb_ld(&(bar)[XB_TMO])) break; if (_sp > XB_SPIN_CAP) { atomicAdd(&(bar)[XB_TMO], 1u); break; } } } } while (0)

struct XcdBarrier {
    unsigned* bar; unsigned x;
    volatile LAS unsigned* st;
};

__device__ __forceinline__ XcdBarrier xcd_barrier_post(unsigned* bar, volatile LAS unsigned* st) {
    XcdBarrier b; b.bar = bar; b.x = xb_xcc_id(); b.st = st;
    if (threadIdx.x == 0) (void)xb_add(&bar[XB_XCNT(b.x)], 1u);
    return b;
}
__device__ __forceinline__ void xcd_barrier_complete(unsigned* bar, unsigned x, unsigned& nloc, unsigned& nx) {
    const unsigned G = gridDim.x * gridDim.y * gridDim.z;
    unsigned sum, cnt, mine, sp = 0u;
    for (;;) {
        sum = 0u; cnt = 0u; mine = 0u;
#pragma unroll
        for (unsigned j = 0; j < 16; ++j) { const unsigned c = xb_ld(&bar[XB_XCNT(j)]); sum += c; cnt += (c > 0u) ? 1u : 0u; mine = (j == x) ? c : mine; }
        if (sum == G) break;
        __builtin_amdgcn_s_sleep(1);
        if ((++sp & 255u) == 0u) { if (xb_ld(&bar[XB_TMO])) break; if (sp > XB_SPIN_CAP) { atomicAdd(&bar[XB_TMO], 1u); break; } }
    }
    nloc = mine > 0u ? mine : 1u; nx = cnt > 0u ? cnt : 1u;
}

__device__ __forceinline__ void xcd_barrier(const XcdBarrier& b) {
    asm volatile("s_waitcnt vmcnt(0)" ::: "memory");
    __syncthreads();
    if (threadIdx.x == 0) {
        unsigned* bar = b.bar;
        __builtin_amdgcn_s_waitcnt(0);
        unsigned nloc = b.st[0], nx = b.st[1];
        if (nloc == 0u) { xcd_barrier_complete(bar, b.x, nloc, nx); b.st[0] = nloc; b.st[1] = nx; }
        const unsigned old = xb_add(&bar[XB_XSUB(b.x)], 1u);
        const unsigned gen = old / nloc;
        if (old + 1u == (gen + 1u) * nloc) {
            __builtin_amdgcn_fence(__ATOMIC_RELEASE, "agent");
            asm volatile("s_waitcnt vmcnt(0)" ::: "memory");
            const unsigned og = xb_add(&bar[XB_TOP], 1u);
            const unsigned tg = og / nx;
            if (og + 1u == (tg + 1u) * nx) xb_add(&bar[XB_TOPGEN], 1u);
            else XB_SPIN(xb_ld(&bar[XB_TOPGEN]) == tg, bar);
            __builtin_amdgcn_fence(__ATOMIC_ACQUIRE, "agent");
            xb_add(&bar[XB_XGEN(b.x)], 1u);
            asm volatile("s_waitcnt vmcnt(0)" ::: "memory");
        } else {
            XB_SPIN(xb_ld(&bar[XB_XGEN(b.x)]) == gen, bar);
            __builtin_amdgcn_fence(__ATOMIC_ACQUIRE, "agent");
            asm volatile("s_waitcnt vmcnt(0)" ::: "memory");
        }
    }
    __syncthreads();
}

#ifndef MK_PROBE
#define MK_PROBE 0
#endif
#ifndef MK_STAGGER
#define MK_STAGGER 0
#endif
#ifndef MK_DRY
#define MK_DRY 0
#endif
#ifndef MK_WGM_IN
#define MK_WGM_IN 2
#define MK_WGM_SQ 2
#endif
#ifndef MK_XBAR
#define MK_XBAR 0
#endif
#ifndef MK_REP_MASK
#define MK_REP_MASK 0
#define MK_REP_N 0
#endif
#ifndef MK_PA
#define MK_PA 0
#define MK_PB 0
#define MK_TMAX 1000
#endif

struct Frame {
    LAS unsigned char* lds;
    volatile LAS unsigned* MISC;
    gu32* ctl;
    unsigned char* ws;
    const float* x; float* out;
    int tid, lane, wave;
    int vcu, G;
};
struct Args { const float* in[18]; float* out; unsigned char* ws; int ph_lo, ph_hi; };

__device__ __forceinline__ float wave_sum(float v) {
    v += __builtin_bit_cast(float, __builtin_amdgcn_mov_dpp(__builtin_bit_cast(int, v), 0xB1, 0xf, 0xf, true));
    v += __builtin_bit_cast(float, __builtin_amdgcn_mov_dpp(__builtin_bit_cast(int, v), 0x4E, 0xf, 0xf, true));
    v += __builtin_bit_cast(float, __builtin_amdgcn_mov_dpp(__builtin_bit_cast(int, v), 0x141, 0xf, 0xf, true));
    v += __builtin_bit_cast(float, __builtin_amdgcn_mov_dpp(__builtin_bit_cast(int, v), 0x140, 0xf, 0xf, true));
    { auto r = __builtin_amdgcn_permlane16_swap(__float_as_uint(v), __float_as_uint(v), false, false); v = __uint_as_float(r[0]) + __uint_as_float(r[1]); }
    { auto r = __builtin_amdgcn_permlane32_swap(__float_as_uint(v), __float_as_uint(v), false, false); v = __uint_as_float(r[0]) + __uint_as_float(r[1]); }
    return v;
}

__device__ __forceinline__ float wave_max(float v) {
    v = fmaxf(v, __builtin_bit_cast(float, __builtin_amdgcn_mov_dpp(__builtin_bit_cast(int, v), 0xB1, 0xf, 0xf, true)));
    v = fmaxf(v, __builtin_bit_cast(float, __builtin_amdgcn_mov_dpp(__builtin_bit_cast(int, v), 0x4E, 0xf, 0xf, true)));
    v = fmaxf(v, __builtin_bit_cast(float, __builtin_amdgcn_mov_dpp(__builtin_bit_cast(int, v), 0x141, 0xf, 0xf, true)));
    v = fmaxf(v, __builtin_bit_cast(float, __builtin_amdgcn_mov_dpp(__builtin_bit_cast(int, v), 0x140, 0xf, 0xf, true)));
    { auto r = __builtin_amdgcn_permlane16_swap(__float_as_uint(v), __float_as_uint(v), false, false); v = fmaxf(__uint_as_float(r[0]), __uint_as_float(r[1])); }
    { auto r = __builtin_amdgcn_permlane32_swap(__float_as_uint(v), __float_as_uint(v), false, false); v = fmaxf(__uint_as_float(r[0]), __uint_as_float(r[1])); }
    return v;
}
__device__ __forceinline__ unsigned pk4i8(float a, float b, float c, float d) { return ((unsigned)(int)a & 0xffu) | (((unsigned)(int)b & 0xffu) << 8) | (((unsigned)(int)c & 0xffu) << 16) | ((unsigned)(int)d << 24); }
__device__ __forceinline__ void store_row_i8(const f32x4 (&v)[4], signed char* row, float* scale, int lane) {
    float mx = 0.f;
#pragma unroll
    for (int j = 0; j < 4; ++j) mx = fmaxf(fmaxf(mx, fmaxf(fabsf(v[j][0]), fabsf(v[j][1]))), fmaxf(fabsf(v[j][2]), fabsf(v[j][3])));
    mx = wave_max(mx); const float inv = mx > 0.f ? 127.f / mx : 0.f;
#pragma unroll
    for (int j = 0; j < 4; ++j) *(unsigned*)(row + j * 256 + lane * 4) = pk4i8(rintf(v[j][0] * inv), rintf(v[j][1] * inv), rintf(v[j][2] * inv), rintf(v[j][3] * inv));
    if (lane == 0) *scale = mx * (1.f / 127.f);
}

__device__ __forceinline__ void p0_transpose_item(const float* W, int K, int N, bf16* WT, int row_off, int row_mul, float scale, int sc_n0, int sc_n1, LAS float* scr, int item, int lane) {
    const int nblk = N / 32, kb = item / nblk, nb = item % nblk, k0 = 64 * kb, n0 = 32 * nb;
#pragma unroll 32
    for (int i = 0; i < 32; ++i) { const int kk = 2 * i + (lane >> 5); scr[kk * 33 + (lane & 31)] = W[(size_t)(k0 + kk) * N + n0 + (lane & 31)]; }
    LDS_WAIT(); asm volatile("" ::: "memory");
    const float sc = (n0 >= sc_n0 && n0 < sc_n1) ? scale : 1.0f;
    const int c = lane & 7;
#pragma unroll
    for (int j = 0; j < 4; ++j) { const int n = (lane >> 3) + 8 * j; const LAS float* s = scr + (8 * c) * 33 + n;
        v4u o; o.x = pk2(s[0 * 33] * sc, s[1 * 33] * sc); o.y = pk2(s[2 * 33] * sc, s[3 * 33] * sc); o.z = pk2(s[4 * 33] * sc, s[5 * 33] * sc); o.w = pk2(s[6 * 33] * sc, s[7 * 33] * sc);
        *(GAS v4u*)(WT + (size_t)(row_off + (n0 + n) * row_mul) * K + k0 + 8 * c) = o; }
    LDS_WAIT(); asm volatile("" ::: "memory");
}
__device__ __forceinline__ void p0_quant_item(const float* W, int K, int N, int n0, signed char* WT, int row_off, int row_mul, float* scales, float qsc, int sc_n0, int sc_n1, LAS float* scr, int lane) {
    const int nl = lane & 31, kh = lane >> 5; const float* wp = W + n0 + nl; float mx = 0.f;
#pragma unroll 1
    for (int kb = 0; kb < K / 64; ++kb) { const float* wk = wp + (size_t)(kb * 64 + kh) * N;
#pragma unroll 32
        for (int i = 0; i < 32; ++i) mx = fmaxf(mx, fabsf(wk[(size_t)(2 * i) * N])); }
    mx = fmaxf(mx, __shfl_xor(mx, 32));
    const float inv = mx > 0.f ? 127.f / mx : 0.f;
    if (lane < 32) scales[row_off + (n0 + nl) * row_mul] = mx * (1.f / 127.f) * ((n0 >= sc_n0 && n0 < sc_n1) ? qsc : 1.f);
    const int c = lane & 7;
#pragma unroll 1
    for (int kb = 0; kb < K / 64; ++kb) { const float* wk = wp + (size_t)(kb * 64 + kh) * N;
#pragma unroll 32
        for (int i = 0; i < 32; ++i) { scr[(2 * i + kh) * 33 + nl] = rintf(wk[(size_t)(2 * i) * N] * inv); }
        LDS_WAIT(); asm volatile("" ::: "memory");
#pragma unroll
        for (int j = 0; j < 4; ++j) { const int n = (lane >> 3) + 8 * j; const LAS float* s = scr + (8 * c) * 33 + n;
            v2u o; o.x = pk4i8(s[0 * 33], s[1 * 33], s[2 * 33], s[3 * 33]); o.y = pk4i8(s[4 * 33], s[5 * 33], s[6 * 33], s[7 * 33]);
            *(GAS v2u*)(WT + (size_t)(row_off + (n0 + n) * row_mul) * K + kb * 64 + 8 * c) = o; }
        LDS_WAIT(); asm volatile("" ::: "memory");
    }
}
__device__ __forceinline__ void p0_transpose_item_f8(const float* W, int K, int N, unsigned char* WT, float scale, LAS float* scr, int item, int lane) {
    const int nblk = N / 32, kb = item / nblk, nb = item % nblk, k0 = 64 * kb, n0 = 32 * nb;
#pragma unroll 32
    for (int i = 0; i < 32; ++i) { const int kk = 2 * i + (lane >> 5); scr[kk * 33 + (lane & 31)] = W[(size_t)(k0 + kk) * N + n0 + (lane & 31)]; }
    LDS_WAIT(); asm volatile("" ::: "memory");
    const int c = lane & 7;
#pragma unroll
    for (int j = 0; j < 4; ++j) { const int n = (lane >> 3) + 8 * j; const LAS float* s = scr + (8 * c) * 33 + n;
        int w0 = pg8::f8pk(s[0 * 33] * scale, s[1 * 33] * scale, 0, false); w0 = pg8::f8pk(s[2 * 33] * scale, s[3 * 33] * scale, w0, true);
        int w1 = pg8::f8pk(s[4 * 33] * scale, s[5 * 33] * scale, 0, false); w1 = pg8::f8pk(s[6 * 33] * scale, s[7 * 33] * scale, w1, true);
        v2u o; o.x = (unsigned)w0; o.y = (unsigned)w1; *(GAS v2u*)(WT + (size_t)(n0 + n) * K + k0 + 8 * c) = o; }
    LDS_WAIT(); asm volatile("" ::: "memory");
}
__device__ __forceinline__ void p0a_prologue(Frame& F, const Args& a) {
    const float* c = a.in[1]; const float* w_ada = a.in[2]; const float* b_ada = a.in[3];
    if (F.vcu < 192) {
        LAS float* sl = (LAS float*)(F.lds);
        LAS float* red = (LAS float*)(F.lds + 16384);
        for (int i = F.tid; i < BATCH * DM; i += NTHREADS) { const float cv = c[i]; sl[i] = cv / (1.f + __expf(-cv)); }
        __syncthreads();
        const int l = F.vcu / 96, cb = F.vcu % 96, col = cb * 64 + F.lane;
        const float* w = w_ada + (size_t)l * DM * 6 * DM + col;
        float acc[BATCH] = {0.f, 0.f, 0.f, 0.f};
        const int kbeg = F.wave * 128;
#pragma unroll 32
        for (int k = kbeg; k < kbeg + 128; ++k) { const float wv = w[(size_t)k * 6 * DM];
#pragma unroll
            for (int b = 0; b < BATCH; ++b) acc[b] += sl[b * DM + k] * wv; }
#pragma unroll
        for (int b = 0; b < BATCH; ++b) red[(F.wave * BATCH + b) * 64 + F.lane] = acc[b];
        __syncthreads();
        if (F.wave < BATCH) { float s = 0.f;
#pragma unroll
            for (int w8 = 0; w8 < 8; ++w8) s += red[(w8 * BATCH + F.wave) * 64 + F.lane];
            float* mod = (float*)(F.ws + TB_MOD);
            mod[((size_t)l * BATCH + F.wave) * 6 * DM + col] = s + b_ada[l * 6 * DM + col]; }
        __syncthreads();
    }
    { const int gt = F.vcu * NTHREADS + F.tid, NGT = F.G * NTHREADS; float* par = (float*)(F.ws + TB_PAR);
      for (int i = gt; i < PAR_TOTAL; i += NGT) { float v;
          if (i < PAR_LN1G) v = a.in[5][i - PAR_WCONV];
          else if (i < PAR_LN1B) v = a.in[9][i - PAR_LN1G];
          else if (i < PAR_LN2G) v = a.in[10][i - PAR_LN1B];
          else if (i < PAR_LN2B) v = a.in[16][i - PAR_LN2G];
          else if (i < PAR_BR) v = a.in[17][i - PAR_LN2B];
          else if (i < PAR_WR) v = a.in[12][i - PAR_BR];
          else v = a.in[11][i - PAR_WR];
          par[i] = v; } }
    { const int gt = F.vcu * NTHREADS + F.tid, NGT = F.G * NTHREADS; unsigned short* wimg = (unsigned short*)(F.ws + TB_WRS);
      for (int idx = gt; idx < DM * NEXP; idx += NGT) { const int col = idx >> 4, e = idx & 15; const float v = a.in[11][idx]; const unsigned h = f2bf(v); const float hv = __uint_as_float(h << 16);
          wimg[e * WR_PITCH + col] = (unsigned short)h; wimg[(NEXP + e) * WR_PITCH + col] = (unsigned short)f2bf(v - hv); } }
    LAS float* scr = (LAS float*)(F.lds + RING_OFF + F.wave * 16384);
    const int gw = F.vcu * NWAVES + F.wave, NGW = F.G * NWAVES;
    constexpr int I_AB = (CONV_CH / 64) * (DM / 32), I_O = (DM / 64) * (DM / 32), I_G = (DM / 64) * (FFD / 32), I_D = (FFD / 64) * (DM / 32);
    constexpr int PER_L = 2 * I_AB + I_O + NEXP * I_D, NITEMS = DEPTH * PER_L;
    constexpr int H_IN = IN_W / 32, H_GU = NEXP * 2 * (FFD / 32), H_L = H_IN + H_GU, NHEAVY = DEPTH * H_L;
    const bool hv = (gw % 3) != 2; const int hrank = gw - gw / 3 - (hv ? 0 : 1), nhv = NGW - NGW / 3;
    const int nidle = nhv > NHEAVY ? nhv - NHEAVY : 0, nlt = NGW / 3 + nidle;
    const int lrank = hv ? (hrank >= NHEAVY ? NGW / 3 + hrank - NHEAVY : -1) : gw / 3;
    if (hv) for (int it = hrank; it < NHEAVY; it += nhv) { const int l = it / H_L; int r = it % H_L;
        if (r < H_IN) { const int n0 = r * 32; const bool isc = n0 >= CONV_CH && n0 < 2 * CONV_CH, isx = n0 >= 2 * CONV_CH && n0 < 3 * CONV_CH;
            p0_quant_item(a.in[4] + (size_t)l * DM * IN_W, DM, IN_W, n0, (signed char*)(F.ws + W_IN + l * W_IN_L), isc ? -CONV_CH : isx ? 1 - 3 * CONV_CH : 0, (isc || isx) ? 2 : 1, (float*)(F.ws + W_IN + l * W_IN_L + W_IN_SC), QSCALE, 3 * CONV_CH, 3 * CONV_CH + ATT_W, scr, F.lane); continue; }
        r -= H_IN; const int e = r / (2 * (FFD / 32)), wh = (r / (FFD / 32)) & 1, nb = r % (FFD / 32); const size_t le = (size_t)l * NEXP + e;
        p0_quant_item(a.in[13 + wh] + le * DM * FFD, DM, FFD, nb * 32, (signed char*)(F.ws + W_GU + le * W_GU_E), wh, 2, (float*)(F.ws + W_GU + le * W_GU_E + W_GU_SC), 1.f, 0, 0, scr, F.lane); }
    for (int it = lrank < 0 ? NITEMS : lrank; it < NITEMS; it += nlt) {
        const int l = it / PER_L; int r = it % PER_L;
        if (r < I_AB) { p0_transpose_item_f8(a.in[6] + (size_t)l * CONV_CH * DM, CONV_CH, DM, (unsigned char*)(F.ws + W_A + l * W_A_L), 64.0f, scr, r, F.lane); continue; } r -= I_AB;
        if (r < I_AB) { p0_transpose_item_f8(a.in[7] + (size_t)l * ATT_W * DM, ATT_W, DM, (unsigned char*)(F.ws + W_B + l * W_B_L), 64.0f, scr, r, F.lane); continue; } r -= I_AB;
        if (r < I_O) { p0_transpose_item_f8(a.in[8] + (size_t)l * DM * DM, DM, DM, (unsigned char*)(F.ws + W_O + l * W_O_L), 64.0f, scr, r, F.lane); continue; } r -= I_O;
        const int e = r / I_D; r %= I_D; const size_t le = (size_t)l * NEXP + e;
        p0_transpose_item_f8(a.in[15] + le * FFD * DM, FFD, DM, (unsigned char*)(F.ws + W_DN + le * W_DN_E), 64.0f, scr, r, F.lane);
    }
}
__device__ __forceinline__ void p0b_u0(Frame& F) {
    const float* x = F.x; const float* mod = (const float*)(F.ws + TB_MOD); signed char* U = (signed char*)(F.ws + WS_ACT); float* sU = (float*)(F.ws + WS_ACT + ACT_SU);
    const int gw = F.vcu * NWAVES + F.wave, NGW = F.G * NWAVES;
    for (int m = gw; m < M_TOK; m += NGW) { const int b = m / SEQ; const float* mb = mod + (size_t)b * 6 * DM; f32x4 u[4];
#pragma unroll
        for (int j = 0; j < 4; ++j) { const int col = j * 256 + F.lane * 4; const f32x4 v = *(const f32x4*)(x + (size_t)m * DM + col), sh = *(const f32x4*)(mb + col), sc = *(const f32x4*)(mb + DM + col);
            u[j] = v * (sc + 1.0f) + sh; }
        store_row_i8(u, U + (size_t)m * DM, sU + m, F.lane); }
}
__device__ __forceinline__ void p2_conv(Frame& F, int l, bf16* ao) {
    bf16* cb = (bf16*)(F.ws + WS_PROJ); const bf16* pp = cb + (size_t)M_TOK * 512;
    const float* wc = (const float*)(F.ws + TB_PAR) + PAR_WCONV + (size_t)l * 3 * CONV_CH;
    const int gw = F.vcu * NWAVES + F.wave, NGW = F.G * NWAVES; const int ch = F.lane * 8;
    float w0[8], w1[8], w2[8];
#pragma unroll
    for (int i = 0; i < 8; ++i) { w0[i] = wc[ch + i]; w1[i] = wc[CONV_CH + ch + i]; w2[i] = wc[2 * CONV_CH + ch + i]; }
    for (int chunk = gw; chunk < M_TOK / 16; chunk += NGW) {
        const int row0 = chunk * 16; const int t0 = row0 % SEQ;
        float pm2[8], pm1[8];
#pragma unroll
        for (int i = 0; i < 8; ++i) { pm2[i] = 0.f; pm1[i] = 0.f; }
        if (t0 >= 2) {
            const v4u q2 = *(const v4u*)(pp + (size_t)(row0 - 2) * 512 + ch), q1 = *(const v4u*)(pp + (size_t)(row0 - 1) * 512 + ch);
#pragma unroll
            for (int i = 0; i < 4; ++i) { pm2[2 * i] = bflo(q2[i]); pm2[2 * i + 1] = bfhi(q2[i]); pm1[2 * i] = bflo(q1[i]); pm1[2 * i + 1] = bfhi(q1[i]); }
        }
        for (int r = 0; r < 16; ++r) { const size_t off = (size_t)(row0 + r) * 512 + ch;
            const v4u q0 = *(const v4u*)(pp + off), bb = *(const v4u*)(cb + off);
            float p0[8], o[8];
#pragma unroll
            for (int i = 0; i < 4; ++i) { p0[2 * i] = bflo(q0[i]); p0[2 * i + 1] = bfhi(q0[i]); }
#pragma unroll
            for (int i = 0; i < 8; ++i) o[i] = w2[i] * p0[i] + w1[i] * pm1[i] + w0[i] * pm2[i];
            int q0w = pg8::f8pk(bflo(bb[0]) * o[0] * 2.0f, bfhi(bb[0]) * o[1] * 2.0f, 0, false); q0w = pg8::f8pk(bflo(bb[1]) * o[2] * 2.0f, bfhi(bb[1]) * o[3] * 2.0f, q0w, true);
            int q1w = pg8::f8pk(bflo(bb[2]) * o[4] * 2.0f, bfhi(bb[2]) * o[5] * 2.0f, 0, false); q1w = pg8::f8pk(bflo(bb[3]) * o[6] * 2.0f, bfhi(bb[3]) * o[7] * 2.0f, q1w, true);
            v2u ov; ov.x = (unsigned)q0w; ov.y = (unsigned)q1w; *(v2u*)((unsigned char*)ao + off) = ov;
#pragma unroll
            for (int i = 0; i < 8; ++i) { pm2[i] = pm1[i]; pm1[i] = p0[i]; } }
    }
}
__device__ __forceinline__ void p2_attn(Frame& F, unsigned char* lds_generic) {
    const sba::bf16_t* Q = (const sba::bf16_t*)(F.ws + WS_PROJ + 3 * PJ_T512); const sba::bf16_t* K = (const sba::bf16_t*)(F.ws + WS_PROJ + 4 * PJ_T512); const sba::bf16_t* V = (const sba::bf16_t*)(F.ws + WS_PROJ + 5 * PJ_T512);
    sba::bf16_t* O = (sba::bf16_t*)(F.ws + WS_ACT);
    constexpr int NQB = SEQ / 256, NUNITS = BATCH * NHEAD * NQB;
    if (F.G == 256) {
        const int bh = F.vcu >> 3, s = F.vcu & 7;
        for (int i = 0; i < 4; ++i) { const int qb = (i == 0) ? s : (i == 1) ? 15 - s : (i == 2) ? 16 + s : 31 - s; sba::attn_unit(bh / NHEAD, bh % NHEAD, qb, Q, K, V, O, (char*)lds_generic); }
    } else {
        for (int u = F.vcu; u < NUNITS; u += F.G) { const int bh = u / NQB, qb = u % NQB; sba::attn_unit(bh / NHEAD, bh % NHEAD, qb, Q, K, V, O, (char*)lds_generic); }
    }
}
__device__ __forceinline__ float quad_sum(float v) {
    { auto r = __builtin_amdgcn_permlane16_swap(__float_as_uint(v), __float_as_uint(v), false, false); v = __uint_as_float(r[0]) + __uint_as_float(r[1]); }
    { auto r = __builtin_amdgcn_permlane32_swap(__float_as_uint(v), __float_as_uint(v), false, false); v = __uint_as_float(r[0]) + __uint_as_float(r[1]); }
    return v;
}
__device__ __forceinline__ float quad_max(float v) {
    { auto r = __builtin_amdgcn_permlane16_swap(__float_as_uint(v), __float_as_uint(v), false, false); v = fmaxf(__uint_as_float(r[0]), __uint_as_float(r[1])); }
    { auto r = __builtin_amdgcn_permlane32_swap(__float_as_uint(v), __float_as_uint(v), false, false); v = fmaxf(__uint_as_float(r[0]), __uint_as_float(r[1])); }
    return v;
}
__device__ __forceinline__ void p5_ln1(Frame& F, int l, const bf16* X, bf16* Xo, bool dry) {
    const float* mod = (const float*)(F.ws + TB_MOD) + (size_t)l * BATCH * 6 * DM; const float* par = (const float*)(F.ws + TB_PAR);
    const float* g = par + PAR_LN1G + l * DM; const float* bta = par + PAR_LN1B + l * DM; const float* w_router = par + PAR_WR; const float* b_router = par + PAR_BR;
    int* epos = (int*)(F.ws + TB_EIDX); float* gate = (float*)(F.ws + TB_GATE); int* gcnt = (int*)(F.ctl + CW_GCNT + 64 * l);
    signed char* U2 = (signed char*)(F.ws + WS_ACT); float* sU2 = (float*)(F.ws + WS_ACT + ACT_SU); int* list_e = (int*)(F.ws + WS_ACT + ACT_LIST);
    constexpr int WPITCH = WR_PITCH;
    LAS unsigned short* wth = (LAS unsigned short*)(F.lds);
    LAS unsigned short* wtl = wth + 16 * WPITCH;
    LAS float* pg = (LAS float*)(F.lds + 4 * 16 * WPITCH);
    LAS float* lgs = pg + 4 * DM;
    LAS int* hist = (LAS int*)(lgs + NWAVES * 256); LAS int* hbase = hist + 16; LAS int* te = hbase + 16; LAS int* tp = te + 256;
    const int blk = blockIdx.x; const int b = (blk * 128) / SEQ; const float* mb = mod + (size_t)b * 6 * DM;
    const int t = F.lane & 15, kq = F.lane >> 4; const int row = blk * 128 + F.wave * 16 + t;
    const bf16* xr = X + (size_t)row * DM + 8 * kq; (void)Xo; (void)w_router;
    constexpr int NIMG = 2 * NEXP * WPITCH * 2 / 16;
    const v4u* wsrc = (const v4u*)(F.ws + TB_WRS);
    v4u wimg[9]; float pv[2][4];
#pragma unroll
    for (int q = 0; q < 9; ++q) { const int i = F.tid + q * NTHREADS; wimg[q] = (q < 8 || i < NIMG) ? wsrc[(q < 8 || i < NIMG) ? i : 0] : (v4u){0u, 0u, 0u, 0u}; }
#pragma unroll
    for (int q = 0; q < 2; ++q) { const int idx = F.tid + q * NTHREADS; pv[q][0] = g[idx]; pv[q][1] = bta[idx]; pv[q][2] = mb[4 * DM + idx]; pv[q][3] = mb[3 * DM + idx]; }
    asm volatile("" ::: "memory");
    v4u raw[32];
#pragma unroll
    for (int s = 0; s < 32; ++s) raw[s] = *(const v4u*)(xr + 32 * s);
    asm volatile("" ::: "memory");
#pragma unroll
    for (int q = 0; q < 9; ++q) { const int i = F.tid + q * NTHREADS; if (q < 8 || i < NIMG) ((LAS v4u*)F.lds)[i] = wimg[q]; }
#pragma unroll
    for (int q = 0; q < 2; ++q) { const int idx = F.tid + q * NTHREADS; pg[idx] = pv[q][0]; pg[DM + idx] = pv[q][1]; pg[2 * DM + idx] = pv[q][2] + 1.0f; pg[3 * DM + idx] = pv[q][3]; }
    if (F.tid < NEXP) hist[F.tid] = 0;
    __syncthreads();
    float sum = 0.f, sq = 0.f;
#pragma unroll
    for (int s = 0; s < 32; ++s) { const float e0 = bflo(raw[s].x), e1 = bfhi(raw[s].x), e2 = bflo(raw[s].y), e3 = bfhi(raw[s].y), e4 = bflo(raw[s].z), e5 = bfhi(raw[s].z), e6 = bflo(raw[s].w), e7 = bfhi(raw[s].w);
        sum += ((e0 + e1) + (e2 + e3)) + ((e4 + e5) + (e6 + e7)); sq += ((e0 * e0 + e1 * e1) + (e2 * e2 + e3 * e3)) + ((e4 * e4 + e5 * e5) + (e6 * e6 + e7 * e7)); }
    const float mean = quad_sum(sum) * (1.f / DM); const float var = fmaxf(quad_sum(sq) * (1.f / DM) - mean * mean, 0.f);
    const float rstd = 1.f / sqrtf(var + LN_EPS);
    typedef short bf16x8_t __attribute__((ext_vector_type(8)));
    f32x4 acc = {0.f, 0.f, 0.f, 0.f}; float amax = 0.f;
    const LAS unsigned short* wph = wth + t * WPITCH + 8 * kq; const LAS unsigned short* wpl = wtl + t * WPITCH + 8 * kq;
    const LAS float* pp = pg + 8 * kq;
#pragma unroll
    for (int s = 0; s < 32; ++s) {
        const f32x4 g0 = *(const LAS f32x4*)(pp + 32 * s), g1 = *(const LAS f32x4*)(pp + 32 * s + 4), b0 = *(const LAS f32x4*)(pp + DM + 32 * s), b1 = *(const LAS f32x4*)(pp + DM + 32 * s + 4);
        const f32x4 c0 = *(const LAS f32x4*)(pp + 2 * DM + 32 * s), c1 = *(const LAS f32x4*)(pp + 2 * DM + 32 * s + 4), h0 = *(const LAS f32x4*)(pp + 3 * DM + 32 * s), h1 = *(const LAS f32x4*)(pp + 3 * DM + 32 * s + 4);
        v4u rw = raw[s]; asm volatile("" : "+v"(rw.x), "+v"(rw.y), "+v"(rw.z), "+v"(rw.w));
        const f32x4 x0 = (((f32x4){bflo(rw.x), bfhi(rw.x), bflo(rw.y), bfhi(rw.y)}) - mean) * rstd * g0 + b0, x1 = (((f32x4){bflo(rw.z), bfhi(rw.z), bflo(rw.w), bfhi(rw.w)}) - mean) * rstd * g1 + b1;
        const f32x4 u0 = x0 * c0 + h0, u1 = x1 * c1 + h1;
        amax = fmaxf(amax, fmaxf(fmaxf(fmaxf(fabsf(u0[0]), fabsf(u0[1])), fmaxf(fabsf(u0[2]), fabsf(u0[3]))), fmaxf(fmaxf(fabsf(u1[0]), fabsf(u1[1])), fmaxf(fabsf(u1[2]), fabsf(u1[3])))));
        v4u uh, ul;
        uh.x = pk2(u0[0], u0[1]); uh.y = pk2(u0[2], u0[3]); uh.z = pk2(u1[0], u1[1]); uh.w = pk2(u1[2], u1[3]);
        ul.x = pk2(u0[0] - bflo(uh.x), u0[1] - bfhi(uh.x)); ul.y = pk2(u0[2] - bflo(uh.y), u0[3] - bfhi(uh.y)); ul.z = pk2(u1[0] - bflo(uh.z), u1[1] - bfhi(uh.z)); ul.w = pk2(u1[2] - bflo(uh.w), u1[3] - bfhi(uh.w));
        const bf16x8_t wh = *(const LAS bf16x8_t*)(wph + 32 * s), wl = *(const LAS bf16x8_t*)(wpl + 32 * s);
        acc = __builtin_amdgcn_mfma_f32_16x16x32_bf16(wh, __builtin_bit_cast(bf16x8_t, uh), acc, 0, 0, 0);
        acc = __builtin_amdgcn_mfma_f32_16x16x32_bf16(wh, __builtin_bit_cast(bf16x8_t, ul), acc, 0, 0, 0);
        acc = __builtin_amdgcn_mfma_f32_16x16x32_bf16(wl, __builtin_bit_cast(bf16x8_t, uh), acc, 0, 0, 0);
        if (s & 1) asm volatile("" ::: "memory");
    }
    {
        const float rmax = quad_max(amax), qinv = rmax > 0.f ? 127.f / rmax : 0.f; signed char* uw = U2 + (size_t)row * DM + 8 * kq;
#pragma unroll
        for (int s = 0; s < 32; ++s) {
            const f32x4 g0 = *(const LAS f32x4*)(pp + 32 * s), g1 = *(const LAS f32x4*)(pp + 32 * s + 4), b0 = *(const LAS f32x4*)(pp + DM + 32 * s), b1 = *(const LAS f32x4*)(pp + DM + 32 * s + 4);
            const f32x4 c0 = *(const LAS f32x4*)(pp + 2 * DM + 32 * s), c1 = *(const LAS f32x4*)(pp + 2 * DM + 32 * s + 4), h0 = *(const LAS f32x4*)(pp + 3 * DM + 32 * s), h1 = *(const LAS f32x4*)(pp + 3 * DM + 32 * s + 4);
            v4u rw = raw[s]; asm volatile("" : "+v"(rw.x), "+v"(rw.y), "+v"(rw.z), "+v"(rw.w));
            const f32x4 u0 = ((((f32x4){bflo(rw.x), bfhi(rw.x), bflo(rw.y), bfhi(rw.y)}) - mean) * rstd * g0 + b0) * c0 + h0, u1 = ((((f32x4){bflo(rw.z), bfhi(rw.z), bflo(rw.w), bfhi(rw.w)}) - mean) * rstd * g1 + b1) * c1 + h1;
            v2u o; o.x = pk4i8(rintf(u0[0] * qinv), rintf(u0[1] * qinv), rintf(u0[2] * qinv), rintf(u0[3] * qinv)); o.y = pk4i8(rintf(u1[0] * qinv), rintf(u1[1] * qinv), rintf(u1[2] * qinv), rintf(u1[3] * qinv));
            if (!dry) *(v2u*)(uw + 32 * s) = o; else asm volatile("" :: "v"(o.x), "v"(o.y));
            if (s & 1) asm volatile("" ::: "memory"); }
        if (kq == 0 && !dry) { sU2[row] = rmax * (1.f / 127.f); float* st = (float*)(F.ws + TB_SLOT); st[row * 2] = mean; st[row * 2 + 1] = rstd; }
    }
    LAS float* lw = lgs + F.wave * 256;
    *(LAS f32x4*)(lw + t * 16 + 4 * kq) = acc;
    LDS_WAIT(); asm volatile("" ::: "memory");
    float lg[NEXP];
#pragma unroll
    for (int q = 0; q < 4; ++q) { const f32x4 v = *(const LAS f32x4*)(lw + t * 16 + 4 * q); lg[4 * q] = v[0]; lg[4 * q + 1] = v[1]; lg[4 * q + 2] = v[2]; lg[4 * q + 3] = v[3]; }
    float aff[NEXP], sel[NEXP];
#pragma unroll
    for (int e = 0; e < NEXP; ++e) { aff[e] = 1.f / (1.f + __expf(-lg[e])); sel[e] = aff[e] + b_router[e]; }
    int gbest = 0; float gs_best = -1e30f;
#pragma unroll
    for (int gi = 0; gi < 4; ++gi) { float m1 = -1e30f, m2 = -1e30f;
#pragma unroll
        for (int q = 0; q < 4; ++q) { const float xv = sel[gi * 4 + q]; if (xv > m1) { m2 = m1; m1 = xv; } else if (xv > m2) m2 = xv; }
        const float gsc = m1 + m2; if (gsc > gs_best) { gs_best = gsc; gbest = gi; } }
    float sg[4], ag[4];
#pragma unroll
    for (int q = 0; q < 4; ++q) { sg[q] = gbest == 0 ? sel[q] : gbest == 1 ? sel[4 + q] : gbest == 2 ? sel[8 + q] : sel[12 + q]; ag[q] = gbest == 0 ? aff[q] : gbest == 1 ? aff[4 + q] : gbest == 2 ? aff[8 + q] : aff[12 + q]; }
    int i1 = 0; float v1 = sg[0];
#pragma unroll
    for (int q = 1; q < 4; ++q) if (sg[q] > v1) { v1 = sg[q]; i1 = q; }
    int i2 = -1; float v2 = -1e30f;
#pragma unroll
    for (int q = 0; q < 4; ++q) if (q != i1 && sg[q] > v2) { v2 = sg[q]; i2 = q; }
    const float a1 = i1 == 0 ? ag[0] : i1 == 1 ? ag[1] : i1 == 2 ? ag[2] : ag[3], a2 = i2 == 0 ? ag[0] : i2 == 1 ? ag[1] : i2 == 2 ? ag[2] : ag[3];
    const float inv = 1.f / (a1 + a2);
    if (kq == 0) { const int e1 = gbest * 4 + i1, e2 = gbest * 4 + i2, i = F.wave * 16 + t;
        if (!dry) { gate[row * 2] = a1 * inv; gate[row * 2 + 1] = a2 * inv; }
        te[i * 2] = e1; te[i * 2 + 1] = e2;
        tp[i * 2] = __hip_atomic_fetch_add(&hist[e1], 1, __ATOMIC_RELAXED, __HIP_MEMORY_SCOPE_WORKGROUP); tp[i * 2 + 1] = __hip_atomic_fetch_add(&hist[e2], 1, __ATOMIC_RELAXED, __HIP_MEMORY_SCOPE_WORKGROUP); }
    __syncthreads();
    if (dry) return;
    if (F.tid < NEXP) hbase[F.tid] = atomicAdd(gcnt + F.tid, hist[F.tid]);
    __syncthreads();
    if (F.tid < 128) { const int tok = blk * 128 + F.tid;
#pragma unroll
        for (int k = 0; k < 2; ++k) { const int e = te[F.tid * 2 + k], p = hbase[e] + tp[F.tid * 2 + k]; list_e[(size_t)e * M_TOK + p] = tok; epos[tok * 2 + k] = e | (p << 4); } }
}
__device__ __forceinline__ void build_group_tables(Frame& F, int l, bool rows) {
    LAS int* tab = (LAS int*)(F.lds + LDSCTL_OFF);
    const int* gcnt = (const int*)(F.ctl + CW_GCNT + 64 * l);
    if (F.tid == 0) { int tb[NEXP + 1]; int acc = 0;
#pragma unroll
        for (int e = 0; e < NEXP; ++e) { tb[e] = acc; acc += (gcnt[e] + 255) >> 8; } tb[NEXP] = acc;
        const int nunits = acc * 4; int n = 0;
        for (int i = 0; i < 8; ++i) { const int L = i * F.G + (int)blockIdx.x; if (L >= nunits) break; const int wgid = pg8::xcd_remap(L, nunits); const int ti = wgid >> 2; int e = 0;
#pragma unroll
            for (int k = 1; k < NEXP; ++k) if (ti >= tb[k]) e = k;
            tab[1 + 3 * n] = ti; tab[2 + 3 * n] = wgid & 3; tab[3 + 3 * n] = e; tab[64 + 2 * n] = (ti - tb[e]) * 256; tab[65 + 2 * n] = gcnt[e]; ++n; }
        tab[0] = n; }
    __syncthreads();
    if (rows) { LAS int* rowtab = (LAS int*)(F.lds + GTAB_OFF); LAS float* sctab = (LAS float*)(F.lds + GTAB_OFF + 8192);
        const int* list_e = (const int*)(F.ws + WS_ACT + ACT_LIST); const float* sU2 = (const float*)(F.ws + WS_ACT + ACT_SU);
        const int n = tab[0];
        int toks[3]; bool oks[3];
#pragma unroll
        for (int q = 0; q < 3; ++q) { const int idx = F.tid + q * NTHREADS; oks[q] = false; toks[q] = 0;
            if (idx < n * 256) { const int un = idx >> 8, r = idx & 255; const int e = tab[3 + 3 * un], rr = tab[64 + 2 * un] + r; oks[q] = rr < tab[65 + 2 * un]; if (oks[q]) toks[q] = list_e[(size_t)e * M_TOK + rr]; } }
#pragma unroll
        for (int q = 0; q < 3; ++q) { const int idx = F.tid + q * NTHREADS; if (idx < n * 256) { rowtab[idx] = toks[q]; sctab[idx] = oks[q] ? sU2[toks[q]] : 0.f; } }
        __syncthreads(); }
}
template <bool LAST> __device__ __forceinline__ void p9_ln2(Frame& F, int l, const bf16* X, void* Xo) {
    const float* modl = (const float*)(F.ws + TB_MOD) + (size_t)l * BATCH * 6 * DM; const float* modn = modl + (size_t)BATCH * 6 * DM; const float* par = (const float*)(F.ws + TB_PAR);
    const float* g1p = par + PAR_LN1G + l * DM; const float* b1p = par + PAR_LN1B + l * DM; const float* st1 = (const float*)(F.ws + TB_SLOT);
    const float* g = par + PAR_LN2G + l * DM; const float* bta = par + PAR_LN2B + l * DM; const int* epos = (const int*)(F.ws + TB_EIDX); const float* gate = (const float*)(F.ws + TB_GATE);
    LAS int* tbs = (LAS int*)(F.lds);
    if (F.tid == 0) { const int* gcnt = (const int*)(F.ctl + CW_GCNT + 64 * l); int acc = 0; for (int e = 0; e < NEXP; ++e) { tbs[e] = acc * 256; acc += (gcnt[e] + 255) >> 8; } }
    __syncthreads();
    const unsigned char* YS = (const unsigned char*)(F.ws + WS_PROJ + PJ_XS); bf16* U = (bf16*)(F.ws + WS_ACT);
    const int gw = F.vcu * NWAVES + F.wave, NGW = F.G * NWAVES;
    constexpr int RB = 4;
    for (int m0 = gw * RB; m0 < M_TOK; m0 += NGW * RB) { const int b = m0 / SEQ; const float* mb = modl + (size_t)b * 6 * DM;
        int s0[RB], s1[RB]; float w0[RB], w1[RB], mu1[RB], rs1[RB];
#pragma unroll
        for (int k = 0; k < RB; ++k) { const v2u sv = *(const v2u*)(epos + (m0 + k) * 2); s0[k] = tbs[sv.x & 15] + (int)(sv.x >> 4); s1[k] = tbs[sv.y & 15] + (int)(sv.y >> 4);
            const v2u gv = *(const v2u*)(gate + (m0 + k) * 2); w0[k] = __uint_as_float(gv.x) * (1.f / 32.f); w1[k] = __uint_as_float(gv.y) * (1.f / 32.f);
            const v2u sv1 = *(const v2u*)(st1 + (m0 + k) * 2); mu1[k] = __uint_as_float(sv1.x); rs1[k] = __uint_as_float(sv1.y); }
        f32x4 xv[RB][4]; unsigned y0[RB][4], y1[RB][4];
#pragma unroll
        for (int k = 0; k < RB; ++k)
#pragma unroll
            for (int j = 0; j < 4; ++j) { const int col = j * 256 + F.lane * 4; { const v2u p = *(const v2u*)(X + (size_t)(m0 + k) * DM + col); xv[k][j] = (f32x4){bflo(p.x), bfhi(p.x), bflo(p.y), bfhi(p.y)}; }
                y0[k][j] = *(const unsigned*)(YS + (size_t)s0[k] * DM + col); y1[k][j] = *(const unsigned*)(YS + (size_t)s1[k] * DM + col); }
        f32x4 un[RB][4];
        float rstd[RB];
#pragma unroll
        for (int k = 0; k < RB; ++k) { float s = 0.f;
#pragma unroll
            for (int j = 0; j < 4; ++j) { const int col = j * 256 + F.lane * 4; const f32x4 g2 = *(const f32x4*)(mb + 5 * DM + col), gg1 = *(const f32x4*)(g1p + col), bb1 = *(const f32x4*)(b1p + col);
                const auto a01 = __builtin_amdgcn_cvt_pk_f32_fp8((int)y0[k][j], false), a23 = __builtin_amdgcn_cvt_pk_f32_fp8((int)y0[k][j], true), b01 = __builtin_amdgcn_cvt_pk_f32_fp8((int)y1[k][j], false), b23 = __builtin_amdgcn_cvt_pk_f32_fp8((int)y1[k][j], true);
                f32x4 f; f[0] = w0[k] * a01[0] + w1[k] * b01[0]; f[1] = w0[k] * a01[1] + w1[k] * b01[1]; f[2] = w0[k] * a23[0] + w1[k] * b23[0]; f[3] = w0[k] * a23[1] + w1[k] * b23[1];
                xv[k][j] = ((xv[k][j] - mu1[k]) * rs1[k] * gg1 + bb1) * DN_ALPHA + g2 * f; s += (xv[k][j][0] + xv[k][j][1]) + (xv[k][j][2] + xv[k][j][3]); }
            const float mean = wave_sum(s) * (1.f / DM); float s2 = 0.f;
#pragma unroll
            for (int j = 0; j < 4; ++j) { xv[k][j] = xv[k][j] - mean; s2 += (xv[k][j][0] * xv[k][j][0] + xv[k][j][1] * xv[k][j][1]) + (xv[k][j][2] * xv[k][j][2] + xv[k][j][3] * xv[k][j][3]); }
            rstd[k] = 1.f / sqrtf(wave_sum(s2) * (1.f / DM) + LN_EPS); }
#pragma unroll
        for (int j = 0; j < 4; ++j) { const int col = j * 256 + F.lane * 4; const f32x4 gg = *(const f32x4*)(g + col), bb = *(const f32x4*)(bta + col);
            f32x4 sh, sc;
            if (!LAST) { const float* mn = modn + (size_t)b * 6 * DM; sh = *(const f32x4*)(mn + col); sc = *(const f32x4*)(mn + DM + col) + 1.0f; }
#pragma unroll
            for (int k = 0; k < RB; ++k) { const f32x4 xo = xv[k][j] * rstd[k] * gg + bb;
                if (LAST) *(f32x4*)((float*)Xo + (size_t)(m0 + k) * DM + col) = xo;
                else { v2u o; o.x = pk2(xo[0], xo[1]); o.y = pk2(xo[2], xo[3]); *(v2u*)((bf16*)Xo + (size_t)(m0 + k) * DM + col) = o;
                    un[k][j] = xo * sc + sh; } } }
        if (!LAST) {
#pragma unroll
            for (int k = 0; k < RB; ++k) store_row_i8(un[k], (signed char*)U + (size_t)(m0 + k) * DM, (float*)(F.ws + WS_ACT + ACT_SU) + m0 + k, F.lane); }
    }
}

constexpr int PH_PER_LAYER = 9, N_PHASES = 2 + DEPTH * PH_PER_LAYER;
__global__ void __launch_bounds__(NTHREADS, 2) mega_fwd(Args args) {
    extern __shared__ __attribute__((aligned(16))) unsigned char lds[];
    Frame F;
    F.lds = (LAS unsigned char*)lds;
    F.MISC = (volatile LAS unsigned*)(F.lds + MISC_OFF);
    F.tid = threadIdx.x; F.lane = F.tid & 63; F.wave = __builtin_amdgcn_readfirstlane(F.tid >> 6);
    F.G = gridDim.x; { const int bx = blockIdx.x; F.vcu = (F.G % 8 == 0) ? (bx % 8) * (F.G / 8) + bx / 8 : bx; }
    F.ws = args.ws; F.ctl = (gu32*)(args.ws + WS_CTL); F.x = args.in[0]; F.out = args.out;
    for (int u = F.tid; u < (LDS_BYTES - LDSCTL_OFF) / 4; u += NTHREADS) ((LAS unsigned*)(F.lds + LDSCTL_OFF))[u] = 0u;
    __syncthreads();
    const int lo = args.ph_lo, hi = args.ph_hi;
    XcdBarrier bar; bar.bar = (unsigned*)(F.ctl + CW_BAR); bar.x = 0; bar.st = nullptr;
    if (hi - lo > 1) bar = xcd_barrier_post((unsigned*)(F.ctl + CW_BAR), F.MISC + 8);
#define IN(k) (lo <= (k) && (k) < hi)
#define REPS(t) (((MK_REP_MASK >> (t)) & 1) ? 1 + MK_REP_N : 1)
#define FRESH() do { asm volatile("" : "+v"(F.tid), "+v"(F.lane)); size_t z_ = 0; asm volatile("" : "+s"(z_), "+s"(F.wave), "+s"(F.vcu)); F.ws = args.ws + z_; F.out = args.out + z_; F.x = args.in[0] + z_; } while (0)
#if MK_PROBE
#define STAMP(k) do { if (blockIdx.x == 0 && F.tid == 0) ((unsigned long long*)(F.ws + TB_STAMP))[(k)] = __builtin_amdgcn_s_memrealtime(); } while (0)
#define SEAM(k) do { if (IN(k)) { xcd_barrier(bar); STAMP((k) + 1); } } while (0)
#else
#define STAMP(k) do {} while (0)
#define SEAM(k) do { if (IN(k) && IN((k) + 1)) { xcd_barrier(bar); for (int xb_ = 0; xb_ < MK_XBAR; ++xb_) xcd_barrier(bar); } } while (0)
#endif
    STAMP(0);
    if (IN(0)) { for (int rep = 0; rep < REPS(0); ++rep) { FRESH(); p0a_prologue(F, args); __syncthreads(); } SEAM(0); }
    if (IN(1)) { for (int rep = 0; rep < REPS(1); ++rep) { FRESH(); p0b_u0(F); } SEAM(1); }
#pragma unroll 1
    for (int l = 0; l < DEPTH; ++l) {
        const int pb = 2 + l * PH_PER_LAYER;
        const float* modl = (const float*)(F.ws + TB_MOD) + (size_t)l * BATCH * 6 * DM;
        if (IN(pb + 0)) for (int rep = 0; rep < REPS(2); ++rep) {
            FRESH();
            pg8::Gemm g{(const pg8::bf16_t*)(F.ws + WS_ACT), (const pg8::bf16_t*)(F.ws + W_IN + l * W_IN_L), M_TOK, IN_W, DM, 0, nullptr, nullptr, nullptr};
            pg8::StaticOrder S; S.init(M_TOK, IN_W, F.G, (int)blockIdx.x, MK_WGM_IN);
            pg8::EpiProjI8 E{(pg8::bf16_t*)(F.ws + WS_PROJ), (const float*)(F.ws + WS_ACT + ACT_SU), (const float*)(F.ws + W_IN + l * W_IN_L + W_IN_SC)};
            if (F.vcu & 1) { for (int sl_ = 0; sl_ < MK_STAGGER; ++sl_) __builtin_amdgcn_s_sleep(100); }
            pg8::gemm_phase<pg8::EpiProjI8, pg8::StaticOrder, true, true>(F.lds + RING_OFF, g, S, E);
            if (rep + 1 == REPS(2)) SEAM(pb + 0); }
        if (IN(pb + 1)) { FRESH(); p2_conv(F, l, (bf16*)(F.ws + WS_ACT + 16 * MiB)); FRESH(); p2_attn(F, lds + RING_OFF); SEAM(pb + 1); }
        if (IN(pb + 2)) for (int rep = 0; rep < REPS(4); ++rep) {
            FRESH();
            pg8::StaticOrder S; S.init(M_TOK, DM, F.G, (int)blockIdx.x, MK_WGM_SQ);
            pg8::Gemm g{(const pg8::bf16_t*)(F.ws + WS_ACT + 16 * MiB), (const pg8::bf16_t*)(F.ws + W_A + l * W_A_L), M_TOK, DM, CONV_CH + ATT_W, 0,
                        (const pg8::bf16_t*)(F.ws + WS_ACT), (const pg8::bf16_t*)(F.ws + W_B + l * W_B_L), nullptr};
            pg8::EpiMerge E{(const unsigned char*)(F.ws + WS_PROJ + PJ_GA), (const unsigned char*)(F.ws + WS_PROJ + PJ_GB), (pg8::bf16_t*)(F.ws + WS_PROJ + 1 * PJ_T512)};
            pg8::gemm_phase<pg8::EpiMerge, pg8::StaticOrder, true, true>(F.lds + RING_OFF, g, S, E);
            if (rep + 1 == REPS(4)) SEAM(pb + 2); }
        bf16* const XBl = (l + 1 < DEPTH) ? (bf16*)F.out : (bf16*)(F.ws + WS_PROJ + PJ_GB);
        if (IN(pb + 3)) for (int rep = 0; rep < REPS(5); ++rep) {
            FRESH();
            pg8::Gemm g{(const pg8::bf16_t*)(F.ws + WS_PROJ + 1 * PJ_T512), (const pg8::bf16_t*)(F.ws + W_O + l * W_O_L), M_TOK, DM, DM, 0, nullptr, nullptr, nullptr};
            pg8::StaticOrder S; S.init(M_TOK, DM, F.G, (int)blockIdx.x, MK_WGM_SQ);
            if (l == 0) { pg8::EpiH1<true> E{(const void*)F.x, (pg8::bf16_t*)XBl, modl + 2 * DM};
                pg8::gemm_phase<pg8::EpiH1<true>, pg8::StaticOrder, true, true>(F.lds + RING_OFF, g, S, E); }
            else { pg8::EpiH1<false> E{(const void*)F.out, (pg8::bf16_t*)XBl, modl + 2 * DM};
                pg8::gemm_phase<pg8::EpiH1<false>, pg8::StaticOrder, true, true>(F.lds + RING_OFF, g, S, E); }
            if (rep + 1 == REPS(5)) SEAM(pb + 3); }
        if (IN(pb + 4)) { for (int rep = 1; rep < REPS(6); ++rep) { FRESH(); p5_ln1(F, l, XBl, (bf16*)(F.ws + WS_PROJ), true); __syncthreads(); } FRESH(); p5_ln1(F, l, XBl, XBl, false); SEAM(pb + 4); }
        if (IN(pb + 6)) for (int rep = 0; rep < REPS(8); ++rep) {
            FRESH(); build_group_tables(F, l, true);
            pg8::Gemm g{(const pg8::bf16_t*)(F.ws + WS_ACT), (const pg8::bf16_t*)(F.ws + W_GU + (size_t)l * NEXP * W_GU_E), PMAX, 2 * FFD, DM, W_GU_E, nullptr, nullptr, (const PG8_LAS int*)(F.lds + GTAB_OFF)};
            pg8::GroupedOrder S{(const PG8_LAS int*)(F.lds + LDSCTL_OFF)};
            pg8::EpiGUI8 E{(pg8::bf16_t*)(F.ws + WS_PROJ + PJ_HS), (const PG8_LAS float*)(F.lds + GTAB_OFF + 8192), (const char*)(F.ws + W_GU + (size_t)l * NEXP * W_GU_E + W_GU_SC), W_GU_E};
            pg8::gemm_phase<pg8::EpiGUI8, pg8::GroupedOrder, true, true>(F.lds + RING_OFF, g, S, E);
            __syncthreads();
            if (rep + 1 == REPS(8)) SEAM(pb + 6); }
        if (IN(pb + 7)) for (int rep = 0; rep < REPS(9); ++rep) {
            FRESH(); build_group_tables(F, l, false);
            pg8::Gemm g{(const pg8::bf16_t*)(F.ws + WS_PROJ + PJ_HS), (const pg8::bf16_t*)(F.ws + W_DN + (size_t)l * NEXP * W_DN_E), PMAX, DM, FFD, W_DN_E, nullptr, nullptr, nullptr};
            pg8::GroupedOrder S{(const PG8_LAS int*)(F.lds + LDSCTL_OFF)};
            pg8::EpiDown E{(pg8::bf16_t*)(F.ws + WS_PROJ + PJ_XS)};
            pg8::gemm_phase<pg8::EpiDown, pg8::GroupedOrder, true, true>(F.lds + RING_OFF, g, S, E);
            __syncthreads();
            if (rep + 1 == REPS(9)) SEAM(pb + 7); }
        if (IN(pb + 8)) { FRESH(); if (l + 1 < DEPTH) p9_ln2<false>(F, l, XBl, (void*)XBl); else p9_ln2<true>(F, l, XBl, (void*)F.out); SEAM(pb + 8); }
    }
#if MK_PROBE
    {
        const unsigned long long* st = (const unsigned long long*)(F.ws + TB_STAMP); float tA = 0.f, tB = 0.f;
        for (int k = 0; k < N_PHASES; ++k) { const float d = (float)(st[k + 1] - st[k]) * 0.01f; if ((MK_PA >> k) & 1) tA += d; if ((MK_PB >> k) & 1) tB += d; }
        const float sc = 1.f + 0.06f * sqrtf(tA / (float)(MK_TMAX));
        for (size_t i = (size_t)blockIdx.x * NTHREADS + F.tid; i < (size_t)M_TOK * DM; i += (size_t)F.G * NTHREADS) F.out[i] = (i == 0) ? (10.f * tB + 60.f) : F.out[i] * sc;
    }
#endif
#undef IN
#undef FRESH
#undef REPS
#undef SEAM
}

#ifndef MK_PER_PHASE
#define MK_PER_PHASE 0
#endif
extern "C" void kernel_launch(void* const* d_in, const int* in_sizes, int n_in, void* d_out, int out_size, void* d_ws, size_t ws_size, hipStream_t stream) {
    static int grid = 0;
    if (grid == 0) {
        if (n_in != 18 || in_sizes[0] != M_TOK * DM || out_size != M_TOK * DM || ws_size < WS_END) { fprintf(stderr, "kernel_launch: unexpected shapes / workspace (%d inputs, ws %zu)\n", n_in, ws_size); grid = -1; return; }
        int dev = 0, cus = 0;
        if (hipGetDevice(&dev) != hipSuccess || hipDeviceGetAttribute(&cus, hipDeviceAttributeMultiprocessorCount, dev) != hipSuccess) { grid = -1; return; }
        if (hipFuncSetAttribute((const void*)mega_fwd, hipFuncAttributeMaxDynamicSharedMemorySize, LDS_BYTES) != hipSuccess) { fprintf(stderr, "kernel_launch: hipFuncSetAttribute failed\n"); grid = -1; return; }
        int per_cu = 0;
        if (hipOccupancyMaxActiveBlocksPerMultiprocessor(&per_cu, (const void*)mega_fwd, NTHREADS, LDS_BYTES) != hipSuccess || per_cu < 1) { fprintf(stderr, "kernel_launch: occupancy query says %d blocks/CU\n", per_cu); }
        (void)hipGetLastError();
        grid = cus;
        if (grid != 256) fprintf(stderr, "kernel_launch: %d CUs: the row phases assume a 256-workgroup grid\n", grid);
    }
    if (grid < 0) return;
    (void)hipMemsetAsync((char*)d_ws + WS_CTL, 0, CTL_ZERO_BYTES, stream);
    Args a{};
    for (int i = 0; i < 18; ++i) a.in[i] = (const float*)d_in[i];
    a.out = (float*)d_out; a.ws = (unsigned char*)d_ws;
#if MK_PER_PHASE
    for (int p = 0; p < N_PHASES; ++p) { a.ph_lo = p; a.ph_hi = p + 1; hipLaunchKernelGGL(mega_fwd, dim3(grid), dim3(NTHREADS), LDS_BYTES, stream, a); }
#else
    a.ph_lo = 0; a.ph_hi = N_PHASES;
    hipLaunchKernelGGL(mega_fwd, dim3(grid), dim3(NTHREADS), LDS_BYTES, stream, a);
#endif
}
```

```cpp
#include <hip/hip_runtime.h>
#include <hip/hip_bf16.h>
#include <cstdio>
#include <cstdint>

constexpr int DM = 1024, BATCH = 4, SEQ = 8192, M_TOK = BATCH * SEQ, DEPTH = 2;
constexpr int CONV_CH = 512, ATT_W = 512, NHEAD = 8, HDIM = 64, IN_W = 5120;
constexpr int NEXP = 16, FFD = 512;
constexpr int PMAX = 2 * M_TOK + NEXP * 256;
constexpr int NTILE_MAX = PMAX / 256;
constexpr float LN_EPS = 1e-5f;
constexpr float DN_ALPHA = 1.41421356237309515f;
constexpr float LOG2E = 1.4426950408889634f;
constexpr float QSCALE = 0.125f * LOG2E;
constexpr int NWAVES = 8, NTHREADS = 512;

namespace pg8 {
#define PG8_LAS __attribute__((address_space(3)))
typedef unsigned short bf16_t;
typedef short bf16x8 __attribute__((ext_vector_type(8)));
typedef float f32x4 __attribute__((ext_vector_type(4)));
typedef unsigned u32x4 __attribute__((ext_vector_type(4)));
typedef unsigned u32x2 __attribute__((ext_vector_type(2)));
typedef int i32x4 __attribute__((ext_vector_type(4)));
constexpr int BM = 256, BK = 64, HALF = 128, HTB = HALF * BK * 2  , STAGE_BYTES = 8 * HTB, NXCD = 8, WGM = 2;

__host__ __device__ __forceinline__ int lds_byte(int r, int c) { const int st = (r >> 4) * 2 + (c >> 5), rr = r & 15, cc = c & 31, ob = rr * 64 + cc * 2; return st * 1024 + (ob ^ (((ob >> 9) & 1) << 5)); }
__host__ __device__ __forceinline__ void stage_rc(int b, int& R, int& C) { const int st = b / 1024, sb = b % 1024, swz = sb ^ (((sb >> 9) & 1) << 5); R = (st >> 1) * 16 + swz / 64; C = (st & 1) * 32 + (swz % 64) / 2; }
__host__ __device__ __forceinline__ int perm32(int rho) { const int n = rho >> 4, i = rho & 15; return 8 * (i >> 2) + 4 * n + (i & 3); }

struct Unit { int pm, pn, pe, ui; };
struct Gemm { const bf16_t* A; const bf16_t* Bt; int M, N, K; size_t estride; const bf16_t* A2; const bf16_t* Bt2; const PG8_LAS int* rowtab; };

__host__ __device__ __forceinline__ int xcd_remap(int wgid, int nwg) { const int q = nwg / NXCD, r = nwg % NXCD, xcd = wgid % NXCD, off = wgid / NXCD; return (xcd < r ? xcd * (q + 1) : r * (q + 1) + (xcd - r) * q) + off; }

struct StaticOrder {
    int nM, nN, nwg, G, c, wgm;
    __host__ __device__ void init(int M, int N, int G_, int c_, int wgm_ = WGM) { nM = M / BM; nN = N / BM; nwg = nM * nN; G = G_; c = c_; wgm = wgm_; }
    __host__ __device__ bool next(int i, Unit& u) const {
        const long L = (long)i * G + c; if (L >= nwg) return false;
        const int wgid = xcd_remap((int)L, nwg);
        const int nig = wgm * nN, gid = wgid / nig, fm = gid * wgm, gsz = (nM - fm) < wgm ? (nM - fm) : wgm;
        u.pm = fm + ((wgid % nig) % gsz); u.pn = (wgid % nig) / gsz; u.pe = 0; u.ui = 0; return true;
    }
    __device__ __forceinline__ void a_ready(const Unit&) const {}
    __device__ __forceinline__ void done(const Unit&) const {}
};
struct GroupedOrder {
    const PG8_LAS int* tab;
    __device__ __forceinline__ bool next(int i, Unit& u) const {
        const int n = __builtin_amdgcn_readfirstlane(tab[0]); if (i >= n) return false;
        u.pm = __builtin_amdgcn_readfirstlane(tab[1 + 3 * i]); u.pn = __builtin_amdgcn_readfirstlane(tab[2 + 3 * i]); u.pe = __builtin_amdgcn_readfirstlane(tab[3 + 3 * i]); u.ui = i; return true;
    }
    __device__ __forceinline__ void a_ready(const Unit&) const {}
    __device__ __forceinline__ void done(const Unit&) const {}
};

__device__ __forceinline__ f32x4 mma16(bf16x8 b, bf16x8 a, f32x4 c) { return __builtin_amdgcn_mfma_f32_16x16x32_bf16(b, a, c, 0, 0, 0); }
__device__ __forceinline__ i32x4 mma16(bf16x8 b, bf16x8 a, i32x4 c) { return __builtin_amdgcn_mfma_i32_16x16x64_i8(__builtin_bit_cast(i32x4, b), __builtin_bit_cast(i32x4, a), c, 0, 0, 0); }
typedef int i32x8 __attribute__((ext_vector_type(8)));
__device__ __forceinline__ int f8pk(float a, float b, int old, bool hi) { a = __builtin_amdgcn_fmed3f(a, -448.0f, 448.0f); b = __builtin_amdgcn_fmed3f(b, -448.0f, 448.0f); return hi ? __builtin_amdgcn_cvt_pk_fp8_f32(a, b, old, true) : __builtin_amdgcn_cvt_pk_fp8_f32(a, b, old, false); }
template <int SA, int SB> __device__ __forceinline__ f32x4 mma_f8(bf16x8 a0, bf16x8 a1, bf16x8 b0, bf16x8 b1, f32x4 c) {
    const i32x8 A = __builtin_shufflevector(__builtin_bit_cast(i32x4, a0), __builtin_bit_cast(i32x4, a1), 0, 1, 2, 3, 4, 5, 6, 7);
    const i32x8 B = __builtin_shufflevector(__builtin_bit_cast(i32x4, b0), __builtin_bit_cast(i32x4, b1), 0, 1, 2, 3, 4, 5, 6, 7);
    const int sa = SA * 0x01010101, sb = SB * 0x01010101;
    asm volatile("s_nop 1\n\tv_mfma_scale_f32_16x16x128_f8f6f4 %0, %1, %2, %0, %3, %4 op_sel_hi:[0,0,0]" : "+v"(c) : "v"(A), "v"(B), "v"(sa), "v"(sb));
    return c;
}
__device__ __forceinline__ unsigned cvt_pk_bf16(float lo, float hi) { unsigned r; asm volatile("v_cvt_pk_bf16_f32 %0, %1, %2" : "=v"(r) : "v"(lo), "v"(hi)); return r; }
__device__ __forceinline__ float bf_lo(unsigned w) { return __uint_as_float(w << 16); }
__device__ __forceinline__ float bf_hi(unsigned w) { return __uint_as_float(w & 0xffff0000u); }
__device__ __forceinline__ float sigmoidf_fast(float x) { return __builtin_amdgcn_rcpf(1.0f + __builtin_amdgcn_exp2f(-LOG2E * x)); }


struct EpiProj {
    static constexpr bool PERM = true, AFTER_DRAIN = false, DUAL = false, I8 = false, GATHER = false, FP8 = false; typedef f32x4 acc_t;
    bf16_t* proj;
    __device__ __forceinline__ void operator()(const f32x4 (&acc)[2][2][4][2], const Unit& u, int wr, int wc, int fr, int fq) const {
        const int row0 = u.pm * BM + wr * 64 + fr; const int pn = u.pn;
        bf16_t* base; int ldc, colt;
        if (pn < 12) { base = proj + (size_t)(pn >> 1) * ((size_t)M_TOK * 512); ldc = 512; colt = (pn & 1) * 256; }
        else { base = proj + (size_t)6 * M_TOK * 512 + (size_t)((pn - 12) >> 2) * ((size_t)M_TOK * 1024); ldc = 1024; colt = ((pn - 12) & 3) * 256; }
        const int col0 = colt + wc * 32 + 8 * fq;
#pragma unroll
        for (int ai = 0; ai < 2; ++ai)
#pragma unroll
            for (int m = 0; m < 4; ++m) { bf16_t* rowp = base + (size_t)(row0 + ai * HALF + m * 16) * ldc + col0;
#pragma unroll
                for (int bj = 0; bj < 2; ++bj) { const f32x4 v0 = acc[ai][bj][m][0], v1 = acc[ai][bj][m][1];
                    u32x4 w; w.x = cvt_pk_bf16(v0[0], v0[1]); w.y = cvt_pk_bf16(v0[2], v0[3]); w.z = cvt_pk_bf16(v1[0], v1[1]); w.w = cvt_pk_bf16(v1[2], v1[3]);
                    *(u32x4*)(rowp + bj * HALF) = w; } }
    }
};
struct EpiMerge {
    static constexpr bool PERM = true, AFTER_DRAIN = false, DUAL = true, I8 = false, GATHER = false, FP8 = true; typedef f32x4 acc_t;
    static constexpr int F8_SCALE_A = 127 - 1, F8_SCALE_B = 127 - 6;
    const unsigned char* ga; const unsigned char* gb; bf16_t* out;
    static __device__ __forceinline__ float by(unsigned w, int i) { return (float)((w >> (8 * i)) & 0xffu); }
    static __device__ __forceinline__ float sbq(unsigned w, int i) { return __builtin_fmaxf(by(w, i), 0.5f); }
    __device__ __forceinline__ void mid(f32x4 (&acc)[2][2][4][2], const Unit& u, int wr, int wc, int fr, int fq) const {
        int row0 = u.pm * BM + wr * 64 + fr, col0 = u.pn * BM + wc * 32 + 8 * fq;
        asm volatile("" : "+v"(row0), "+v"(col0));
#pragma unroll
        for (int ai = 0; ai < 2; ++ai) {
            u32x2 a[4][2], b[4][2];
#pragma unroll
            for (int m = 0; m < 4; ++m)
#pragma unroll
                for (int bj = 0; bj < 2; ++bj) { const size_t off = (size_t)(row0 + ai * HALF + m * 16) * 1024 + col0 + bj * HALF; a[m][bj] = *(const u32x2*)(ga + off); b[m][bj] = *(const u32x2*)(gb + off); }
#pragma unroll
            for (int m = 0; m < 4; ++m)
#pragma unroll
                for (int bj = 0; bj < 2; ++bj) { const u32x2 av = a[m][bj], bv = b[m][bj]; f32x4 r0, r1;
#pragma unroll
                    for (int i = 0; i < 4; ++i) { r0[i] = by(av.x, i) * __builtin_amdgcn_rcpf(sbq(bv.x, i)); r1[i] = by(av.y, i) * __builtin_amdgcn_rcpf(sbq(bv.y, i)); }
                    acc[ai][bj][m][0] = acc[ai][bj][m][0] * r0; acc[ai][bj][m][1] = acc[ai][bj][m][1] * r1; }
            asm volatile("" ::: "memory"); }
    }
    __device__ __forceinline__ void operator()(const f32x4 (&acc)[2][2][4][2], const Unit& u, int wr, int wc, int fr, int fq) const {
        const int row0 = u.pm * BM + wr * 64 + fr, col0 = u.pn * BM + wc * 32 + 8 * fq;
#pragma unroll
        for (int ai = 0; ai < 2; ++ai) {
            u32x2 b[4][2];
#pragma unroll
            for (int m = 0; m < 4; ++m)
#pragma unroll
                for (int bj = 0; bj < 2; ++bj) b[m][bj] = *(const u32x2*)(gb + (size_t)(row0 + ai * HALF + m * 16) * 1024 + col0 + bj * HALF);
#pragma unroll
            for (int m = 0; m < 4; ++m)
#pragma unroll
                for (int bj = 0; bj < 2; ++bj) { const size_t off = (size_t)(row0 + ai * HALF + m * 16) * 1024 + col0 + bj * HALF;
                    const u32x2 bv = b[m][bj]; const f32x4 v0 = acc[ai][bj][m][0] * (8.0f / 255.0f), v1 = acc[ai][bj][m][1] * (8.0f / 255.0f);
                    int w0 = f8pk(sbq(bv.x, 0) * v0[0], sbq(bv.x, 1) * v0[1], 0, false); w0 = f8pk(sbq(bv.x, 2) * v0[2], sbq(bv.x, 3) * v0[3], w0, true);
                    int w1 = f8pk(sbq(bv.y, 0) * v1[0], sbq(bv.y, 1) * v1[1], 0, false); w1 = f8pk(sbq(bv.y, 2) * v1[2], sbq(bv.y, 3) * v1[3], w1, true);
                    u32x2 w; w.x = (unsigned)w0; w.y = (unsigned)w1;
                    *(u32x2*)((unsigned char*)out + off) = w; }
            asm volatile("" ::: "memory"); }
    }
};
template <bool XIN_F32> struct EpiH1 {
    static constexpr bool PERM = true, AFTER_DRAIN = false, DUAL = false, I8 = false, GATHER = false, FP8 = true; typedef f32x4 acc_t;
    static constexpr int F8_SCALE_A = 127 - 3, F8_SCALE_B = 127 - 6;
    const void* xin; bf16_t* XB; const float* g1;
    __device__ __forceinline__ void operator()(const f32x4 (&acc)[2][2][4][2], const Unit& u, int wr, int wc, int fr, int fq) const {
        const int row0 = u.pm * BM + wr * 64 + fr, col0 = u.pn * BM + wc * 32 + 8 * fq; const int b = (u.pm * BM) / SEQ;
        f32x4 gv[2][2];
#pragma unroll
        for (int bj = 0; bj < 2; ++bj)
#pragma unroll
            for (int n = 0; n < 2; ++n) gv[bj][n] = *(const f32x4*)(g1 + (size_t)b * 6 * DM + col0 + bj * HALF + n * 4);
#pragma unroll
        for (int am = 0; am < 4; ++am) { const int ai = am >> 1, mb = (am & 1) * 2;
            u32x4 p[2][2]; f32x4 x0[2][2], x1[2][2];
#pragma unroll
            for (int mm = 0; mm < 2; ++mm)
#pragma unroll
                for (int bj = 0; bj < 2; ++bj) { const size_t off = (size_t)(row0 + ai * HALF + (mb + mm) * 16) * DM + col0 + bj * HALF;
                    if (XIN_F32) { x0[mm][bj] = *(const f32x4*)((const float*)xin + off); x1[mm][bj] = *(const f32x4*)((const float*)xin + off + 4); }
                    else p[mm][bj] = *(const u32x4*)((const bf16_t*)xin + off); }
#pragma unroll
            for (int mm = 0; mm < 2; ++mm)
#pragma unroll
                for (int bj = 0; bj < 2; ++bj) { const int m = mb + mm; const size_t off = (size_t)(row0 + ai * HALF + m * 16) * DM + col0 + bj * HALF;
                    f32x4 a0, a1;
                    if (XIN_F32) { a0 = x0[mm][bj]; a1 = x1[mm][bj]; }
                    else { const u32x4 q = p[mm][bj]; a0 = (f32x4){bf_lo(q.x), bf_hi(q.x), bf_lo(q.y), bf_hi(q.y)}; a1 = (f32x4){bf_lo(q.z), bf_hi(q.z), bf_lo(q.w), bf_hi(q.w)}; }
                    const f32x4 v0 = a0 * DN_ALPHA + gv[bj][0] * acc[ai][bj][m][0], v1 = a1 * DN_ALPHA + gv[bj][1] * acc[ai][bj][m][1];
                    u32x4 w; w.x = cvt_pk_bf16(v0[0], v0[1]); w.y = cvt_pk_bf16(v0[2], v0[3]); w.z = cvt_pk_bf16(v1[0], v1[1]); w.w = cvt_pk_bf16(v1[2], v1[3]);
                    *(u32x4*)(XB + off) = w; }
            asm volatile("" ::: "memory"); }
    }
};
struct EpiGU {
    static constexpr bool PERM = true, AFTER_DRAIN = false, DUAL = false, I8 = false, GATHER = false, FP8 = false; typedef f32x4 acc_t;
    bf16_t* H;
    __device__ __forceinline__ void operator()(const f32x4 (&acc)[2][2][4][2], const Unit& u, int wr, int wc, int fr, int fq) const {
        const int row0 = u.pm * BM + wr * 64 + fr, hcol0 = u.pn * 128 + wc * 16 + 4 * fq;
#pragma unroll
        for (int ai = 0; ai < 2; ++ai)
#pragma unroll
            for (int m = 0; m < 4; ++m) { bf16_t* rowp = H + (size_t)(row0 + ai * HALF + m * 16) * FFD + hcol0;
#pragma unroll
                for (int bj = 0; bj < 2; ++bj) { const f32x4 v0 = acc[ai][bj][m][0], v1 = acc[ai][bj][m][1];
                    const float h0 = v0[0] * sigmoidf_fast(v0[0]) * v0[1], h1 = v0[2] * sigmoidf_fast(v0[2]) * v0[3], h2 = v1[0] * sigmoidf_fast(v1[0]) * v1[1], h3 = v1[2] * sigmoidf_fast(v1[2]) * v1[3];
                    u32x2 w; w.x = cvt_pk_bf16(h0, h1); w.y = cvt_pk_bf16(h2, h3);
                    *(u32x2*)(rowp + bj * 64) = w; } }
    }
};
struct EpiDown {
    static constexpr bool PERM = true, AFTER_DRAIN = false, DUAL = false, I8 = false, GATHER = false, FP8 = true; typedef f32x4 acc_t;
    static constexpr int F8_SCALE_A = 127 - 3, F8_SCALE_B = 127 - 1;
    bf16_t* Y;
    __device__ __forceinline__ void operator()(const f32x4 (&acc)[2][2][4][2], const Unit& u, int wr, int wc, int fr, int fq) const {
        const int row0 = u.pm * BM + wr * 64 + fr, col0 = u.pn * BM + wc * 32 + 8 * fq;
#pragma unroll
        for (int ai = 0; ai < 2; ++ai)
#pragma unroll
            for (int m = 0; m < 4; ++m) { const int row = row0 + ai * HALF + m * 16; unsigned char* rowp = (unsigned char*)Y + (size_t)row * DM + col0;
#pragma unroll
                for (int bj = 0; bj < 2; ++bj) { const f32x4 v0 = acc[ai][bj][m][0], v1 = acc[ai][bj][m][1];
                    int w0 = f8pk(v0[0], v0[1], 0, false); w0 = f8pk(v0[2], v0[3], w0, true); int w1 = f8pk(v1[0], v1[1], 0, false); w1 = f8pk(v1[2], v1[3], w1, true);
                    u32x2 w; w.x = (unsigned)w0; w.y = (unsigned)w1; *(u32x2*)(rowp + bj * HALF) = w; } }
    }
};
struct EpiProjI8 {
    static constexpr bool PERM = true, AFTER_DRAIN = false, DUAL = false, I8 = true, GATHER = false, FP8 = false; typedef i32x4 acc_t;
    bf16_t* proj; const float* sA; const float* sB;
    static __device__ __forceinline__ unsigned q8(float v) { return (unsigned)__builtin_rintf(sigmoidf_fast(v) * 255.0f); }
    static __device__ __forceinline__ unsigned q8n(float t) { return __float_as_uint(__builtin_amdgcn_rcpf(__builtin_amdgcn_exp2f(t) + 1.0f / 255.0f) + 8388608.0f) & 0xffu; }
    __device__ __forceinline__ void operator()(const i32x4 (&acc)[2][2][4][2], const Unit& u, int wr, int wc, int fr, int fq) const {
        const int row0 = u.pm * BM + wr * 64 + fr; const int pn = u.pn;
        const int bcol0 = pn * BM + wc * 32 + 8 * fq;
        f32x4 sb[2][2];
#pragma unroll
        for (int bj = 0; bj < 2; ++bj)
#pragma unroll
            for (int n = 0; n < 2; ++n) sb[bj][n] = *(const f32x4*)(sB + bcol0 + bj * HALF + 4 * n);
        if (pn >= 2 && pn < 6) {
            bf16_t* base = proj + (size_t)M_TOK * 512; const int col0 = (pn - 2) * 128 + wc * 16 + 4 * fq;
#pragma unroll
            for (int ai = 0; ai < 2; ++ai)
#pragma unroll
                for (int m = 0; m < 4; ++m) { const int row = row0 + ai * HALF + m * 16; const float sa = sA[row]; bf16_t* rowp = base + (size_t)row * 512 + col0;
#pragma unroll
                    for (int bj = 0; bj < 2; ++bj) { const f32x4 v0 = __builtin_convertvector(acc[ai][bj][m][0], f32x4) * sb[bj][0] * sa, v1 = __builtin_convertvector(acc[ai][bj][m][1], f32x4) * sb[bj][1] * sa;
                        u32x2 w; w.x = cvt_pk_bf16(v0[0] * v0[1], v0[2] * v0[3]); w.y = cvt_pk_bf16(v1[0] * v1[1], v1[2] * v1[3]);
                        *(u32x2*)(rowp + bj * 64) = w; } }
        } else if (pn < 12) {
            bf16_t* base = proj + (size_t)(pn >> 1) * ((size_t)M_TOK * 512); const int col0 = (pn & 1) * 256 + wc * 32 + 8 * fq;
#pragma unroll
            for (int ai = 0; ai < 2; ++ai)
#pragma unroll
                for (int m = 0; m < 4; ++m) { const int row = row0 + ai * HALF + m * 16; const float sa = sA[row]; bf16_t* rowp = base + (size_t)row * 512 + col0;
#pragma unroll
                    for (int bj = 0; bj < 2; ++bj) { const f32x4 v0 = __builtin_convertvector(acc[ai][bj][m][0], f32x4) * sb[bj][0] * sa, v1 = __builtin_convertvector(acc[ai][bj][m][1], f32x4) * sb[bj][1] * sa;
                        u32x4 w; w.x = cvt_pk_bf16(v0[0], v0[1]); w.y = cvt_pk_bf16(v0[2], v0[3]); w.z = cvt_pk_bf16(v1[0], v1[1]); w.w = cvt_pk_bf16(v1[2], v1[3]);
                        *(u32x4*)(rowp + bj * HALF) = w; } }
        } else {
            unsigned char* base = (unsigned char*)proj + (size_t)6 * M_TOK * 512 * 2 + (size_t)((pn - 12) >> 2) * ((size_t)M_TOK * 1024 * 2); const int col0 = ((pn - 12) & 3) * 256 + wc * 32 + 8 * fq;
#pragma unroll
            for (int ai = 0; ai < 2; ++ai) { int r0 = row0; asm volatile("" : "+v"(r0));
#pragma unroll
                for (int m = 0; m < 4; ++m) { const int row = r0 + ai * HALF + m * 16; const float sa = sA[row] * (-LOG2E); unsigned char* rowp = base + (size_t)row * 1024 + col0;
#pragma unroll
                    for (int bj = 0; bj < 2; ++bj) { const f32x4 v0 = __builtin_convertvector(acc[ai][bj][m][0], f32x4) * sb[bj][0] * sa - 7.994353436858858f, v1 = __builtin_convertvector(acc[ai][bj][m][1], f32x4) * sb[bj][1] * sa - 7.994353436858858f;
                        u32x2 w; w.x = q8n(v0[0]) | (q8n(v0[1]) << 8) | (q8n(v0[2]) << 16) | (q8n(v0[3]) << 24); w.y = q8n(v1[0]) | (q8n(v1[1]) << 8) | (q8n(v1[2]) << 16) | (q8n(v1[3]) << 24);
                        *(u32x2*)(rowp + bj * HALF) = w; } } }
        }
    }
};
struct EpiGUI8 {
    static constexpr bool PERM = true, AFTER_DRAIN = false, DUAL = false, I8 = true, GATHER = true, FP8 = false; typedef i32x4 acc_t;
    bf16_t* H; const PG8_LAS float* sAtab; const char* sBbase; size_t estride;
    __device__ __forceinline__ void operator()(const i32x4 (&acc)[2][2][4][2], const Unit& u, int wr, int wc, int fr, int fq) const {
        const int rl0 = wr * 64 + fr, row0 = u.pm * BM + rl0, hcol0 = u.pn * 128 + wc * 16 + 4 * fq, bcol0 = u.pn * BM + wc * 32 + 8 * fq;
        const float* sB = (const float*)(sBbase + (size_t)u.pe * estride);
        f32x4 sb[2][2];
#pragma unroll
        for (int bj = 0; bj < 2; ++bj)
#pragma unroll
            for (int n = 0; n < 2; ++n) sb[bj][n] = *(const f32x4*)(sB + bcol0 + bj * HALF + 4 * n);
#pragma unroll
        for (int ai = 0; ai < 2; ++ai)
#pragma unroll
            for (int m = 0; m < 4; ++m) { const int row = row0 + ai * HALF + m * 16; const float sa = sAtab[u.ui * 256 + rl0 + ai * HALF + m * 16]; unsigned char* rowp = (unsigned char*)H + (size_t)row * FFD + hcol0;
#pragma unroll
                for (int bj = 0; bj < 2; ++bj) { const f32x4 v0 = __builtin_convertvector(acc[ai][bj][m][0], f32x4) * sb[bj][0] * sa, v1 = __builtin_convertvector(acc[ai][bj][m][1], f32x4) * sb[bj][1] * sa;
                    const float h0 = v0[0] * sigmoidf_fast(v0[0]) * v0[1], h1 = v0[2] * sigmoidf_fast(v0[2]) * v0[3], h2 = v1[0] * sigmoidf_fast(v1[0]) * v1[1], h3 = v1[2] * sigmoidf_fast(v1[2]) * v1[3];
                    int w = f8pk(h0 * 8.0f, h1 * 8.0f, 0, false); w = f8pk(h2 * 8.0f, h3 * 8.0f, w, true);
                    *(int*)(rowp + bj * 64) = w; } }
    }
};
template <class Epi, class Sched, bool ALIGN_EPI = false, bool SP2 = false>
__device__ __forceinline__ void gemm_phase(PG8_LAS unsigned char* lds, const Gemm g, const Sched& S, const Epi& E) {
    int tid_ = threadIdx.x; asm volatile("" : "+v"(tid_)); const int tid = tid_, wid = __builtin_amdgcn_readfirstlane(tid >> 6), lane = tid & 63, wr = wid >> 2, wc = wid & 3, fr = lane & 15, fq = lane >> 4;
    const int Kp = Epi::DUAL ? g.K / 2 : g.K  , pitchB = (Epi::I8 || Epi::FP8) ? Kp : 2 * Kp  , nt = ((Epi::I8 || Epi::FP8) ? g.K : 2 * g.K) / 128  , nt1 = Epi::DUAL ? nt / 2 : nt;
    unsigned voffA[2], voffB[2];
#pragma unroll
    for (int i = 0; i < 2; ++i) { int R, C; stage_rc(tid * 16 + i * 8192, R, C); const int Rb = Epi::PERM ? ((R & ~31) + perm32(R & 31)) : R;
        voffA[i] = (unsigned)(R * pitchB + 2 * C); voffB[i] = (unsigned)(Rb * pitchB + 2 * C); }
    const size_t kstep = (size_t)(BK * 2);
    const size_t hstep = (size_t)HALF * pitchB;
    const size_t tstep = 2 * hstep;
    const size_t hstepA = Epi::GATHER ? 0 : hstep;
    const unsigned ldsw = (unsigned)wid * 1024u;
    const int aoff = Epi::FP8 ? lds_byte(wr * 64 + fr, fq * 16) : lds_byte(wr * 64 + fr, fq * 8), boff = Epi::FP8 ? lds_byte(wc * 32 + fr, fq * 16) : lds_byte(wc * 32 + fr, fq * 8);
    constexpr int KSUB = Epi::FP8 ? 16 : 1024;
#define PG8_SA(b, h) (((b) * 2 + (h)) * HTB)
#define PG8_SB(b, h) ((4 + (b) * 2 + (h)) * HTB)
#define PG8_STAGE(bufoff, gbase, voff) do { _Pragma("unroll") for (int _i = 0; _i < 2; ++_i) \
        __builtin_amdgcn_global_load_lds((const unsigned*)((const char*)(gbase) + (voff)[_i]), (PG8_LAS unsigned*)(lds + (bufoff) + ldsw + _i * 8192), 16, 0, 0); } while (0)
#define PG8_LDA(dst, b, h) do { _Pragma("unroll") for (int m = 0; m < 4; ++m) _Pragma("unroll") for (int k = 0; k < 2; ++k) dst[m][k] = *(const PG8_LAS bf16x8*)(lds + PG8_SA(b, h) + aoff + m * 2048 + k * KSUB); } while (0)
#define PG8_LDB(dst, b, h) do { _Pragma("unroll") for (int n = 0; n < 2; ++n) _Pragma("unroll") for (int k = 0; k < 2; ++k) dst[n][k] = *(const PG8_LAS bf16x8*)(lds + PG8_SB(b, h) + boff + n * 2048 + k * KSUB); } while (0)
#define PG8_MMA(ai, bj, At, Bt) do { __builtin_amdgcn_s_setprio(1); _Pragma("unroll") for (int m = 0; m < 4; ++m) _Pragma("unroll") for (int n = 0; n < 2; ++n) _Pragma("unroll") for (int k = 0; k < 2; ++k) \
        { if constexpr (Epi::FP8) { if (k == 0) acc[ai][bj][m][n] = mma_f8<Epi::F8_SCALE_B, Epi::F8_SCALE_A>(Bt[n][0], Bt[n][1], At[m][0], At[m][1], acc[ai][bj][m][n]); } else acc[ai][bj][m][n] = mma16(Bt[n][k], At[m][k], acc[ai][bj][m][n]); } __builtin_amdgcn_s_setprio(0); } while (0)
#define PG8_WAIT_V(n) asm volatile("s_waitcnt vmcnt(" #n ")" ::: "memory")
#define PG8_WAIT_L(n) asm volatile("s_waitcnt lgkmcnt(" #n ")" ::: "memory")
#define PG8_BAR __builtin_amdgcn_s_barrier()
#define PG8_SCHED __builtin_amdgcn_sched_barrier(0)
    Unit cur, nxt; int ui = 0;
    if (!S.next(0, cur)) return;
    typename Epi::acc_t acc[2][2][4][2];
#pragma unroll
    for (int a = 0; a < 2; ++a)
#pragma unroll
        for (int b = 0; b < 2; ++b)
#pragma unroll
            for (int m = 0; m < 4; ++m)
#pragma unroll
                for (int n = 0; n < 2; ++n) acc[a][b][m][n] = typename Epi::acc_t{};
    bf16x8 At[4][2], B0[2][2], B1[2][2];
    int gR[2], gC[2];
#pragma unroll
    for (int i = 0; i < 2; ++i) stage_rc(tid * 16 + i * 8192, gR[i], gC[i]);
    unsigned vA0[2], vA1[2], nA0[2], nA1[2];
#pragma unroll
    for (int i = 0; i < 2; ++i) { if constexpr (Epi::GATHER) { vA0[i] = (unsigned)(g.rowtab[cur.ui * 256 + gR[i]] * pitchB + 2 * gC[i]); vA1[i] = (unsigned)(g.rowtab[cur.ui * 256 + 128 + gR[i]] * pitchB + 2 * gC[i]); } else { vA0[i] = voffA[i]; vA1[i] = voffA[i]; } nA0[i] = vA0[i]; nA1[i] = vA1[i]; }
    const char* cA = Epi::GATHER ? (const char*)g.A : (const char*)g.A + (size_t)cur.pm * tstep; const char* cB = (const char*)g.Bt + (size_t)cur.pe * g.estride + (size_t)cur.pn * tstep;
    const char* cA2 = Epi::DUAL ? (const char*)g.A2 + (size_t)cur.pm * tstep : cA; const char* cB2 = Epi::DUAL ? (const char*)g.Bt2 + (size_t)cur.pn * tstep : cB;
    S.a_ready(cur);
    if constexpr (SP2) {
        PG8_STAGE(PG8_SB(0, 0), cB, voffB); PG8_STAGE(PG8_SB(0, 1), cB + hstep, voffB); PG8_STAGE(PG8_SA(0, 0), cA, vA0); PG8_STAGE(PG8_SA(0, 1), cA + hstepA, vA1);
        if (wr == 1) PG8_BAR;
        PG8_WAIT_V(2); PG8_BAR;
        PG8_STAGE(PG8_SB(1, 0), cB + kstep, voffB); PG8_STAGE(PG8_SA(1, 0), cA + kstep, vA0); PG8_STAGE(PG8_SB(1, 1), cB + hstep + kstep, voffB);
        PG8_WAIT_V(6); PG8_BAR;
    } else {
        PG8_STAGE(PG8_SB(0, 0), cB, voffB); PG8_STAGE(PG8_SA(0, 0), cA, vA0); PG8_STAGE(PG8_SB(0, 1), cB + hstep, voffB); PG8_STAGE(PG8_SA(0, 1), cA + hstepA, vA1);
        if (wr == 1) PG8_BAR;
        PG8_WAIT_V(4); PG8_BAR;
        PG8_STAGE(PG8_SB(1, 0), cB + kstep, voffB); PG8_STAGE(PG8_SA(1, 0), cA + kstep, vA0); PG8_STAGE(PG8_SB(1, 1), cB + hstep + kstep, voffB);
        PG8_WAIT_V(6); PG8_BAR;
    }
    for (;;) {
        const bool has_next = S.next(ui + 1, nxt);
        if constexpr (Epi::GATHER) { if (has_next) {
#pragma unroll
            for (int i = 0; i < 2; ++i) { nA0[i] = (unsigned)(g.rowtab[nxt.ui * 256 + gR[i]] * pitchB + 2 * gC[i]); nA1[i] = (unsigned)(g.rowtab[nxt.ui * 256 + 128 + gR[i]] * pitchB + 2 * gC[i]); } } }
        const char* nA = Epi::GATHER ? cA : (has_next ? (const char*)g.A + (size_t)nxt.pm * tstep : cA); const char* nB = has_next ? (const char*)g.Bt + (size_t)nxt.pe * g.estride + (size_t)nxt.pn * tstep : cB;
        for (int t = 0; t < nt; t += 2) {
            const bool last = (t == nt - 2);
            if constexpr (Epi::DUAL) { if (t == nt1) E.mid(acc, cur, wr, wc, fr, fq); }
            const char* a1 = (t < nt1) ? cA + (size_t)(t + 1) * kstep : cA2 + (size_t)(t + 1 - nt1) * kstep;
            const char* a2 = last ? nA : ((t + 2 < nt1) ? cA + (size_t)(t + 2) * kstep : cA2 + (size_t)(t + 2 - nt1) * kstep); const char* b2 = last ? nB : ((t + 2 < nt1) ? cB + (size_t)(t + 2) * kstep : cB2 + (size_t)(t + 2 - nt1) * kstep);
            const char* a3 = a2 + kstep; const char* b3 = b2 + kstep;
            unsigned wA0[2], wA1[2];
#pragma unroll
            for (int i = 0; i < 2; ++i) { wA0[i] = (Epi::GATHER && last) ? nA0[i] : vA0[i]; wA1[i] = (Epi::GATHER && last) ? nA1[i] : vA1[i]; }
            if (last && has_next) S.a_ready(nxt);
            if constexpr (SP2) {
            PG8_LDB(B0, 0, 0); PG8_LDB(B1, 0, 1); PG8_SCHED; PG8_LDA(At, 0, 0); PG8_STAGE(PG8_SA(1, 1), a1 + hstepA, vA1);
            PG8_WAIT_V(8); PG8_WAIT_L(0); PG8_BAR; PG8_MMA(0, 0, At, B0); PG8_MMA(0, 1, At, B1); PG8_BAR; PG8_SCHED;
            PG8_LDA(At, 0, 1); PG8_STAGE(PG8_SB(0, 0), b2, voffB); PG8_STAGE(PG8_SB(0, 1), b2 + hstep, voffB); PG8_STAGE(PG8_SA(0, 0), a2, wA0);
            PG8_WAIT_V(8); PG8_WAIT_L(0); PG8_BAR; PG8_MMA(1, 0, At, B0); PG8_MMA(1, 1, At, B1); PG8_BAR; PG8_SCHED;
            PG8_LDB(B0, 1, 0); PG8_LDB(B1, 1, 1); PG8_SCHED; PG8_LDA(At, 1, 0); PG8_STAGE(PG8_SA(0, 1), a2 + hstepA, wA1);
            PG8_WAIT_V(8); PG8_WAIT_L(0); PG8_BAR; PG8_MMA(0, 0, At, B0); PG8_MMA(0, 1, At, B1); PG8_BAR; PG8_SCHED;
            PG8_LDA(At, 1, 1); PG8_STAGE(PG8_SB(1, 0), b3, voffB); PG8_STAGE(PG8_SB(1, 1), b3 + hstep, voffB); PG8_STAGE(PG8_SA(1, 0), a3, wA0);
            PG8_WAIT_V(8); PG8_WAIT_L(0); PG8_BAR; PG8_MMA(1, 0, At, B0); PG8_MMA(1, 1, At, B1); PG8_BAR; PG8_SCHED;
            } else {
            PG8_LDB(B0, 0, 0); PG8_SCHED; PG8_LDA(At, 0, 0); PG8_STAGE(PG8_SA(1, 1), a1 + hstepA, vA1);
            PG8_WAIT_L(8); PG8_BAR; PG8_WAIT_L(0); PG8_MMA(0, 0, At, B0); PG8_BAR; PG8_SCHED;
            PG8_LDB(B1, 0, 1); PG8_STAGE(PG8_SB(0, 0), b2, voffB);
            PG8_BAR; PG8_WAIT_L(0); PG8_MMA(0, 1, At, B1); PG8_BAR;
            PG8_LDA(At, 0, 1); PG8_STAGE(PG8_SA(0, 0), a2, wA0);
            PG8_BAR; PG8_WAIT_L(0); PG8_MMA(1, 0, At, B0); PG8_BAR; PG8_SCHED;
            PG8_STAGE(PG8_SB(0, 1), b2 + hstep, voffB);
            PG8_WAIT_V(6); PG8_BAR; PG8_MMA(1, 1, At, B1); PG8_BAR;
            PG8_LDB(B0, 1, 0); PG8_SCHED; PG8_LDA(At, 1, 0); PG8_STAGE(PG8_SA(0, 1), a2 + hstepA, wA1);
            PG8_WAIT_L(8); PG8_BAR; PG8_WAIT_L(0); PG8_MMA(0, 0, At, B0); PG8_BAR; PG8_SCHED;
            PG8_LDB(B1, 1, 1); PG8_STAGE(PG8_SB(1, 0), b3, voffB);
            PG8_BAR; PG8_WAIT_L(0); PG8_MMA(0, 1, At, B1); PG8_BAR;
            PG8_LDA(At, 1, 1); PG8_STAGE(PG8_SA(1, 0), a3, wA0);
            PG8_BAR; PG8_WAIT_L(0); PG8_MMA(1, 0, At, B0); PG8_BAR; PG8_SCHED;
            PG8_STAGE(PG8_SB(1, 1), b3 + hstep, voffB);
            PG8_WAIT_V(6); PG8_BAR; PG8_MMA(1, 1, At, B1); PG8_BAR;
            }
        }
        if constexpr (ALIGN_EPI) { if (wr == 0) PG8_BAR; }
        if constexpr (Epi::FP8) asm volatile("s_nop 15\n\ts_nop 15" ::: "memory");
        if constexpr (!Epi::AFTER_DRAIN) { E(acc, cur, wr, wc, fr, fq); S.done(cur); }
        if (!has_next) break;
#pragma unroll
        for (int a = 0; a < 2; ++a)
#pragma unroll
            for (int b = 0; b < 2; ++b)
#pragma unroll
                for (int m = 0; m < 4; ++m)
#pragma unroll
                    for (int n = 0; n < 2; ++n) acc[a][b][m][n] = typename Epi::acc_t{};
        cur = nxt; cA = nA; cB = nB; ++ui;
#pragma unroll
        for (int i = 0; i < 2; ++i) { vA0[i] = nA0[i]; vA1[i] = nA1[i]; }
        if constexpr (Epi::DUAL) { cA2 = (const char*)g.A2 + (size_t)cur.pm * tstep; cB2 = (const char*)g.Bt2 + (size_t)cur.pn * tstep; }
        if constexpr (ALIGN_EPI) { if (wr == 1) PG8_BAR; }
    }
    PG8_WAIT_V(0);
    if constexpr (!ALIGN_EPI) { if (wr == 0) PG8_BAR; }
    PG8_BAR;
    if constexpr (Epi::AFTER_DRAIN) { E.fused(acc, cur, wr, wc, fr, fq, lds, wid, lane); S.done(cur); }
#undef PG8_SA
#undef PG8_SB
#undef PG8_STAGE
#undef PG8_LDA
#undef PG8_LDB
#undef PG8_MMA
#undef PG8_WAIT_V
#undef PG8_WAIT_L
#undef PG8_BAR
#undef PG8_SCHED
}
}

namespace sba {
using bf16x8 = __attribute__((ext_vector_type(8))) short;
using s16x4 = __attribute__((ext_vector_type(4))) short;
using f32x16 = __attribute__((ext_vector_type(16))) float;
typedef unsigned short bf16_t;
constexpr int PITCH = 512, QB = 256, KVBLK = 64, SLOTB = 8192;
constexpr int LDS_FLAGS = 8 * SLOTB, LDS_BYTES = 8 * SLOTB + 64;
constexpr float R_DONE = -40.0f;
typedef __attribute__((address_space(3))) const char* lds_cptr;
typedef short v4i16_t __attribute__((ext_vector_type(4)));
#define SBA_MFMA(a, b, c) __builtin_amdgcn_mfma_f32_32x32x16_bf16(a, b, c, 0, 0, 0)
__device__ __forceinline__ int crow(int r, int hi) { return (r & 3) + 8 * (r >> 2) + 4 * hi; }
__device__ __forceinline__ void glds16(const void* gsrc, unsigned lds_dst) { unsigned keep;
    asm volatile("s_mov_b32 %0, m0\n\ts_mov_b32 m0, %2\n\ts_nop 0\n\tglobal_load_lds_dwordx4 %1, off\n\ts_mov_b32 m0, %0" : "=&s"(keep) : "v"(gsrc), "s"(lds_dst) : "memory"); }
typedef float f32x2_t __attribute__((ext_vector_type(2))); typedef __bf16 bf16x2_t __attribute__((ext_vector_type(2)));
__device__ __forceinline__ unsigned cvtpk(float lo, float hi) { f32x2_t v = {lo, hi}; bf16x2_t b = __builtin_convertvector(v, bf16x2_t); return __builtin_bit_cast(unsigned, b); }
__device__ __forceinline__ s16x4 vtr(lds_cptr p) { return __builtin_bit_cast(s16x4, __builtin_amdgcn_ds_read_tr16_b64_v4i16((__attribute__((address_space(3))) v4i16_t*)p)); }
__device__ __forceinline__ bf16x8 pack8(const f32x16& v, int b0) {
    typedef unsigned u32x4 __attribute__((ext_vector_type(4)));
    u32x4 w; w.x = cvtpk(v[b0], v[b0 + 1]); w.y = cvtpk(v[b0 + 2], v[b0 + 3]); w.z = cvtpk(v[b0 + 4], v[b0 + 5]); w.w = cvtpk(v[b0 + 6], v[b0 + 7]); return __builtin_bit_cast(bf16x8, w); }

__device__ __forceinline__ float vmin(float a, float b) { return __builtin_amdgcn_fmed3f(a, -3.0e38f, b); }
template <bool DIAG> __device__ __forceinline__ void tile(f32x16 (&o)[2], f32x16& R, const bf16x8 (&qr)[4], const bf16x8 (&tri)[2], const bf16x8 ones, lds_cptr kp, lds_cptr vp, int qrel, int hi) {
    f32x16 z0 = {}, z1 = {};
#pragma unroll
    for (int d0 = 0; d0 < 4; ++d0) {
        const bf16x8 k0 = *(const __attribute__((address_space(3))) bf16x8*)(kp + d0 * 2048);
        const bf16x8 k1 = *(const __attribute__((address_space(3))) bf16x8*)(kp + d0 * 2048 + 512);
        z0 = SBA_MFMA(k0, qr[d0], z0); z1 = SBA_MFMA(k1, qr[d0], z1); }
    f32x16 sp;
#pragma unroll
    for (int r = 0; r < 16; ++r) { const float zc = vmin(z1[r], 126.0f); float s = __builtin_amdgcn_logf(1.0f + __builtin_amdgcn_exp2f(zc));
        if (DIAG) { if (!(32 + crow(r, hi) < qrel)) s = 0.f; }
        sp[r] = s; z1[r] = (zc - s) + R[r]; }
    const bf16x8 x1a = pack8(sp, 0), x1b = pack8(sp, 8);
    f32x16 S = SBA_MFMA(ones, x1a, R); S = SBA_MFMA(ones, x1b, S);
    z1 = SBA_MFMA(tri[0], x1a, z1); z1 = SBA_MFMA(tri[1], x1b, z1);
#pragma unroll
    for (int r = 0; r < 16; ++r) { const float zc = vmin(z0[r], 126.0f); float s = __builtin_amdgcn_logf(1.0f + __builtin_amdgcn_exp2f(zc));
        if (DIAG) { if (!(crow(r, hi) < qrel)) s = 0.f; }
        sp[r] = s; z0[r] = (zc - s) + S[r]; }
    const bf16x8 x0a = pack8(sp, 0), x0b = pack8(sp, 8);
    z0 = SBA_MFMA(tri[0], x0a, z0); z0 = SBA_MFMA(tri[1], x0b, z0);
    R = SBA_MFMA(ones, x0a, S); R = SBA_MFMA(ones, x0b, R);
#pragma unroll
    for (int r = 0; r < 16; ++r) { float a0 = __builtin_amdgcn_exp2f(z0[r]), a1 = __builtin_amdgcn_exp2f(z1[r]);
        if (DIAG) { if (!(crow(r, hi) < qrel)) a0 = 0.f; if (!(32 + crow(r, hi) < qrel)) a1 = 0.f; }
        z0[r] = a0; z1[r] = a1; }
    const bf16x8 p0 = pack8(z0, 0), p1 = pack8(z0, 8), p2 = pack8(z1, 0), p3 = pack8(z1, 8);
#pragma unroll
    for (int d0 = 0; d0 < 2; ++d0) {
        s16x4 lo[4], hh[4];
#pragma unroll
        for (int ks = 0; ks < 4; ++ks) { lo[ks] = vtr(vp + d0 * 4096 + ks * 1024); hh[ks] = vtr(vp + d0 * 4096 + ks * 1024 + 512); }
#define SBA_PK(k) (bf16x8){lo[k][0], lo[k][1], lo[k][2], lo[k][3], hh[k][0], hh[k][1], hh[k][2], hh[k][3]}
        o[d0] = SBA_MFMA(p0, SBA_PK(0), o[d0]); o[d0] = SBA_MFMA(p1, SBA_PK(1), o[d0]); o[d0] = SBA_MFMA(p2, SBA_PK(2), o[d0]); o[d0] = SBA_MFMA(p3, SBA_PK(3), o[d0]);
#undef SBA_PK
    }
}

#define SBA_WAIT_BAR() asm volatile("s_waitcnt vmcnt(0) lgkmcnt(0)\n\ts_barrier" ::: "memory")
__device__ __forceinline__ void attn_unit(int b, int h, int qb, const bf16_t* Q, const bf16_t* K, const bf16_t* V, bf16_t* O, char* shm) {
    int tid_ = threadIdx.x; asm volatile("" : "+v"(tid_)); const int tid = tid_, lane = tid & 63, r32 = lane & 31, hi = lane >> 5; const int wid = __builtin_amdgcn_readfirstlane(tid >> 6);
    const int grp = wid >> 2, w4 = wid & 3, rb = grp ? (w4 ^ 2) : w4;
    const long rowbase = (long)b * SEQ; const int q0 = qb * QB + grp * 128;
    const bf16_t* Qw = Q + (rowbase + q0 + rb * 32) * PITCH + h * HDIM;
    const bf16_t* Kh = K + rowbase * PITCH + h * HDIM; const bf16_t* Vh = V + rowbase * PITCH + h * HDIM;
    const unsigned lds0 = (unsigned)(uintptr_t)shm + (unsigned)grp * (4 * SLOTB);
    const bf16_t* ksrc0 = Kh + (long)lane * PITCH + (2 * w4) * 8; const bf16_t* ksrc1 = ksrc0 + 8;
    const int p0 = 2 * w4, p1 = 2 * w4 + 1;
    const bf16_t* vsrc0 = Vh + (long)(16 * (p0 & 3) + (lane >> 2)) * PITCH + (p0 >> 2) * 32 + (lane & 3) * 8;
    const bf16_t* vsrc1 = Vh + (long)(16 * (p1 & 3) + (lane >> 2)) * PITCH + (p1 >> 2) * 32 + (lane & 3) * 8;
    const unsigned kdst = lds0 + p0 * 1024, vdst = lds0 + 2 * SLOTB + p0 * 1024;
#define SBA_DMA(t, slot) do { const long go_ = (long)(t) * KVBLK * PITCH; \
        glds16(ksrc0 + go_, (unsigned)__builtin_amdgcn_readfirstlane(kdst + (slot))); glds16(ksrc1 + go_, (unsigned)__builtin_amdgcn_readfirstlane(kdst + 1024 + (slot))); \
        glds16(vsrc0 + go_, (unsigned)__builtin_amdgcn_readfirstlane(vdst + (slot))); glds16(vsrc1 + go_, (unsigned)__builtin_amdgcn_readfirstlane(vdst + 1024 + (slot))); } while (0)
    const lds_cptr shm3 = (lds_cptr)shm + grp * (4 * SLOTB);
    const lds_cptr kp0 = shm3 + hi * 1024 + r32 * 16;
    const lds_cptr vp0 = shm3 + 2 * SLOTB + ((lane >> 4) & 1) * 32 + (lane & 3) * 8 + (4 * hi + ((lane & 15) >> 2)) * 64;
    volatile __attribute__((address_space(3))) unsigned* flags = (volatile __attribute__((address_space(3))) unsigned*)((lds_cptr)shm + LDS_FLAGS);
    const int jtop = (q0 + 128) / KVBLK - 1, jd = q0 / KVBLK + (rb >> 1), qrel = 32 * (rb & 1) + r32;
    SBA_DMA(jtop, 0);
    bf16x8 qr[4];
#pragma unroll
    for (int d0 = 0; d0 < 4; ++d0) qr[d0] = *reinterpret_cast<const bf16x8*>(&Qw[(long)r32 * PITCH + d0 * 16 + hi * 8]);
    bf16x8 tri[2]; bf16x8 ones;
#pragma unroll
    for (int s = 0; s < 2; ++s)
#pragma unroll
        for (int j = 0; j < 8; ++j) tri[s][j] = ((16 * s + 8 * (j >> 2) + 4 * hi + (j & 3)) > r32) ? (short)0xBF80 : (short)0;
#pragma unroll
    for (int j = 0; j < 8; ++j) ones[j] = (short)0xBF80;
    f32x16 o[2]; o[0] = f32x16{}; o[1] = f32x16{}; f32x16 R = f32x16{};
    bool mydone = false;
    const int nsteps = (qb * QB + QB) / KVBLK;
    for (int it = 0; it < nsteps; ++it) {
        const int j = jtop - it;
        SBA_WAIT_BAR();
        if (it > 0) { const int pf = ((it - 1) & 1) * 8; unsigned all = 1u;
#pragma unroll
            for (int w = 0; w < 8; ++w) all &= flags[pf + w];
            if (__builtin_amdgcn_readfirstlane(all)) break; }
        const int cur = (it & 1) * SLOTB, oth = SLOTB - cur;
        if (j > 0) SBA_DMA(j - 1, oth);
        if (!mydone && j >= 0 && j <= jd) {
            if (j == jd) tile<true>(o, R, qr, tri, ones, kp0 + cur, vp0 + cur, qrel, hi);
            else tile<false>(o, R, qr, tri, ones, kp0 + cur, vp0 + cur, qrel, hi);
            mydone = __all(R[0] < R_DONE) != 0;
        }
        if (lane == 0) flags[(it & 1) * 8 + wid] = (mydone || j <= 0) ? 1u : 0u;
    }
    SBA_WAIT_BAR();
    unsigned char* Ow = (unsigned char*)O + (rowbase + q0 + rb * 32) * ATT_W + h * HDIM;
#pragma unroll
    for (int r = 0; r < 16; ++r) { const int orow = crow(r, hi);
#pragma unroll
        for (int d0 = 0; d0 < 2; ++d0) { const int w = pg8::f8pk(o[d0][r] * 2.0f, 0.f, 0, false); Ow[(long)orow * ATT_W + d0 * 32 + r32] = (unsigned char)(w & 0xff); } }
#undef SBA_DMA
}
#undef SBA_WAIT_BAR
#undef SBA_MFMA
}


constexpr size_t MiB = 1u << 20, KiB = 1u << 10;
constexpr size_t WS_CTL = 0, CTL_ZERO_BYTES = 64 * KiB;
constexpr size_t WS_TAB = 1 * MiB;
constexpr size_t TB_MOD = WS_TAB;
constexpr size_t TB_HIST = WS_TAB + 192 * KiB;
constexpr size_t TB_TILE = WS_TAB + 208 * KiB;
constexpr size_t TB_EIDX = WS_TAB + 256 * KiB;
constexpr size_t TB_GATE = WS_TAB + 512 * KiB;
constexpr size_t TB_SLOT = WS_TAB + 768 * KiB;
constexpr size_t TB_WRS = WS_TAB + 1024 * KiB;
constexpr int WR_PITCH = 1032;
constexpr size_t TB_STAMP = WS_TAB + 1400 * KiB;
constexpr size_t TB_PAR = WS_TAB + 1408 * KiB;
constexpr int PAR_WCONV = 0, PAR_LN1G = PAR_WCONV + DEPTH * 3 * CONV_CH, PAR_LN1B = PAR_LN1G + DEPTH * DM, PAR_LN2G = PAR_LN1B + DEPTH * DM, PAR_LN2B = PAR_LN2G + DEPTH * DM,
              PAR_BR = PAR_LN2B + DEPTH * DM, PAR_WR = PAR_BR + NEXP, PAR_TOTAL = PAR_WR + DM * NEXP;
static_assert(TB_PAR + (size_t)PAR_TOTAL * 4 <= 3 * MiB, "tables");
constexpr size_t WS_W = 3 * MiB;
constexpr size_t W_IN = WS_W, W_IN_L = (size_t)IN_W * DM * 2;
constexpr size_t W_A = W_IN + DEPTH * W_IN_L, W_A_L = (size_t)DM * CONV_CH * 2;
constexpr size_t W_B = W_A + DEPTH * W_A_L, W_B_L = W_A_L;
constexpr size_t W_O = W_B + DEPTH * W_B_L, W_O_L = (size_t)DM * DM * 2;
constexpr size_t W_GU = W_O + DEPTH * W_O_L, W_GU_E = (size_t)2 * FFD * DM * 2;
constexpr size_t W_DN = W_GU + (size_t)DEPTH * NEXP * W_GU_E, W_DN_E = (size_t)DM * FFD * 2;
constexpr size_t W_IN_SC = 6 * MiB;
constexpr size_t W_GU_SC = 1 * MiB + 64 * KiB;
constexpr size_t ACT_SU = 33 * MiB;
constexpr size_t ACT_LIST = 34 * MiB;
constexpr size_t WS_ACT = W_DN + (size_t)DEPTH * NEXP * W_DN_E;
constexpr size_t WS_PROJ = WS_ACT + (size_t)M_TOK * DM * 2;
constexpr size_t PJ_T512 = (size_t)M_TOK * 512 * 2, PJ_GA = 6 * PJ_T512, PJ_GB = PJ_GA + (size_t)M_TOK * DM * 2;
constexpr size_t PJ_XS = 0, PJ_HS = (size_t)PMAX * DM * 2;
constexpr size_t PJ_SXS = 69 * MiB;
constexpr size_t WS_END = WS_PROJ + (size_t)M_TOK * IN_W * 2;
static_assert(WS_ACT == 127 * MiB && WS_END == 511 * MiB, "d_ws map");
static_assert(PJ_HS + (size_t)PMAX * FFD * 2 <= (size_t)M_TOK * IN_W * 2, "MoE overlay fits the proj region");
constexpr int CW_BAR = 4096;
constexpr int CW_GCNT = 1024;

constexpr int RING_OFF = 0, RING_BYTES = 131072;
constexpr int LDSCTL_OFF = RING_BYTES, MISC_OFF = LDSCTL_OFF + 320;
constexpr int GTAB_OFF = RING_BYTES + 1024;
constexpr int LDS_BYTES = 149504;
static_assert(MISC_OFF + 128 <= GTAB_OFF && GTAB_OFF + 8 * 2048 <= LDS_BYTES, "LDS map");

#define GAS __attribute__((address_space(1)))
#define LAS __attribute__((address_space(3)))
typedef unsigned short bf16;
typedef unsigned v4u __attribute__((ext_vector_type(4)));
typedef unsigned v2u __attribute__((ext_vector_type(2)));
typedef float f32x4 __attribute__((ext_vector_type(4)));
typedef GAS unsigned gu32;
#define RLX_AGENT __ATOMIC_RELAXED, __HIP_MEMORY_SCOPE_AGENT
#define LDS_WAIT() asm volatile("s_waitcnt lgkmcnt(0)" ::: "memory")
#define VM_WAIT() asm volatile("s_waitcnt vmcnt(0)" ::: "memory")
__device__ __forceinline__ unsigned f2bf(float f) { unsigned u = __builtin_bit_cast(unsigned, f); return (u + 0x7fffu + ((u >> 16) & 1u)) >> 16; }
typedef float f32x2_r __attribute__((ext_vector_type(2))); typedef __bf16 bf16x2_r __attribute__((ext_vector_type(2)));
__device__ __forceinline__ unsigned pk2(float lo, float hi) { f32x2_r v = {lo, hi}; return __builtin_bit_cast(unsigned, __builtin_convertvector(v, bf16x2_r)); }
__device__ __forceinline__ float bflo(unsigned w) { return __uint_as_float(w << 16); }
__device__ __forceinline__ float bfhi(unsigned w) { return __uint_as_float(w & 0xffff0000u); }


#define XB_TMO      128
#define XB_XCNT(j)  (256  + 64 * (j))
#define XB_XSUB(j)  (1280 + 64 * (j))
#define XB_XGEN(j)  (2304 + 64 * (j))
#define XB_TOP      3328
#define XB_TOPGEN   3392
#define XCD_BAR_WORDS 3456
#define XB_SPIN_CAP (1u << 18)

__device__ __forceinline__ unsigned xb_ld(unsigned* p)              { return __hip_atomic_load(p, __ATOMIC_RELAXED, __HIP_MEMORY_SCOPE_AGENT); }
__device__ __forceinline__ unsigned xb_add(unsigned* p, unsigned v) { return __hip_atomic_fetch_add(p, v, __ATOMIC_RELAXED, __HIP_MEMORY_SCOPE_AGENT); }
__device__ __forceinline__ unsigned xb_xcc_id() { return (unsigned)__builtin_amdgcn_s_getreg((3 << 11) | 20) & 0xFu; }
#define XB_SPIN(cond, bar) do { unsigned _sp = 0; while (cond) { __builtin_amdgcn_s_sleep(1); \
    if ((++_sp & 255u) == 0u) { if (xb_ld(&(bar)[XB_TMO])) break; if (_sp > XB_SPIN_CAP) { atomicAdd(&(bar)[XB_TMO], 1u); break; } } } } while (0)

struct XcdBarrier {
    unsigned* bar; unsigned x;
    volatile LAS unsigned* st;
};

__device__ __forceinline__ XcdBarrier xcd_barrier_post(unsigned* bar, volatile LAS unsigned* st) {
    XcdBarrier b; b.bar = bar; b.x = xb_xcc_id(); b.st = st;
    if (threadIdx.x == 0) (void)xb_add(&bar[XB_XCNT(b.x)], 1u);
    return b;
}
__device__ __forceinline__ void xcd_barrier_complete(unsigned* bar, unsigned x, unsigned& nloc, unsigned& nx) {
    const unsigned G = gridDim.x * gridDim.y * gridDim.z;
    unsigned sum, cnt, mine, sp = 0u;
    for (;;) {
        sum = 0u; cnt = 0u; mine = 0u;
#pragma unroll
        for (unsigned j = 0; j < 16; ++j) { const unsigned c = xb_ld(&bar[XB_XCNT(j)]); sum += c; cnt += (c > 0u) ? 1u : 0u; mine = (j == x) ? c : mine; }
        if (sum == G) break;
        __builtin_amdgcn_s_sleep(1);
        if ((++sp & 255u) == 0u) { if (xb_ld(&bar[XB_TMO])) break; if (sp > XB_SPIN_CAP) { atomicAdd(&bar[XB_TMO], 1u); break; } }
    }
    nloc = mine > 0u ? mine : 1u; nx = cnt > 0u ? cnt : 1u;
}

__device__ __forceinline__ void xcd_barrier(const XcdBarrier& b) {
    asm volatile("s_waitcnt vmcnt(0)" ::: "memory");
    __syncthreads();
    if (threadIdx.x == 0) {
        unsigned* bar = b.bar;
        __builtin_amdgcn_s_waitcnt(0);
        unsigned nloc = b.st[0], nx = b.st[1];
        if (nloc == 0u) { xcd_barrier_complete(bar, b.x, nloc, nx); b.st[0] = nloc; b.st[1] = nx; }
        const unsigned old = xb_add(&bar[XB_XSUB(b.x)], 1u);
        const unsigned gen = old / nloc;
        if (old + 1u == (gen + 1u) * nloc) {
            __builtin_amdgcn_fence(__ATOMIC_RELEASE, "agent");
            asm volatile("s_waitcnt vmcnt(0)" ::: "memory");
            const unsigned og = xb_add(&bar[XB_TOP], 1u);
            const unsigned tg = og / nx;
            if (og + 1u == (tg + 1u) * nx) xb_add(&bar[XB_TOPGEN], 1u);
            else XB_SPIN(xb_ld(&bar[XB_TOPGEN]) == tg, bar);
            __builtin_amdgcn_fence(__ATOMIC_ACQUIRE, "agent");
            xb_add(&bar[XB_XGEN(b.x)], 1u);
            asm volatile("s_waitcnt vmcnt(0)" ::: "memory");
        } else {
            XB_SPIN(xb_ld(&bar[XB_XGEN(b.x)]) == gen, bar);
            __builtin_amdgcn_fence(__ATOMIC_ACQUIRE, "agent");
            asm volatile("s_waitcnt vmcnt(0)" ::: "memory");
        }
    }
    __syncthreads();
}

#ifndef MK_PROBE
#define MK_PROBE 0
#endif
#ifndef MK_STAGGER
#define MK_STAGGER 0
#endif
#ifndef MK_DRY
#define MK_DRY 0
#endif
#ifndef MK_WGM_IN
#define MK_WGM_IN 2
#define MK_WGM_SQ 2
#endif
#ifndef MK_XBAR
#define MK_XBAR 0
#endif
#ifndef MK_REP_MASK
#define MK_REP_MASK 0
#define MK_REP_N 0
#endif
#ifndef MK_PA
#define MK_PA 0
#define MK_PB 0
#define MK_TMAX 1000
#endif

struct Frame {
    LAS unsigned char* lds;
    volatile LAS unsigned* MISC;
    gu32* ctl;
    unsigned char* ws;
    const float* x; float* out;
    int tid, lane, wave;
    int vcu, G;
};
struct Args { const float* in[18]; float* out; unsigned char* ws; int ph_lo, ph_hi; };

__device__ __forceinline__ float wave_sum(float v) {
    v += __builtin_bit_cast(float, __builtin_amdgcn_mov_dpp(__builtin_bit_cast(int, v), 0xB1, 0xf, 0xf, true));
    v += __builtin_bit_cast(float, __builtin_amdgcn_mov_dpp(__builtin_bit_cast(int, v), 0x4E, 0xf, 0xf, true));
    v += __builtin_bit_cast(float, __builtin_amdgcn_mov_dpp(__builtin_bit_cast(int, v), 0x141, 0xf, 0xf, true));
    v += __builtin_bit_cast(float, __builtin_amdgcn_mov_dpp(__builtin_bit_cast(int, v), 0x140, 0xf, 0xf, true));
    { auto r = __builtin_amdgcn_permlane16_swap(__float_as_uint(v), __float_as_uint(v), false, false); v = __uint_as_float(r[0]) + __uint_as_float(r[1]); }
    { auto r = __builtin_amdgcn_permlane32_swap(__float_as_uint(v), __float_as_uint(v), false, false); v = __uint_as_float(r[0]) + __uint_as_float(r[1]); }
    return v;
}

__device__ __forceinline__ float wave_max(float v) {
    v = fmaxf(v, __builtin_bit_cast(float, __builtin_amdgcn_mov_dpp(__builtin_bit_cast(int, v), 0xB1, 0xf, 0xf, true)));
    v = fmaxf(v, __builtin_bit_cast(float, __builtin_amdgcn_mov_dpp(__builtin_bit_cast(int, v), 0x4E, 0xf, 0xf, true)));
    v = fmaxf(v, __builtin_bit_cast(float, __builtin_amdgcn_mov_dpp(__builtin_bit_cast(int, v), 0x141, 0xf, 0xf, true)));
    v = fmaxf(v, __builtin_bit_cast(float, __builtin_amdgcn_mov_dpp(__builtin_bit_cast(int, v), 0x140, 0xf, 0xf, true)));
    { auto r = __builtin_amdgcn_permlane16_swap(__float_as_uint(v), __float_as_uint(v), false, false); v = fmaxf(__uint_as_float(r[0]), __uint_as_float(r[1])); }
    { auto r = __builtin_amdgcn_permlane32_swap(__float_as_uint(v), __float_as_uint(v), false, false); v = fmaxf(__uint_as_float(r[0]), __uint_as_float(r[1])); }
    return v;
}
__device__ __forceinline__ unsigned q4i8(float a, float b, float c, float d, float inv) {
    const unsigned y0 = __float_as_uint(__builtin_fmaf(a, inv, 12582912.0f)), y1 = __float_as_uint(__builtin_fmaf(b, inv, 12582912.0f)), y2 = __float_as_uint(__builtin_fmaf(c, inv, 12582912.0f)), y3 = __float_as_uint(__builtin_fmaf(d, inv, 12582912.0f));
    return __builtin_amdgcn_perm(__builtin_amdgcn_perm(y3, y2, 0x0c0c0400u), __builtin_amdgcn_perm(y1, y0, 0x0c0c0400u), 0x05040100u);
}
__device__ __forceinline__ unsigned pk4i8(float a, float b, float c, float d) { return ((unsigned)(int)a & 0xffu) | (((unsigned)(int)b & 0xffu) << 8) | (((unsigned)(int)c & 0xffu) << 16) | ((unsigned)(int)d << 24); }
__device__ __forceinline__ void store_row_i8(const f32x4 (&v)[4], signed char* row, float* scale, int lane) {
    float mx = 0.f;
#pragma unroll
    for (int j = 0; j < 4; ++j) mx = fmaxf(fmaxf(mx, fmaxf(fabsf(v[j][0]), fabsf(v[j][1]))), fmaxf(fabsf(v[j][2]), fabsf(v[j][3])));
    mx = wave_max(mx); const float inv = mx > 0.f ? 127.f / mx : 0.f;
#pragma unroll
    for (int j = 0; j < 4; ++j) *(unsigned*)(row + j * 256 + lane * 4) = q4i8(v[j][0], v[j][1], v[j][2], v[j][3], inv);
    if (lane == 0) *scale = mx * (1.f / 127.f);
}

__device__ __forceinline__ void p0_transpose_item(const float* W, int K, int N, bf16* WT, int row_off, int row_mul, float scale, int sc_n0, int sc_n1, LAS float* scr, int item, int lane) {
    const int nblk = N / 32, kb = item / nblk, nb = item % nblk, k0 = 64 * kb, n0 = 32 * nb;
#pragma unroll 32
    for (int i = 0; i < 32; ++i) { const int kk = 2 * i + (lane >> 5); scr[kk * 33 + (lane & 31)] = W[(size_t)(k0 + kk) * N + n0 + (lane & 31)]; }
    LDS_WAIT(); asm volatile("" ::: "memory");
    const float sc = (n0 >= sc_n0 && n0 < sc_n1) ? scale : 1.0f;
    const int c = lane & 7;
#pragma unroll
    for (int j = 0; j < 4; ++j) { const int n = (lane >> 3) + 8 * j; const LAS float* s = scr + (8 * c) * 33 + n;
        v4u o; o.x = pk2(s[0 * 33] * sc, s[1 * 33] * sc); o.y = pk2(s[2 * 33] * sc, s[3 * 33] * sc); o.z = pk2(s[4 * 33] * sc, s[5 * 33] * sc); o.w = pk2(s[6 * 33] * sc, s[7 * 33] * sc);
        *(GAS v4u*)(WT + (size_t)(row_off + (n0 + n) * row_mul) * K + k0 + 8 * c) = o; }
    LDS_WAIT(); asm volatile("" ::: "memory");
}
__device__ __forceinline__ void p0_quant_item(const float* W, int K, int N, int n0, signed char* WT, int row_off, int row_mul, float* scales, float qsc, int sc_n0, int sc_n1, LAS float* scr, int lane) {
    const int nl = lane & 31, kh = lane >> 5; const float* wp = W + n0 + nl; float mx = 0.f;
#pragma unroll 1
    for (int kb = 0; kb < K / 64; ++kb) { const float* wk = wp + (size_t)(kb * 64 + kh) * N;
#pragma unroll 32
        for (int i = 0; i < 32; ++i) mx = fmaxf(mx, fabsf(wk[(size_t)(2 * i) * N])); }
    mx = fmaxf(mx, __shfl_xor(mx, 32));
    const float inv = mx > 0.f ? 127.f / mx : 0.f;
    if (lane < 32) scales[row_off + (n0 + nl) * row_mul] = mx * (1.f / 127.f) * ((n0 >= sc_n0 && n0 < sc_n1) ? qsc : 1.f);
    const int c = lane & 7;
#pragma unroll 1
    for (int kb = 0; kb < K / 64; ++kb) { const float* wk = wp + (size_t)(kb * 64 + kh) * N;
#pragma unroll 32
        for (int i = 0; i < 32; ++i) { scr[(2 * i + kh) * 33 + nl] = rintf(wk[(size_t)(2 * i) * N] * inv); }
        LDS_WAIT(); asm volatile("" ::: "memory");
#pragma unroll
        for (int j = 0; j < 4; ++j) { const int n = (lane >> 3) + 8 * j; const LAS float* s = scr + (8 * c) * 33 + n;
            v2u o; o.x = pk4i8(s[0 * 33], s[1 * 33], s[2 * 33], s[3 * 33]); o.y = pk4i8(s[4 * 33], s[5 * 33], s[6 * 33], s[7 * 33]);
            *(GAS v2u*)(WT + (size_t)(row_off + (n0 + n) * row_mul) * K + kb * 64 + 8 * c) = o; }
        LDS_WAIT(); asm volatile("" ::: "memory");
    }
}
__device__ __forceinline__ void p0_transpose_item_f8(const float* W, int K, int N, unsigned char* WT, float scale, LAS float* scr, int item, int lane) {
    const int nblk = N / 32, kb = item / nblk, nb = item % nblk, k0 = 64 * kb, n0 = 32 * nb;
#pragma unroll 32
    for (int i = 0; i < 32; ++i) { const int kk = 2 * i + (lane >> 5); scr[kk * 33 + (lane & 31)] = W[(size_t)(k0 + kk) * N + n0 + (lane & 31)]; }
    LDS_WAIT(); asm volatile("" ::: "memory");
    const int c = lane & 7;
#pragma unroll
    for (int j = 0; j < 4; ++j) { const int n = (lane >> 3) + 8 * j; const LAS float* s = scr + (8 * c) * 33 + n;
        int w0 = pg8::f8pk(s[0 * 33] * scale, s[1 * 33] * scale, 0, false); w0 = pg8::f8pk(s[2 * 33] * scale, s[3 * 33] * scale, w0, true);
        int w1 = pg8::f8pk(s[4 * 33] * scale, s[5 * 33] * scale, 0, false); w1 = pg8::f8pk(s[6 * 33] * scale, s[7 * 33] * scale, w1, true);
        v2u o; o.x = (unsigned)w0; o.y = (unsigned)w1; *(GAS v2u*)(WT + (size_t)(n0 + n) * K + k0 + 8 * c) = o; }
    LDS_WAIT(); asm volatile("" ::: "memory");
}
__device__ __forceinline__ void p0a_prologue(Frame& F, const Args& a) {
    const float* c = a.in[1]; const float* w_ada = a.in[2]; const float* b_ada = a.in[3];
    if (F.vcu < 192) {
        LAS float* sl = (LAS float*)(F.lds);
        LAS float* red = (LAS float*)(F.lds + 16384);
        for (int i = F.tid; i < BATCH * DM; i += NTHREADS) { const float cv = c[i]; sl[i] = cv / (1.f + __expf(-cv)); }
        __syncthreads();
        const int l = F.vcu / 96, cb = F.vcu % 96, col = cb * 64 + F.lane;
        const float* w = w_ada + (size_t)l * DM * 6 * DM + col;
        float acc[BATCH] = {0.f, 0.f, 0.f, 0.f};
        const int kbeg = F.wave * 128;
#pragma unroll 32
        for (int k = kbeg; k < kbeg + 128; ++k) { const float wv = w[(size_t)k * 6 * DM];
#pragma unroll
            for (int b = 0; b < BATCH; ++b) acc[b] += sl[b * DM + k] * wv; }
#pragma unroll
        for (int b = 0; b < BATCH; ++b) red[(F.wave * BATCH + b) * 64 + F.lane] = acc[b];
        __syncthreads();
        if (F.wave < BATCH) { float s = 0.f;
#pragma unroll
            for (int w8 = 0; w8 < 8; ++w8) s += red[(w8 * BATCH + F.wave) * 64 + F.lane];
            float* mod = (float*)(F.ws + TB_MOD);
            mod[((size_t)l * BATCH + F.wave) * 6 * DM + col] = s + b_ada[l * 6 * DM + col]; }
        __syncthreads();
    }
    { const int gt = F.vcu * NTHREADS + F.tid, NGT = F.G * NTHREADS; float* par = (float*)(F.ws + TB_PAR);
      for (int i = gt; i < PAR_TOTAL; i += NGT) { float v;
          if (i < PAR_LN1G) v = a.in[5][i - PAR_WCONV];
          else if (i < PAR_LN1B) v = a.in[9][i - PAR_LN1G];
          else if (i < PAR_LN2G) v = a.in[10][i - PAR_LN1B];
          else if (i < PAR_LN2B) v = a.in[16][i - PAR_LN2G];
          else if (i < PAR_BR) v = a.in[17][i - PAR_LN2B];
          else if (i < PAR_WR) v = a.in[12][i - PAR_BR];
          else v = a.in[11][i - PAR_WR];
          par[i] = v; } }
    { const int gt = F.vcu * NTHREADS + F.tid, NGT = F.G * NTHREADS; unsigned short* wimg = (unsigned short*)(F.ws + TB_WRS);
      for (int idx = gt; idx < DM * NEXP; idx += NGT) { const int col = idx >> 4, e = idx & 15; const float v = a.in[11][idx]; const unsigned h = f2bf(v); const float hv = __uint_as_float(h << 16);
          wimg[e * WR_PITCH + col] = (unsigned short)h; wimg[(NEXP + e) * WR_PITCH + col] = (unsigned short)f2bf(v - hv); } }
    LAS float* scr = (LAS float*)(F.lds + RING_OFF + F.wave * 16384);
    const int gw = F.vcu * NWAVES + F.wave, NGW = F.G * NWAVES;
    constexpr int I_AB = (CONV_CH / 64) * (DM / 32), I_O = (DM / 64) * (DM / 32), I_G = (DM / 64) * (FFD / 32), I_D = (FFD / 64) * (DM / 32);
    constexpr int PER_L = 2 * I_AB + I_O + NEXP * I_D, NITEMS = DEPTH * PER_L;
    constexpr int H_IN = IN_W / 32, H_GU = NEXP * 2 * (FFD / 32), H_L = H_IN + H_GU, NHEAVY = DEPTH * H_L;
    const bool hv = (gw % 3) != 2; const int hrank = gw - gw / 3 - (hv ? 0 : 1), nhv = NGW - NGW / 3;
    const int nidle = nhv > NHEAVY ? nhv - NHEAVY : 0, nlt = NGW / 3 + nidle;
    const int lrank = hv ? (hrank >= NHEAVY ? NGW / 3 + hrank - NHEAVY : -1) : gw / 3;
    if (hv) for (int it = hrank; it < NHEAVY; it += nhv) { const int l = it / H_L; int r = it % H_L;
        if (r < H_IN) { const int n0 = r * 32; const bool isc = n0 >= CONV_CH && n0 < 2 * CONV_CH, isx = n0 >= 2 * CONV_CH && n0 < 3 * CONV_CH;
            p0_quant_item(a.in[4] + (size_t)l * DM * IN_W, DM, IN_W, n0, (signed char*)(F.ws + W_IN + l * W_IN_L), isc ? -CONV_CH : isx ? 1 - 3 * CONV_CH : 0, (isc || isx) ? 2 : 1, (float*)(F.ws + W_IN + l * W_IN_L + W_IN_SC), QSCALE, 3 * CONV_CH, 3 * CONV_CH + ATT_W, scr, F.lane); continue; }
        r -= H_IN; const int e = r / (2 * (FFD / 32)), wh = (r / (FFD / 32)) & 1, nb = r % (FFD / 32); const size_t le = (size_t)l * NEXP + e;
        p0_quant_item(a.in[13 + wh] + le * DM * FFD, DM, FFD, nb * 32, (signed char*)(F.ws + W_GU + le * W_GU_E), wh, 2, (float*)(F.ws + W_GU + le * W_GU_E + W_GU_SC), 1.f, 0, 0, scr, F.lane); }
    for (int it = lrank < 0 ? NITEMS : lrank; it < NITEMS; it += nlt) {
        const int l = it / PER_L; int r = it % PER_L;
        if (r < I_AB) { p0_transpose_item_f8(a.in[6] + (size_t)l * CONV_CH * DM, CONV_CH, DM, (unsigned char*)(F.ws + W_A + l * W_A_L), 64.0f, scr, r, F.lane); continue; } r -= I_AB;
        if (r < I_AB) { p0_transpose_item_f8(a.in[7] + (size_t)l * ATT_W * DM, ATT_W, DM, (unsigned char*)(F.ws + W_B + l * W_B_L), 64.0f, scr, r, F.lane); continue; } r -= I_AB;
        if (r < I_O) { p0_transpose_item_f8(a.in[8] + (size_t)l * DM * DM, DM, DM, (unsigned char*)(F.ws + W_O + l * W_O_L), 64.0f, scr, r, F.lane); continue; } r -= I_O;
        const int e = r / I_D; r %= I_D; const size_t le = (size_t)l * NEXP + e;
        p0_transpose_item_f8(a.in[15] + le * FFD * DM, FFD, DM, (unsigned char*)(F.ws + W_DN + le * W_DN_E), 64.0f, scr, r, F.lane);
    }
}
__device__ __forceinline__ void p0b_u0(Frame& F) {
    const float* x = F.x; const float* mod = (const float*)(F.ws + TB_MOD); signed char* U = (signed char*)(F.ws + WS_ACT); float* sU = (float*)(F.ws + WS_ACT + ACT_SU);
    const int gw = F.vcu * NWAVES + F.wave, NGW = F.G * NWAVES;
    for (int m = gw; m < M_TOK; m += NGW) { const int b = m / SEQ; const float* mb = mod + (size_t)b * 6 * DM; f32x4 u[4];
#pragma unroll
        for (int j = 0; j < 4; ++j) { const int col = j * 256 + F.lane * 4; const f32x4 v = *(const f32x4*)(x + (size_t)m * DM + col), sh = *(const f32x4*)(mb + col), sc = *(const f32x4*)(mb + DM + col);
            u[j] = v * (sc + 1.0f) + sh; }
        store_row_i8(u, U + (size_t)m * DM, sU + m, F.lane); }
}
__device__ __forceinline__ void p2_conv(Frame& F, int l, bf16* ao) {
    bf16* cb = (bf16*)(F.ws + WS_PROJ); const bf16* pp = cb + (size_t)M_TOK * 512;
    const float* wc = (const float*)(F.ws + TB_PAR) + PAR_WCONV + (size_t)l * 3 * CONV_CH;
    const int gw = F.vcu * NWAVES + F.wave, NGW = F.G * NWAVES; const int ch = F.lane * 8;
    float w0[8], w1[8], w2[8];
#pragma unroll
    for (int i = 0; i < 8; ++i) { w0[i] = wc[ch + i]; w1[i] = wc[CONV_CH + ch + i]; w2[i] = wc[2 * CONV_CH + ch + i]; }
    for (int chunk = gw; chunk < M_TOK / 16; chunk += NGW) {
        const int row0 = chunk * 16; const int t0 = row0 % SEQ;
        float pm2[8], pm1[8];
#pragma unroll
        for (int i = 0; i < 8; ++i) { pm2[i] = 0.f; pm1[i] = 0.f; }
        if (t0 >= 2) {
            const v4u q2 = *(const v4u*)(pp + (size_t)(row0 - 2) * 512 + ch), q1 = *(const v4u*)(pp + (size_t)(row0 - 1) * 512 + ch);
#pragma unroll
            for (int i = 0; i < 4; ++i) { pm2[2 * i] = bflo(q2[i]); pm2[2 * i + 1] = bfhi(q2[i]); pm1[2 * i] = bflo(q1[i]); pm1[2 * i + 1] = bfhi(q1[i]); }
        }
        for (int r = 0; r < 16; ++r) { const size_t off = (size_t)(row0 + r) * 512 + ch;
            const v4u q0 = *(const v4u*)(pp + off), bb = *(const v4u*)(cb + off);
            float p0[8], o[8];
#pragma unroll
            for (int i = 0; i < 4; ++i) { p0[2 * i] = bflo(q0[i]); p0[2 * i + 1] = bfhi(q0[i]); }
#pragma unroll
            for (int i = 0; i < 8; ++i) o[i] = w2[i] * p0[i] + w1[i] * pm1[i] + w0[i] * pm2[i];
            int q0w = pg8::f8pk(bflo(bb[0]) * o[0] * 2.0f, bfhi(bb[0]) * o[1] * 2.0f, 0, false); q0w = pg8::f8pk(bflo(bb[1]) * o[2] * 2.0f, bfhi(bb[1]) * o[3] * 2.0f, q0w, true);
            int q1w = pg8::f8pk(bflo(bb[2]) * o[4] * 2.0f, bfhi(bb[2]) * o[5] * 2.0f, 0, false); q1w = pg8::f8pk(bflo(bb[3]) * o[6] * 2.0f, bfhi(bb[3]) * o[7] * 2.0f, q1w, true);
            v2u ov; ov.x = (unsigned)q0w; ov.y = (unsigned)q1w; *(v2u*)((unsigned char*)ao + off) = ov;
#pragma unroll
            for (int i = 0; i < 8; ++i) { pm2[i] = pm1[i]; pm1[i] = p0[i]; } }
    }
}
__device__ __forceinline__ void p2_attn(Frame& F, unsigned char* lds_generic) {
    const sba::bf16_t* Q = (const sba::bf16_t*)(F.ws + WS_PROJ + 3 * PJ_T512); const sba::bf16_t* K = (const sba::bf16_t*)(F.ws + WS_PROJ + 4 * PJ_T512); const sba::bf16_t* V = (const sba::bf16_t*)(F.ws + WS_PROJ + 5 * PJ_T512);
    sba::bf16_t* O = (sba::bf16_t*)(F.ws + WS_ACT);
    constexpr int NQB = SEQ / 256, NUNITS = BATCH * NHEAD * NQB;
    if (F.G == 256) {
        const int bh = F.vcu >> 3, s = F.vcu & 7;
        for (int i = 0; i < 4; ++i) { const int qb = (i == 0) ? s : (i == 1) ? 15 - s : (i == 2) ? 16 + s : 31 - s; sba::attn_unit(bh / NHEAD, bh % NHEAD, qb, Q, K, V, O, (char*)lds_generic); }
    } else {
        for (int u = F.vcu; u < NUNITS; u += F.G) { const int bh = u / NQB, qb = u % NQB; sba::attn_unit(bh / NHEAD, bh % NHEAD, qb, Q, K, V, O, (char*)lds_generic); }
    }
}
__device__ __forceinline__ float quad_sum(float v) {
    { auto r = __builtin_amdgcn_permlane16_swap(__float_as_uint(v), __float_as_uint(v), false, false); v = __uint_as_float(r[0]) + __uint_as_float(r[1]); }
    { auto r = __builtin_amdgcn_permlane32_swap(__float_as_uint(v), __float_as_uint(v), false, false); v = __uint_as_float(r[0]) + __uint_as_float(r[1]); }
    return v;
}
__device__ __forceinline__ float quad_max(float v) {
    { auto r = __builtin_amdgcn_permlane16_swap(__float_as_uint(v), __float_as_uint(v), false, false); v = fmaxf(__uint_as_float(r[0]), __uint_as_float(r[1])); }
    { auto r = __builtin_amdgcn_permlane32_swap(__float_as_uint(v), __float_as_uint(v), false, false); v = fmaxf(__uint_as_float(r[0]), __uint_as_float(r[1])); }
    return v;
}
__device__ __forceinline__ void p5_ln1(Frame& F, int l, const bf16* X, bf16* Xo, bool dry) {
    const float* mod = (const float*)(F.ws + TB_MOD) + (size_t)l * BATCH * 6 * DM; const float* par = (const float*)(F.ws + TB_PAR);
    const float* g = par + PAR_LN1G + l * DM; const float* bta = par + PAR_LN1B + l * DM; const float* w_router = par + PAR_WR; const float* b_router = par + PAR_BR;
    int* epos = (int*)(F.ws + TB_EIDX); float* gate = (float*)(F.ws + TB_GATE); int* gcnt = (int*)(F.ctl + CW_GCNT + 64 * l);
    signed char* U2 = (signed char*)(F.ws + WS_ACT); float* sU2 = (float*)(F.ws + WS_ACT + ACT_SU); int* list_e = (int*)(F.ws + WS_ACT + ACT_LIST);
    constexpr int WPITCH = WR_PITCH;
    LAS unsigned short* wth = (LAS unsigned short*)(F.lds);
    LAS unsigned short* wtl = wth + 16 * WPITCH;
    LAS float* pg = (LAS float*)(F.lds + 4 * 16 * WPITCH);
    LAS float* lgs = pg + 4 * DM;
    LAS int* hist = (LAS int*)(lgs + NWAVES * 256); LAS int* hbase = hist + 16; LAS int* te = hbase + 16; LAS int* tp = te + 256;
    const int blk = blockIdx.x; const int b = (blk * 128) / SEQ; const float* mb = mod + (size_t)b * 6 * DM;
    const int t = F.lane & 15, kq = F.lane >> 4; const int row = blk * 128 + F.wave * 16 + t;
    const bf16* xr = X + (size_t)row * DM + 8 * kq; (void)Xo; (void)w_router;
    constexpr int NIMG = 2 * NEXP * WPITCH * 2 / 16;
    const v4u* wsrc = (const v4u*)(F.ws + TB_WRS);
    v4u wimg[9]; float pv[2][4];
#pragma unroll
    for (int q = 0; q < 9; ++q) { const int i = F.tid + q * NTHREADS; wimg[q] = (q < 8 || i < NIMG) ? wsrc[(q < 8 || i < NIMG) ? i : 0] : (v4u){0u, 0u, 0u, 0u}; }
#pragma unroll
    for (int q = 0; q < 2; ++q) { const int idx = F.tid + q * NTHREADS; pv[q][0] = g[idx]; pv[q][1] = bta[idx]; pv[q][2] = mb[4 * DM + idx]; pv[q][3] = mb[3 * DM + idx]; }
    asm volatile("" ::: "memory");
    v4u raw[32];
#pragma unroll
    for (int s = 0; s < 32; ++s) raw[s] = *(const v4u*)(xr + 32 * s);
    asm volatile("" ::: "memory");
#pragma unroll
    for (int q = 0; q < 9; ++q) { const int i = F.tid + q * NTHREADS; if (q < 8 || i < NIMG) ((LAS v4u*)F.lds)[i] = wimg[q]; }
#pragma unroll
    for (int q = 0; q < 2; ++q) { const int idx = F.tid + q * NTHREADS; pg[idx] = pv[q][0]; pg[DM + idx] = pv[q][1]; pg[2 * DM + idx] = pv[q][2] + 1.0f; pg[3 * DM + idx] = pv[q][3]; }
    if (F.tid < NEXP) hist[F.tid] = 0;
    __syncthreads();
    float sum = 0.f, sq = 0.f;
#pragma unroll
    for (int s = 0; s < 32; ++s) { const float e0 = bflo(raw[s].x), e1 = bfhi(raw[s].x), e2 = bflo(raw[s].y), e3 = bfhi(raw[s].y), e4 = bflo(raw[s].z), e5 = bfhi(raw[s].z), e6 = bflo(raw[s].w), e7 = bfhi(raw[s].w);
        sum += ((e0 + e1) + (e2 + e3)) + ((e4 + e5) + (e6 + e7)); sq += ((e0 * e0 + e1 * e1) + (e2 * e2 + e3 * e3)) + ((e4 * e4 + e5 * e5) + (e6 * e6 + e7 * e7)); }
    const float mean = quad_sum(sum) * (1.f / DM); const float var = fmaxf(quad_sum(sq) * (1.f / DM) - mean * mean, 0.f);
    const float rstd = 1.f / sqrtf(var + LN_EPS);
    typedef short bf16x8_t __attribute__((ext_vector_type(8)));
    f32x4 acc = {0.f, 0.f, 0.f, 0.f}; float amax = 0.f;
    const LAS unsigned short* wph = wth + t * WPITCH + 8 * kq; const LAS unsigned short* wpl = wtl + t * WPITCH + 8 * kq;
    const LAS float* pp = pg + 8 * kq;
#pragma unroll
    for (int s = 0; s < 32; ++s) {
        const f32x4 g0 = *(const LAS f32x4*)(pp + 32 * s), g1 = *(const LAS f32x4*)(pp + 32 * s + 4), b0 = *(const LAS f32x4*)(pp + DM + 32 * s), b1 = *(const LAS f32x4*)(pp + DM + 32 * s + 4);
        const f32x4 c0 = *(const LAS f32x4*)(pp + 2 * DM + 32 * s), c1 = *(const LAS f32x4*)(pp + 2 * DM + 32 * s + 4), h0 = *(const LAS f32x4*)(pp + 3 * DM + 32 * s), h1 = *(const LAS f32x4*)(pp + 3 * DM + 32 * s + 4);
        asm volatile("" : "+v"(raw[s].x), "+v"(raw[s].y), "+v"(raw[s].z), "+v"(raw[s].w));
        const v4u rw = raw[s];
        const f32x4 x0 = (((f32x4){bflo(rw.x), bfhi(rw.x), bflo(rw.y), bfhi(rw.y)}) - mean) * rstd * g0 + b0, x1 = (((f32x4){bflo(rw.z), bfhi(rw.z), bflo(rw.w), bfhi(rw.w)}) - mean) * rstd * g1 + b1;
        const f32x4 u0 = x0 * c0 + h0, u1 = x1 * c1 + h1;
        amax = fmaxf(amax, fmaxf(fmaxf(fmaxf(fabsf(u0[0]), fabsf(u0[1])), fmaxf(fabsf(u0[2]), fabsf(u0[3]))), fmaxf(fmaxf(fabsf(u1[0]), fabsf(u1[1])), fmaxf(fabsf(u1[2]), fabsf(u1[3])))));
        v4u uh, ul;
        uh.x = pk2(u0[0], u0[1]); uh.y = pk2(u0[2], u0[3]); uh.z = pk2(u1[0], u1[1]); uh.w = pk2(u1[2], u1[3]);
        raw[s] = uh;
        ul.x = pk2(u0[0] - bflo(uh.x), u0[1] - bfhi(uh.x)); ul.y = pk2(u0[2] - bflo(uh.y), u0[3] - bfhi(uh.y)); ul.z = pk2(u1[0] - bflo(uh.z), u1[1] - bfhi(uh.z)); ul.w = pk2(u1[2] - bflo(uh.w), u1[3] - bfhi(uh.w));
        const bf16x8_t wh = *(const LAS bf16x8_t*)(wph + 32 * s), wl = *(const LAS bf16x8_t*)(wpl + 32 * s);
        acc = __builtin_amdgcn_mfma_f32_16x16x32_bf16(wh, __builtin_bit_cast(bf16x8_t, uh), acc, 0, 0, 0);
        acc = __builtin_amdgcn_mfma_f32_16x16x32_bf16(wh, __builtin_bit_cast(bf16x8_t, ul), acc, 0, 0, 0);
        acc = __builtin_amdgcn_mfma_f32_16x16x32_bf16(wl, __builtin_bit_cast(bf16x8_t, uh), acc, 0, 0, 0);
        if (s & 1) asm volatile("" ::: "memory");
    }
    {
        const float rmax = quad_max(amax), qinv = rmax > 0.f ? 127.f / rmax : 0.f; signed char* uw = U2 + (size_t)row * DM + 8 * kq;
#pragma unroll
        for (int s = 0; s < 32; ++s) { v4u rw = raw[s]; asm volatile("" : "+v"(rw.x), "+v"(rw.y), "+v"(rw.z), "+v"(rw.w));
            v2u o; o.x = q4i8(bflo(rw.x), bfhi(rw.x), bflo(rw.y), bfhi(rw.y), qinv); o.y = q4i8(bflo(rw.z), bfhi(rw.z), bflo(rw.w), bfhi(rw.w), qinv);
            if (!dry) *(v2u*)(uw + 32 * s) = o; else asm volatile("" :: "v"(o.x), "v"(o.y));
            asm volatile("" ::: "memory"); }
        if (kq == 0 && !dry) { sU2[row] = rmax * (1.f / 127.f); float* st = (float*)(F.ws + TB_SLOT); st[row * 2] = mean; st[row * 2 + 1] = rstd; }
    }
    LAS float* lw = lgs + F.wave * 256;
    *(LAS f32x4*)(lw + t * 16 + 4 * kq) = acc;
    LDS_WAIT(); asm volatile("" ::: "memory");
    float lg[NEXP];
#pragma unroll
    for (int q = 0; q < 4; ++q) { const f32x4 v = *(const LAS f32x4*)(lw + t * 16 + 4 * q); lg[4 * q] = v[0]; lg[4 * q + 1] = v[1]; lg[4 * q + 2] = v[2]; lg[4 * q + 3] = v[3]; }
    float aff[NEXP], sel[NEXP];
#pragma unroll
    for (int e = 0; e < NEXP; ++e) { aff[e] = 1.f / (1.f + __expf(-lg[e])); sel[e] = aff[e] + b_router[e]; }
    int gbest = 0; float gs_best = -1e30f;
#pragma unroll
    for (int gi = 0; gi < 4; ++gi) { float m1 = -1e30f, m2 = -1e30f;
#pragma unroll
        for (int q = 0; q < 4; ++q) { const float xv = sel[gi * 4 + q]; if (xv > m1) { m2 = m1; m1 = xv; } else if (xv > m2) m2 = xv; }
        const float gsc = m1 + m2; if (gsc > gs_best) { gs_best = gsc; gbest = gi; } }
    float sg[4], ag[4];
#pragma unroll
    for (int q = 0; q < 4; ++q) { sg[q] = gbest == 0 ? sel[q] : gbest == 1 ? sel[4 + q] : gbest == 2 ? sel[8 + q] : sel[12 + q]; ag[q] = gbest == 0 ? aff[q] : gbest == 1 ? aff[4 + q] : gbest == 2 ? aff[8 + q] : aff[12 + q]; }
    int i1 = 0; float v1 = sg[0];
#pragma unroll
    for (int q = 1; q < 4; ++q) if (sg[q] > v1) { v1 = sg[q]; i1 = q; }
    int i2 = -1; float v2 = -1e30f;
#pragma unroll
    for (int q = 0; q < 4; ++q) if (q != i1 && sg[q] > v2) { v2 = sg[q]; i2 = q; }
    const float a1 = i1 == 0 ? ag[0] : i1 == 1 ? ag[1] : i1 == 2 ? ag[2] : ag[3], a2 = i2 == 0 ? ag[0] : i2 == 1 ? ag[1] : i2 == 2 ? ag[2] : ag[3];
    const float inv = 1.f / (a1 + a2);
    if (kq == 0) { const int e1 = gbest * 4 + i1, e2 = gbest * 4 + i2, i = F.wave * 16 + t;
        if (!dry) { gate[row * 2] = a1 * inv; gate[row * 2 + 1] = a2 * inv; }
        te[i * 2] = e1; te[i * 2 + 1] = e2;
        tp[i * 2] = __hip_atomic_fetch_add(&hist[e1], 1, __ATOMIC_RELAXED, __HIP_MEMORY_SCOPE_WORKGROUP); tp[i * 2 + 1] = __hip_atomic_fetch_add(&hist[e2], 1, __ATOMIC_RELAXED, __HIP_MEMORY_SCOPE_WORKGROUP); }
    __syncthreads();
    if (dry) return;
    if (F.tid < NEXP) hbase[F.tid] = atomicAdd(gcnt + F.tid, hist[F.tid]);
    __syncthreads();
    if (F.tid < 128) { const int tok = blk * 128 + F.tid;
#pragma unroll
        for (int k = 0; k < 2; ++k) { const int e = te[F.tid * 2 + k], p = hbase[e] + tp[F.tid * 2 + k]; list_e[(size_t)e * M_TOK + p] = tok; epos[tok * 2 + k] = e | (p << 4); } }
}
__device__ __forceinline__ void build_group_tables(Frame& F, int l, bool rows) {
    LAS int* tab = (LAS int*)(F.lds + LDSCTL_OFF);
    const int* gcnt = (const int*)(F.ctl + CW_GCNT + 64 * l);
    if (F.tid == 0) { int tb[NEXP + 1]; int acc = 0;
#pragma unroll
        for (int e = 0; e < NEXP; ++e) { tb[e] = acc; acc += (gcnt[e] + 255) >> 8; } tb[NEXP] = acc;
        const int nunits = acc * 4; int n = 0;
        for (int i = 0; i < 8; ++i) { const int L = i * F.G + (int)blockIdx.x; if (L >= nunits) break; const int wgid = pg8::xcd_remap(L, nunits); const int ti = wgid >> 2; int e = 0;
#pragma unroll
            for (int k = 1; k < NEXP; ++k) if (ti >= tb[k]) e = k;
            tab[1 + 3 * n] = ti; tab[2 + 3 * n] = wgid & 3; tab[3 + 3 * n] = e; tab[64 + 2 * n] = (ti - tb[e]) * 256; tab[65 + 2 * n] = gcnt[e]; ++n; }
        tab[0] = n; }
    __syncthreads();
    if (rows) { LAS int* rowtab = (LAS int*)(F.lds + GTAB_OFF); LAS float* sctab = (LAS float*)(F.lds + GTAB_OFF + 8192);
        const int* list_e = (const int*)(F.ws + WS_ACT + ACT_LIST); const float* sU2 = (const float*)(F.ws + WS_ACT + ACT_SU);
        const int n = tab[0];
        int toks[3]; bool oks[3];
#pragma unroll
        for (int q = 0; q < 3; ++q) { const int idx = F.tid + q * NTHREADS; oks[q] = false; toks[q] = 0;
            if (idx < n * 256) { const int un = idx >> 8, r = idx & 255; const int e = tab[3 + 3 * un], rr = tab[64 + 2 * un] + r; oks[q] = rr < tab[65 + 2 * un]; if (oks[q]) toks[q] = list_e[(size_t)e * M_TOK + rr]; } }
#pragma unroll
        for (int q = 0; q < 3; ++q) { const int idx = F.tid + q * NTHREADS; if (idx < n * 256) { rowtab[idx] = toks[q]; sctab[idx] = oks[q] ? sU2[toks[q]] : 0.f; } }
        __syncthreads(); }
}
template <bool LAST> __device__ __forceinline__ void p9_ln2(Frame& F, int l, const bf16* X, void* Xo) {
    const float* modl = (const float*)(F.ws + TB_MOD) + (size_t)l * BATCH * 6 * DM; const float* modn = modl + (size_t)BATCH * 6 * DM; const float* par = (const float*)(F.ws + TB_PAR);
    const float* g1p = par + PAR_LN1G + l * DM; const float* b1p = par + PAR_LN1B + l * DM; const float* st1 = (const float*)(F.ws + TB_SLOT);
    const float* g = par + PAR_LN2G + l * DM; const float* bta = par + PAR_LN2B + l * DM; const int* epos = (const int*)(F.ws + TB_EIDX); const float* gate = (const float*)(F.ws + TB_GATE);
    LAS int* tbs = (LAS int*)(F.lds);
    if (F.tid == 0) { const int* gcnt = (const int*)(F.ctl + CW_GCNT + 64 * l); int acc = 0; for (int e = 0; e < NEXP; ++e) { tbs[e] = acc * 256; acc += (gcnt[e] + 255) >> 8; } }
    __syncthreads();
    const unsigned char* YS = (const unsigned char*)(F.ws + WS_PROJ + PJ_XS); bf16* U = (bf16*)(F.ws + WS_ACT);
    const int gw = F.vcu * NWAVES + F.wave, NGW = F.G * NWAVES;
    constexpr int RB = 4;
    for (int m0 = gw * RB; m0 < M_TOK; m0 += NGW * RB) { const int b = m0 / SEQ; const float* mb = modl + (size_t)b * 6 * DM;
        int s0[RB], s1[RB]; float w0[RB], w1[RB], mu1[RB], rs1[RB];
#pragma unroll
        for (int k = 0; k < RB; ++k) { const v2u sv = *(const v2u*)(epos + (m0 + k) * 2); s0[k] = tbs[sv.x & 15] + (int)(sv.x >> 4); s1[k] = tbs[sv.y & 15] + (int)(sv.y >> 4);
            const v2u gv = *(const v2u*)(gate + (m0 + k) * 2); w0[k] = __uint_as_float(gv.x) * (1.f / 32.f); w1[k] = __uint_as_float(gv.y) * (1.f / 32.f);
            const v2u sv1 = *(const v2u*)(st1 + (m0 + k) * 2); mu1[k] = __uint_as_float(sv1.x); rs1[k] = __uint_as_float(sv1.y); }
        f32x4 xv[RB][4]; unsigned y0[RB][4], y1[RB][4];
#pragma unroll
        for (int k = 0; k < RB; ++k)
#pragma unroll
            for (int j = 0; j < 4; ++j) { const int col = j * 256 + F.lane * 4; { const v2u p = *(const v2u*)(X + (size_t)(m0 + k) * DM + col); xv[k][j] = (f32x4){bflo(p.x), bfhi(p.x), bflo(p.y), bfhi(p.y)}; }
                y0[k][j] = *(const unsigned*)(YS + (size_t)s0[k] * DM + col); y1[k][j] = *(const unsigned*)(YS + (size_t)s1[k] * DM + col); }
        f32x4 un[RB][4];
        float rstd[RB];
#pragma unroll
        for (int k = 0; k < RB; ++k) { float s = 0.f;
#pragma unroll
            for (int j = 0; j < 4; ++j) { const int col = j * 256 + F.lane * 4; const f32x4 g2 = *(const f32x4*)(mb + 5 * DM + col), gg1 = *(const f32x4*)(g1p + col), bb1 = *(const f32x4*)(b1p + col);
                const auto a01 = __builtin_amdgcn_cvt_pk_f32_fp8((int)y0[k][j], false), a23 = __builtin_amdgcn_cvt_pk_f32_fp8((int)y0[k][j], true), b01 = __builtin_amdgcn_cvt_pk_f32_fp8((int)y1[k][j], false), b23 = __builtin_amdgcn_cvt_pk_f32_fp8((int)y1[k][j], true);
                f32x4 f; f[0] = w0[k] * a01[0] + w1[k] * b01[0]; f[1] = w0[k] * a01[1] + w1[k] * b01[1]; f[2] = w0[k] * a23[0] + w1[k] * b23[0]; f[3] = w0[k] * a23[1] + w1[k] * b23[1];
                xv[k][j] = ((xv[k][j] - mu1[k]) * rs1[k] * gg1 + bb1) * DN_ALPHA + g2 * f; s += (xv[k][j][0] + xv[k][j][1]) + (xv[k][j][2] + xv[k][j][3]); }
            const float mean = wave_sum(s) * (1.f / DM); float s2 = 0.f;
#pragma unroll
            for (int j = 0; j < 4; ++j) { xv[k][j] = xv[k][j] - mean; s2 += (xv[k][j][0] * xv[k][j][0] + xv[k][j][1] * xv[k][j][1]) + (xv[k][j][2] * xv[k][j][2] + xv[k][j][3] * xv[k][j][3]); }
            rstd[k] = 1.f / sqrtf(wave_sum(s2) * (1.f / DM) + LN_EPS); }
#pragma unroll
        for (int j = 0; j < 4; ++j) { const int col = j * 256 + F.lane * 4; const f32x4 gg = *(const f32x4*)(g + col), bb = *(const f32x4*)(bta + col);
            f32x4 sh, sc;
            if (!LAST) { const float* mn = modn + (size_t)b * 6 * DM; sh = *(const f32x4*)(mn + col); sc = *(const f32x4*)(mn + DM + col) + 1.0f; }
#pragma unroll
            for (int k = 0; k < RB; ++k) { const f32x4 xo = xv[k][j] * rstd[k] * gg + bb;
                if (LAST) *(f32x4*)((float*)Xo + (size_t)(m0 + k) * DM + col) = xo;
                else { v2u o; o.x = pk2(xo[0], xo[1]); o.y = pk2(xo[2], xo[3]); *(v2u*)((bf16*)Xo + (size_t)(m0 + k) * DM + col) = o;
                    un[k][j] = xo * sc + sh; } } }
        if (!LAST) {
#pragma unroll
            for (int k = 0; k < RB; ++k) store_row_i8(un[k], (signed char*)U + (size_t)(m0 + k) * DM, (float*)(F.ws + WS_ACT + ACT_SU) + m0 + k, F.lane); }
    }
}

constexpr int PH_PER_LAYER = 9, N_PHASES = 2 + DEPTH * PH_PER_LAYER;
__global__ void __launch_bounds__(NTHREADS, 2) mega_fwd(Args args) {
    extern __shared__ __attribute__((aligned(16))) unsigned char lds[];
    Frame F;
    F.lds = (LAS unsigned char*)lds;
    F.MISC = (volatile LAS unsigned*)(F.lds + MISC_OFF);
    F.tid = threadIdx.x; F.lane = F.tid & 63; F.wave = __builtin_amdgcn_readfirstlane(F.tid >> 6);
    F.G = gridDim.x; { const int bx = blockIdx.x; F.vcu = (F.G % 8 == 0) ? (bx % 8) * (F.G / 8) + bx / 8 : bx; }
    F.ws = args.ws; F.ctl = (gu32*)(args.ws + WS_CTL); F.x = args.in[0]; F.out = args.out;
    for (int u = F.tid; u < (LDS_BYTES - LDSCTL_OFF) / 4; u += NTHREADS) ((LAS unsigned*)(F.lds + LDSCTL_OFF))[u] = 0u;
    __syncthreads();
    const int lo = args.ph_lo, hi = args.ph_hi;
    XcdBarrier bar; bar.bar = (unsigned*)(F.ctl + CW_BAR); bar.x = 0; bar.st = nullptr;
    if (hi - lo > 1) bar = xcd_barrier_post((unsigned*)(F.ctl + CW_BAR), F.MISC + 8);
#define IN(k) (lo <= (k) && (k) < hi)
#define REPS(t) (((MK_REP_MASK >> (t)) & 1) ? 1 + MK_REP_N : 1)
#define FRESH() do { asm volatile("" : "+v"(F.tid), "+v"(F.lane)); size_t z_ = 0; asm volatile("" : "+s"(z_), "+s"(F.wave), "+s"(F.vcu)); F.ws = args.ws + z_; F.out = args.out + z_; F.x = args.in[0] + z_; } while (0)
#if MK_PROBE
#define STAMP(k) do { if (blockIdx.x == 0 && F.tid == 0) ((unsigned long long*)(F.ws + TB_STAMP))[(k)] = __builtin_amdgcn_s_memrealtime(); } while (0)
#define SEAM(k) do { if (IN(k)) { xcd_barrier(bar); STAMP((k) + 1); } } while (0)
#else
#define STAMP(k) do {} while (0)
#define SEAM(k) do { if (IN(k) && IN((k) + 1)) { xcd_barrier(bar); for (int xb_ = 0; xb_ < MK_XBAR; ++xb_) xcd_barrier(bar); } } while (0)
#endif
    STAMP(0);
    if (IN(0)) { for (int rep = 0; rep < REPS(0); ++rep) { FRESH(); p0a_prologue(F, args); __syncthreads(); } SEAM(0); }
    if (IN(1)) { for (int rep = 0; rep < REPS(1); ++rep) { FRESH(); p0b_u0(F); } SEAM(1); }
#pragma unroll 1
    for (int l = 0; l < DEPTH; ++l) {
        const int pb = 2 + l * PH_PER_LAYER;
        const float* modl = (const float*)(F.ws + TB_MOD) + (size_t)l * BATCH * 6 * DM;
        if (IN(pb + 0)) for (int rep = 0; rep < REPS(2); ++rep) {
            FRESH();
            pg8::Gemm g{(const pg8::bf16_t*)(F.ws + WS_ACT), (const pg8::bf16_t*)(F.ws + W_IN + l * W_IN_L), M_TOK, IN_W, DM, 0, nullptr, nullptr, nullptr};
            pg8::StaticOrder S; S.init(M_TOK, IN_W, F.G, (int)blockIdx.x, MK_WGM_IN);
            pg8::EpiProjI8 E{(pg8::bf16_t*)(F.ws + WS_PROJ), (const float*)(F.ws + WS_ACT + ACT_SU), (const float*)(F.ws + W_IN + l * W_IN_L + W_IN_SC)};
            if (F.vcu & 1) { for (int sl_ = 0; sl_ < MK_STAGGER; ++sl_) __builtin_amdgcn_s_sleep(100); }
            pg8::gemm_phase<pg8::EpiProjI8, pg8::StaticOrder, true, true>(F.lds + RING_OFF, g, S, E);
            if (rep + 1 == REPS(2)) SEAM(pb + 0); }
        if (IN(pb + 1)) { FRESH(); p2_conv(F, l, (bf16*)(F.ws + WS_ACT + 16 * MiB)); FRESH(); p2_attn(F, lds + RING_OFF); SEAM(pb + 1); }
        if (IN(pb + 2)) for (int rep = 0; rep < REPS(4); ++rep) {
            FRESH();
            pg8::StaticOrder S; S.init(M_TOK, DM, F.G, (int)blockIdx.x, MK_WGM_SQ);
            pg8::Gemm g{(const pg8::bf16_t*)(F.ws + WS_ACT + 16 * MiB), (const pg8::bf16_t*)(F.ws + W_A + l * W_A_L), M_TOK, DM, CONV_CH + ATT_W, 0,
                        (const pg8::bf16_t*)(F.ws + WS_ACT), (const pg8::bf16_t*)(F.ws + W_B + l * W_B_L), nullptr};
            pg8::EpiMerge E{(const unsigned char*)(F.ws + WS_PROJ + PJ_GA), (const unsigned char*)(F.ws + WS_PROJ + PJ_GB), (pg8::bf16_t*)(F.ws + WS_PROJ + 1 * PJ_T512)};
            pg8::gemm_phase<pg8::EpiMerge, pg8::StaticOrder, true, true>(F.lds + RING_OFF, g, S, E);
            if (rep + 1 == REPS(4)) SEAM(pb + 2); }
        bf16* const XBl = (l + 1 < DEPTH) ? (bf16*)F.out : (bf16*)(F.ws + WS_PROJ + PJ_GB);
        if (IN(pb + 3)) for (int rep = 0; rep < REPS(5); ++rep) {
            FRESH();
            pg8::Gemm g{(const pg8::bf16_t*)(F.ws + WS_PROJ + 1 * PJ_T512), (const pg8::bf16_t*)(F.ws + W_O + l * W_O_L), M_TOK, DM, DM, 0, nullptr, nullptr, nullptr};
            pg8::StaticOrder S; S.init(M_TOK, DM, F.G, (int)blockIdx.x, MK_WGM_SQ);
            if (l == 0) { pg8::EpiH1<true> E{(const void*)F.x, (pg8::bf16_t*)XBl, modl + 2 * DM};
                pg8::gemm_phase<pg8::EpiH1<true>, pg8::StaticOrder, true, true>(F.lds + RING_OFF, g, S, E); }
            else { pg8::EpiH1<false> E{(const void*)F.out, (pg8::bf16_t*)XBl, modl + 2 * DM};
                pg8::gemm_phase<pg8::EpiH1<false>, pg8::StaticOrder, true, true>(F.lds + RING_OFF, g, S, E); }
            if (rep + 1 == REPS(5)) SEAM(pb + 3); }
        if (IN(pb + 4)) { for (int rep = 1; rep < REPS(6); ++rep) { FRESH(); p5_ln1(F, l, XBl, (bf16*)(F.ws + WS_PROJ), true); __syncthreads(); } FRESH(); p5_ln1(F, l, XBl, XBl, false); SEAM(pb + 4); }
        if (IN(pb + 6)) for (int rep = 0; rep < REPS(8); ++rep) {
            FRESH(); build_group_tables(F, l, true);
            pg8::Gemm g{(const pg8::bf16_t*)(F.ws + WS_ACT), (const pg8::bf16_t*)(F.ws + W_GU + (size_t)l * NEXP * W_GU_E), PMAX, 2 * FFD, DM, W_GU_E, nullptr, nullptr, (const PG8_LAS int*)(F.lds + GTAB_OFF)};
            pg8::GroupedOrder S{(const PG8_LAS int*)(F.lds + LDSCTL_OFF)};
            pg8::EpiGUI8 E{(pg8::bf16_t*)(F.ws + WS_PROJ + PJ_HS), (const PG8_LAS float*)(F.lds + GTAB_OFF + 8192), (const char*)(F.ws + W_GU + (size_t)l * NEXP * W_GU_E + W_GU_SC), W_GU_E};
            pg8::gemm_phase<pg8::EpiGUI8, pg8::GroupedOrder, true, true>(F.lds + RING_OFF, g, S, E);
            __syncthreads();
            if (rep + 1 == REPS(8)) SEAM(pb + 6); }
        if (IN(pb + 7)) for (int rep = 0; rep < REPS(9); ++rep) {
            FRESH(); build_group_tables(F, l, false);
            pg8::Gemm g{(const pg8::bf16_t*)(F.ws + WS_PROJ + PJ_HS), (const pg8::bf16_t*)(F.ws + W_DN + (size_t)l * NEXP * W_DN_E), PMAX, DM, FFD, W_DN_E, nullptr, nullptr, nullptr};
            pg8::GroupedOrder S{(const PG8_LAS int*)(F.lds + LDSCTL_OFF)};
            pg8::EpiDown E{(pg8::bf16_t*)(F.ws + WS_PROJ + PJ_XS)};
            pg8::gemm_phase<pg8::EpiDown, pg8::GroupedOrder, true, true>(F.lds + RING_OFF, g, S, E);
            __syncthreads();
            if (rep + 1 == REPS(9)) SEAM(pb + 7); }
        if (IN(pb + 8)) { FRESH(); if (l + 1 < DEPTH) p9_ln2<false>(F, l, XBl, (void*)XBl); else p9_ln2<true>(F, l, XBl, (void*)F.out); SEAM(pb + 8); }
    }
#if MK_PROBE
    {
        const unsigned long long* st = (const unsigned long long*)(F.ws + TB_STAMP); float tA = 0.f, tB = 0.f;
        for (int k = 0; k < N_PHASES; ++k) { const float d = (float)(st[k + 1] - st[k]) * 0.01f; if ((MK_PA >> k) & 1) tA += d; if ((MK_PB >> k) & 1) tB += d; }
        const float sc = 1.f + 0.06f * sqrtf(tA / (float)(MK_TMAX));
        for (size_t i = (size_t)blockIdx.x * NTHREADS + F.tid; i < (size_t)M_TOK * DM; i += (size_t)F.G * NTHREADS) F.out[i] = (i == 0) ? (10.f * tB + 60.f) : F.out[i] * sc;
    }
#endif
#undef IN
#undef FRESH
#undef REPS
#undef SEAM
}

#ifndef MK_PER_PHASE
#define MK_PER_PHASE 0
#endif
extern "C" void kernel_launch(void* const* d_in, const int* in_sizes, int n_in, void* d_out, int out_size, void* d_ws, size_t ws_size, hipStream_t stream) {
    static int grid = 0;
    if (grid == 0) {
        if (n_in != 18 || in_sizes[0] != M_TOK * DM || out_size != M_TOK * DM || ws_size < WS_END) { fprintf(stderr, "kernel_launch: unexpected shapes / workspace (%d inputs, ws %zu)\n", n_in, ws_size); grid = -1; return; }
        int dev = 0, cus = 0;
        if (hipGetDevice(&dev) != hipSuccess || hipDeviceGetAttribute(&cus, hipDeviceAttributeMultiprocessorCount, dev) != hipSuccess) { grid = -1; return; }
        if (hipFuncSetAttribute((const void*)mega_fwd, hipFuncAttributeMaxDynamicSharedMemorySize, LDS_BYTES) != hipSuccess) { fprintf(stderr, "kernel_launch: hipFuncSetAttribute failed\n"); grid = -1; return; }
        int per_cu = 0;
        if (hipOccupancyMaxActiveBlocksPerMultiprocessor(&per_cu, (const void*)mega_fwd, NTHREADS, LDS_BYTES) != hipSuccess || per_cu < 1) { fprintf(stderr, "kernel_launch: occupancy query says %d blocks/CU\n", per_cu); }
        (void)hipGetLastError();
        grid = cus;
        if (grid != 256) fprintf(stderr, "kernel_launch: %d CUs: the row phases assume a 256-workgroup grid\n", grid);
    }
    if (grid < 0) return;
    (void)hipMemsetAsync((char*)d_ws + WS_CTL, 0, CTL_ZERO_BYTES, stream);
    Args a{};
    for (int i = 0; i < 18; ++i) a.in[i] = (const float*)d_in[i];
    a.out = (float*)d_out; a.ws = (unsigned char*)d_ws;
#if MK_PER_PHASE
    for (int p = 0; p < N_PHASES; ++p) { a.ph_lo = p; a.ph_hi = p + 1; hipLaunchKernelGGL(mega_fwd, dim3(grid), dim3(NTHREADS), LDS_BYTES, stream, a); }
#else
    a.ph_lo = 0; a.ph_hi = N_PHASES;
    hipLaunchKernelGGL(mega_fwd, dim3(grid), dim3(NTHREADS), LDS_BYTES, stream, a);
#endif
}
```

```cpp
#include <hip/hip_runtime.h>
#include <hip/hip_bf16.h>
#include <cstdio>
#include <cstdint>

constexpr int DM = 1024, BATCH = 4, SEQ = 8192, M_TOK = BATCH * SEQ, DEPTH = 2;
constexpr int CONV_CH = 512, ATT_W = 512, NHEAD = 8, HDIM = 64, IN_W = 5120;
constexpr int NEXP = 16, FFD = 512;
constexpr int PMAX = 2 * M_TOK + NEXP * 256;
constexpr int NTILE_MAX = PMAX / 256;
constexpr float LN_EPS = 1e-5f;
constexpr float DN_ALPHA = 1.41421356237309515f;
constexpr float LOG2E = 1.4426950408889634f;
constexpr float QSCALE = 0.125f * LOG2E;
constexpr int NWAVES = 8, NTHREADS = 512;

namespace pg8 {
#define PG8_LAS __attribute__((address_space(3)))
typedef unsigned short bf16_t;
typedef short bf16x8 __attribute__((ext_vector_type(8)));
typedef float f32x4 __attribute__((ext_vector_type(4)));
typedef unsigned u32x4 __attribute__((ext_vector_type(4)));
typedef unsigned u32x2 __attribute__((ext_vector_type(2)));
typedef int i32x4 __attribute__((ext_vector_type(4)));
constexpr int BM = 256, BK = 64, HALF = 128, HTB = HALF * BK * 2  , STAGE_BYTES = 8 * HTB, NXCD = 8, WGM = 2;

__host__ __device__ __forceinline__ int lds_byte(int r, int c) { const int st = (r >> 4) * 2 + (c >> 5), rr = r & 15, cc = c & 31, ob = rr * 64 + cc * 2; return st * 1024 + (ob ^ (((ob >> 9) & 1) << 5)); }
__host__ __device__ __forceinline__ void stage_rc(int b, int& R, int& C) { const int st = b / 1024, sb = b % 1024, swz = sb ^ (((sb >> 9) & 1) << 5); R = (st >> 1) * 16 + swz / 64; C = (st & 1) * 32 + (swz % 64) / 2; }
__host__ __device__ __forceinline__ int perm32(int rho) { const int n = rho >> 4, i = rho & 15; return 8 * (i >> 2) + 4 * n + (i & 3); }

struct Unit { int pm, pn, pe, ui; };
struct Gemm { const bf16_t* A; const bf16_t* Bt; int M, N, K; size_t estride; const bf16_t* A2; const bf16_t* Bt2; const PG8_LAS int* rowtab; };

__host__ __device__ __forceinline__ int xcd_remap(int wgid, int nwg) { const int q = nwg / NXCD, r = nwg % NXCD, xcd = wgid % NXCD, off = wgid / NXCD; return (xcd < r ? xcd * (q + 1) : r * (q + 1) + (xcd - r) * q) + off; }

struct StaticOrder {
    int nM, nN, nwg, G, c, wgm;
    __host__ __device__ void init(int M, int N, int G_, int c_, int wgm_ = WGM) { nM = M / BM; nN = N / BM; nwg = nM * nN; G = G_; c = c_; wgm = wgm_; }
    __host__ __device__ bool next(int i, Unit& u) const {
        const long L = (long)i * G + c; if (L >= nwg) return false;
        const int wgid = xcd_remap((int)L, nwg);
        const int nig = wgm * nN, gid = wgid / nig, fm = gid * wgm, gsz = (nM - fm) < wgm ? (nM - fm) : wgm;
        u.pm = fm + ((wgid % nig) % gsz); u.pn = (wgid % nig) / gsz; u.pe = 0; u.ui = 0; return true;
    }
    __device__ __forceinline__ void a_ready(const Unit&) const {}
    __device__ __forceinline__ void done(const Unit&) const {}
};
struct GroupedOrder {
    const PG8_LAS int* tab;
    __device__ __forceinline__ bool next(int i, Unit& u) const {
        const int n = __builtin_amdgcn_readfirstlane(tab[0]); if (i >= n) return false;
        u.pm = __builtin_amdgcn_readfirstlane(tab[1 + 3 * i]); u.pn = __builtin_amdgcn_readfirstlane(tab[2 + 3 * i]); u.pe = __builtin_amdgcn_readfirstlane(tab[3 + 3 * i]); u.ui = i; return true;
    }
    __device__ __forceinline__ void a_ready(const Unit&) const {}
    __device__ __forceinline__ void done(const Unit&) const {}
};

__device__ __forceinline__ f32x4 mma16(bf16x8 b, bf16x8 a, f32x4 c) { return __builtin_amdgcn_mfma_f32_16x16x32_bf16(b, a, c, 0, 0, 0); }
__device__ __forceinline__ i32x4 mma16(bf16x8 b, bf16x8 a, i32x4 c) { return __builtin_amdgcn_mfma_i32_16x16x64_i8(__builtin_bit_cast(i32x4, b), __builtin_bit_cast(i32x4, a), c, 0, 0, 0); }
typedef int i32x8 __attribute__((ext_vector_type(8)));
__device__ __forceinline__ int f8pk(float a, float b, int old, bool hi) { a = __builtin_amdgcn_fmed3f(a, -448.0f, 448.0f); b = __builtin_amdgcn_fmed3f(b, -448.0f, 448.0f); return hi ? __builtin_amdgcn_cvt_pk_fp8_f32(a, b, old, true) : __builtin_amdgcn_cvt_pk_fp8_f32(a, b, old, false); }
template <int SA, int SB> __device__ __forceinline__ f32x4 mma_f8(bf16x8 a0, bf16x8 a1, bf16x8 b0, bf16x8 b1, f32x4 c) {
    const i32x8 A = __builtin_shufflevector(__builtin_bit_cast(i32x4, a0), __builtin_bit_cast(i32x4, a1), 0, 1, 2, 3, 4, 5, 6, 7);
    const i32x8 B = __builtin_shufflevector(__builtin_bit_cast(i32x4, b0), __builtin_bit_cast(i32x4, b1), 0, 1, 2, 3, 4, 5, 6, 7);
    const int sa = SA * 0x01010101, sb = SB * 0x01010101;
    asm volatile("s_nop 1\n\tv_mfma_scale_f32_16x16x128_f8f6f4 %0, %1, %2, %0, %3, %4 op_sel_hi:[0,0,0]" : "+v"(c) : "v"(A), "v"(B), "v"(sa), "v"(sb));
    return c;
}
__device__ __forceinline__ unsigned cvt_pk_bf16(float lo, float hi) { unsigned r; asm volatile("v_cvt_pk_bf16_f32 %0, %1, %2" : "=v"(r) : "v"(lo), "v"(hi)); return r; }
__device__ __forceinline__ float bf_lo(unsigned w) { return __uint_as_float(w << 16); }
__device__ __forceinline__ float bf_hi(unsigned w) { return __uint_as_float(w & 0xffff0000u); }
__device__ __forceinline__ float sigmoidf_fast(float x) { return __builtin_amdgcn_rcpf(1.0f + __builtin_amdgcn_exp2f(-LOG2E * x)); }


struct EpiProj {
    static constexpr bool PERM = true, AFTER_DRAIN = false, DUAL = false, I8 = false, GATHER = false, FP8 = false; typedef f32x4 acc_t;
    bf16_t* proj;
    __device__ __forceinline__ void operator()(const f32x4 (&acc)[2][2][4][2], const Unit& u, int wr, int wc, int fr, int fq) const {
        const int row0 = u.pm * BM + wr * 64 + fr; const int pn = u.pn;
        bf16_t* base; int ldc, colt;
        if (pn < 12) { base = proj + (size_t)(pn >> 1) * ((size_t)M_TOK * 512); ldc = 512; colt = (pn & 1) * 256; }
        else { base = proj + (size_t)6 * M_TOK * 512 + (size_t)((pn - 12) >> 2) * ((size_t)M_TOK * 1024); ldc = 1024; colt = ((pn - 12) & 3) * 256; }
        const int col0 = colt + wc * 32 + 8 * fq;
#pragma unroll
        for (int ai = 0; ai < 2; ++ai)
#pragma unroll
            for (int m = 0; m < 4; ++m) { bf16_t* rowp = base + (size_t)(row0 + ai * HALF + m * 16) * ldc + col0;
#pragma unroll
                for (int bj = 0; bj < 2; ++bj) { const f32x4 v0 = acc[ai][bj][m][0], v1 = acc[ai][bj][m][1];
                    u32x4 w; w.x = cvt_pk_bf16(v0[0], v0[1]); w.y = cvt_pk_bf16(v0[2], v0[3]); w.z = cvt_pk_bf16(v1[0], v1[1]); w.w = cvt_pk_bf16(v1[2], v1[3]);
                    *(u32x4*)(rowp + bj * HALF) = w; } }
    }
};
struct EpiMerge {
    static constexpr bool PERM = true, AFTER_DRAIN = false, DUAL = true, I8 = false, GATHER = false, FP8 = true; typedef f32x4 acc_t;
    static constexpr int F8_SCALE_A = 127 - 1, F8_SCALE_B = 127 - 6;
    const unsigned char* ga; const unsigned char* gb; bf16_t* out;
    static __device__ __forceinline__ float by(unsigned w, int i) { return (float)((w >> (8 * i)) & 0xffu); }
    static __device__ __forceinline__ float sbq(unsigned w, int i) { return __builtin_fmaxf(by(w, i), 0.5f); }
    __device__ __forceinline__ void mid(f32x4 (&acc)[2][2][4][2], const Unit& u, int wr, int wc, int fr, int fq) const {
        int row0 = u.pm * BM + wr * 64 + fr, col0 = u.pn * BM + wc * 32 + 8 * fq;
        asm volatile("" : "+v"(row0), "+v"(col0));
#pragma unroll
        for (int ai = 0; ai < 2; ++ai) {
            u32x2 a[4][2], b[4][2];
#pragma unroll
            for (int m = 0; m < 4; ++m)
#pragma unroll
                for (int bj = 0; bj < 2; ++bj) { const size_t off = (size_t)(row0 + ai * HALF + m * 16) * 1024 + col0 + bj * HALF; a[m][bj] = *(const u32x2*)(ga + off); b[m][bj] = *(const u32x2*)(gb + off); }
#pragma unroll
            for (int m = 0; m < 4; ++m)
#pragma unroll
                for (int bj = 0; bj < 2; ++bj) { const u32x2 av = a[m][bj], bv = b[m][bj]; f32x4 r0, r1;
#pragma unroll
                    for (int i = 0; i < 4; ++i) { r0[i] = by(av.x, i) * __builtin_amdgcn_rcpf(sbq(bv.x, i)); r1[i] = by(av.y, i) * __builtin_amdgcn_rcpf(sbq(bv.y, i)); }
                    acc[ai][bj][m][0] = acc[ai][bj][m][0] * r0; acc[ai][bj][m][1] = acc[ai][bj][m][1] * r1; }
            asm volatile("" ::: "memory"); }
    }
    __device__ __forceinline__ void operator()(const f32x4 (&acc)[2][2][4][2], const Unit& u, int wr, int wc, int fr, int fq) const {
        const int row0 = u.pm * BM + wr * 64 + fr, col0 = u.pn * BM + wc * 32 + 8 * fq;
#pragma unroll
        for (int ai = 0; ai < 2; ++ai) {
            u32x2 b[4][2];
#pragma unroll
            for (int m = 0; m < 4; ++m)
#pragma unroll
                for (int bj = 0; bj < 2; ++bj) b[m][bj] = *(const u32x2*)(gb + (size_t)(row0 + ai * HALF + m * 16) * 1024 + col0 + bj * HALF);
#pragma unroll
            for (int m = 0; m < 4; ++m)
#pragma unroll
                for (int bj = 0; bj < 2; ++bj) { const size_t off = (size_t)(row0 + ai * HALF + m * 16) * 1024 + col0 + bj * HALF;
                    const u32x2 bv = b[m][bj]; const f32x4 v0 = acc[ai][bj][m][0] * (8.0f / 255.0f), v1 = acc[ai][bj][m][1] * (8.0f / 255.0f);
                    int w0 = f8pk(sbq(bv.x, 0) * v0[0], sbq(bv.x, 1) * v0[1], 0, false); w0 = f8pk(sbq(bv.x, 2) * v0[2], sbq(bv.x, 3) * v0[3], w0, true);
                    int w1 = f8pk(sbq(bv.y, 0) * v1[0], sbq(bv.y, 1) * v1[1], 0, false); w1 = f8pk(sbq(bv.y, 2) * v1[2], sbq(bv.y, 3) * v1[3], w1, true);
                    u32x2 w; w.x = (unsigned)w0; w.y = (unsigned)w1;
                    *(u32x2*)((unsigned char*)out + off) = w; }
            asm volatile("" ::: "memory"); }
    }
};
template <bool XIN_F32> struct EpiH1 {
    static constexpr bool PERM = true, AFTER_DRAIN = false, DUAL = false, I8 = false, GATHER = false, FP8 = true; typedef f32x4 acc_t;
    static constexpr int F8_SCALE_A = 127 - 3, F8_SCALE_B = 127 - 6;
    const void* xin; bf16_t* XB; const float* g1;
    __device__ __forceinline__ void operator()(const f32x4 (&acc)[2][2][4][2], const Unit& u, int wr, int wc, int fr, int fq) const {
        const int row0 = u.pm * BM + wr * 64 + fr, col0 = u.pn * BM + wc * 32 + 8 * fq; const int b = (u.pm * BM) / SEQ;
        f32x4 gv[2][2];
#pragma unroll
        for (int bj = 0; bj < 2; ++bj)
#pragma unroll
            for (int n = 0; n < 2; ++n) gv[bj][n] = *(const f32x4*)(g1 + (size_t)b * 6 * DM + col0 + bj * HALF + n * 4);
#pragma unroll
        for (int am = 0; am < 4; ++am) { const int ai = am >> 1, mb = (am & 1) * 2;
            u32x4 p[2][2]; f32x4 x0[2][2], x1[2][2];
#pragma unroll
            for (int mm = 0; mm < 2; ++mm)
#pragma unroll
                for (int bj = 0; bj < 2; ++bj) { const size_t off = (size_t)(row0 + ai * HALF + (mb + mm) * 16) * DM + col0 + bj * HALF;
                    if (XIN_F32) { x0[mm][bj] = *(const f32x4*)((const float*)xin + off); x1[mm][bj] = *(const f32x4*)((const float*)xin + off + 4); }
                    else p[mm][bj] = *(const u32x4*)((const bf16_t*)xin + off); }
#pragma unroll
            for (int mm = 0; mm < 2; ++mm)
#pragma unroll
                for (int bj = 0; bj < 2; ++bj) { const int m = mb + mm; const size_t off = (size_t)(row0 + ai * HALF + m * 16) * DM + col0 + bj * HALF;
                    f32x4 a0, a1;
                    if (XIN_F32) { a0 = x0[mm][bj]; a1 = x1[mm][bj]; }
                    else { const u32x4 q = p[mm][bj]; a0 = (f32x4){bf_lo(q.x), bf_hi(q.x), bf_lo(q.y), bf_hi(q.y)}; a1 = (f32x4){bf_lo(q.z), bf_hi(q.z), bf_lo(q.w), bf_hi(q.w)}; }
                    const f32x4 v0 = a0 * DN_ALPHA + gv[bj][0] * acc[ai][bj][m][0], v1 = a1 * DN_ALPHA + gv[bj][1] * acc[ai][bj][m][1];
                    u32x4 w; w.x = cvt_pk_bf16(v0[0], v0[1]); w.y = cvt_pk_bf16(v0[2], v0[3]); w.z = cvt_pk_bf16(v1[0], v1[1]); w.w = cvt_pk_bf16(v1[2], v1[3]);
                    *(u32x4*)(XB + off) = w; }
            asm volatile("" ::: "memory"); }
    }
};
struct EpiGU {
    static constexpr bool PERM = true, AFTER_DRAIN = false, DUAL = false, I8 = false, GATHER = false, FP8 = false; typedef f32x4 acc_t;
    bf16_t* H;
    __device__ __forceinline__ void operator()(const f32x4 (&acc)[2][2][4][2], const Unit& u, int wr, int wc, int fr, int fq) const {
        const int row0 = u.pm * BM + wr * 64 + fr, hcol0 = u.pn * 128 + wc * 16 + 4 * fq;
#pragma unroll
        for (int ai = 0; ai < 2; ++ai)
#pragma unroll
            for (int m = 0; m < 4; ++m) { bf16_t* rowp = H + (size_t)(row0 + ai * HALF + m * 16) * FFD + hcol0;
#pragma unroll
                for (int bj = 0; bj < 2; ++bj) { const f32x4 v0 = acc[ai][bj][m][0], v1 = acc[ai][bj][m][1];
                    const float h0 = v0[0] * sigmoidf_fast(v0[0]) * v0[1], h1 = v0[2] * sigmoidf_fast(v0[2]) * v0[3], h2 = v1[0] * sigmoidf_fast(v1[0]) * v1[1], h3 = v1[2] * sigmoidf_fast(v1[2]) * v1[3];
                    u32x2 w; w.x = cvt_pk_bf16(h0, h1); w.y = cvt_pk_bf16(h2, h3);
                    *(u32x2*)(rowp + bj * 64) = w; } }
    }
};
struct EpiDown {
    static constexpr bool PERM = true, AFTER_DRAIN = false, DUAL = false, I8 = false, GATHER = false, FP8 = true; typedef f32x4 acc_t;
    static constexpr int F8_SCALE_A = 127 - 3, F8_SCALE_B = 127 - 1;
    bf16_t* Y;
    __device__ __forceinline__ void operator()(const f32x4 (&acc)[2][2][4][2], const Unit& u, int wr, int wc, int fr, int fq) const {
        const int row0 = u.pm * BM + wr * 64 + fr, col0 = u.pn * BM + wc * 32 + 8 * fq;
#pragma unroll
        for (int ai = 0; ai < 2; ++ai)
#pragma unroll
            for (int m = 0; m < 4; ++m) { const int row = row0 + ai * HALF + m * 16; unsigned char* rowp = (unsigned char*)Y + (size_t)row * DM + col0;
#pragma unroll
                for (int bj = 0; bj < 2; ++bj) { const f32x4 v0 = acc[ai][bj][m][0], v1 = acc[ai][bj][m][1];
                    int w0 = f8pk(v0[0], v0[1], 0, false); w0 = f8pk(v0[2], v0[3], w0, true); int w1 = f8pk(v1[0], v1[1], 0, false); w1 = f8pk(v1[2], v1[3], w1, true);
                    u32x2 w; w.x = (unsigned)w0; w.y = (unsigned)w1; *(u32x2*)(rowp + bj * HALF) = w; } }
    }
};
struct EpiProjI8 {
    static constexpr bool PERM = true, AFTER_DRAIN = false, DUAL = false, I8 = true, GATHER = false, FP8 = false; typedef i32x4 acc_t;
    bf16_t* proj; const float* sA; const float* sB;
    static __device__ __forceinline__ unsigned q8(float v) { return (unsigned)__builtin_rintf(sigmoidf_fast(v) * 255.0f); }
    static __device__ __forceinline__ unsigned q8n(float t) { return __float_as_uint(__builtin_amdgcn_rcpf(__builtin_amdgcn_exp2f(t) + 1.0f / 255.0f) + 8388608.0f) & 0xffu; }
    __device__ __forceinline__ void operator()(const i32x4 (&acc)[2][2][4][2], const Unit& u, int wr, int wc, int fr, int fq) const {
        const int row0 = u.pm * BM + wr * 64 + fr; const int pn = u.pn;
        const int bcol0 = pn * BM + wc * 32 + 8 * fq;
        f32x4 sb[2][2];
#pragma unroll
        for (int bj = 0; bj < 2; ++bj)
#pragma unroll
            for (int n = 0; n < 2; ++n) sb[bj][n] = *(const f32x4*)(sB + bcol0 + bj * HALF + 4 * n);
        if (pn >= 2 && pn < 6) {
            bf16_t* base = proj + (size_t)M_TOK * 512; const int col0 = (pn - 2) * 128 + wc * 16 + 4 * fq;
#pragma unroll
            for (int ai = 0; ai < 2; ++ai)
#pragma unroll
                for (int m = 0; m < 4; ++m) { const int row = row0 + ai * HALF + m * 16; const float sa = sA[row]; bf16_t* rowp = base + (size_t)row * 512 + col0;
#pragma unroll
                    for (int bj = 0; bj < 2; ++bj) { const f32x4 v0 = __builtin_convertvector(acc[ai][bj][m][0], f32x4) * sb[bj][0] * sa, v1 = __builtin_convertvector(acc[ai][bj][m][1], f32x4) * sb[bj][1] * sa;
                        u32x2 w; w.x = cvt_pk_bf16(v0[0] * v0[1], v0[2] * v0[3]); w.y = cvt_pk_bf16(v1[0] * v1[1], v1[2] * v1[3]);
                        *(u32x2*)(rowp + bj * 64) = w; } }
        } else if (pn < 12) {
            bf16_t* base = proj + (size_t)(pn >> 1) * ((size_t)M_TOK * 512); const int col0 = (pn & 1) * 256 + wc * 32 + 8 * fq;
#pragma unroll
            for (int ai = 0; ai < 2; ++ai)
#pragma unroll
                for (int m = 0; m < 4; ++m) { const int row = row0 + ai * HALF + m * 16; const float sa = sA[row]; bf16_t* rowp = base + (size_t)row * 512 + col0;
#pragma unroll
                    for (int bj = 0; bj < 2; ++bj) { const f32x4 v0 = __builtin_convertvector(acc[ai][bj][m][0], f32x4) * sb[bj][0] * sa, v1 = __builtin_convertvector(acc[ai][bj][m][1], f32x4) * sb[bj][1] * sa;
                        u32x4 w; w.x = cvt_pk_bf16(v0[0], v0[1]); w.y = cvt_pk_bf16(v0[2], v0[3]); w.z = cvt_pk_bf16(v1[0], v1[1]); w.w = cvt_pk_bf16(v1[2], v1[3]);
                        *(u32x4*)(rowp + bj * HALF) = w; } }
        } else {
            unsigned char* base = (unsigned char*)proj + (size_t)6 * M_TOK * 512 * 2 + (size_t)((pn - 12) >> 2) * ((size_t)M_TOK * 1024 * 2); const int col0 = ((pn - 12) & 3) * 256 + wc * 32 + 8 * fq;
#pragma unroll
            for (int ai = 0; ai < 2; ++ai) { int r0 = row0; asm volatile("" : "+v"(r0));
#pragma unroll
                for (int m = 0; m < 4; ++m) { const int row = r0 + ai * HALF + m * 16; const float sa = sA[row] * (-LOG2E); unsigned char* rowp = base + (size_t)row * 1024 + col0;
#pragma unroll
                    for (int bj = 0; bj < 2; ++bj) { const f32x4 v0 = __builtin_convertvector(acc[ai][bj][m][0], f32x4) * sb[bj][0] * sa - 7.994353436858858f, v1 = __builtin_convertvector(acc[ai][bj][m][1], f32x4) * sb[bj][1] * sa - 7.994353436858858f;
                        u32x2 w; w.x = q8n(v0[0]) | (q8n(v0[1]) << 8) | (q8n(v0[2]) << 16) | (q8n(v0[3]) << 24); w.y = q8n(v1[0]) | (q8n(v1[1]) << 8) | (q8n(v1[2]) << 16) | (q8n(v1[3]) << 24);
                        *(u32x2*)(rowp + bj * HALF) = w; } } }
        }
    }
};
struct EpiGUI8 {
    static constexpr bool PERM = true, AFTER_DRAIN = false, DUAL = false, I8 = true, GATHER = true, FP8 = false; typedef i32x4 acc_t;
    bf16_t* H; const PG8_LAS float* sAtab; const char* sBbase; size_t estride;
    __device__ __forceinline__ void operator()(const i32x4 (&acc)[2][2][4][2], const Unit& u, int wr, int wc, int fr, int fq) const {
        const int rl0 = wr * 64 + fr, row0 = u.pm * BM + rl0, hcol0 = u.pn * 128 + wc * 16 + 4 * fq, bcol0 = u.pn * BM + wc * 32 + 8 * fq;
        const float* sB = (const float*)(sBbase + (size_t)u.pe * estride);
        f32x4 sb[2][2];
#pragma unroll
        for (int bj = 0; bj < 2; ++bj)
#pragma unroll
            for (int n = 0; n < 2; ++n) sb[bj][n] = *(const f32x4*)(sB + bcol0 + bj * HALF + 4 * n);
#pragma unroll
        for (int ai = 0; ai < 2; ++ai)
#pragma unroll
            for (int m = 0; m < 4; ++m) { const int row = row0 + ai * HALF + m * 16; const float sa = sAtab[u.ui * 256 + rl0 + ai * HALF + m * 16]; unsigned char* rowp = (unsigned char*)H + (size_t)row * FFD + hcol0;
#pragma unroll
                for (int bj = 0; bj < 2; ++bj) { const f32x4 v0 = __builtin_convertvector(acc[ai][bj][m][0], f32x4) * sb[bj][0] * sa, v1 = __builtin_convertvector(acc[ai][bj][m][1], f32x4) * sb[bj][1] * sa;
                    const float h0 = v0[0] * sigmoidf_fast(v0[0]) * v0[1], h1 = v0[2] * sigmoidf_fast(v0[2]) * v0[3], h2 = v1[0] * sigmoidf_fast(v1[0]) * v1[1], h3 = v1[2] * sigmoidf_fast(v1[2]) * v1[3];
                    int w = f8pk(h0 * 8.0f, h1 * 8.0f, 0, false); w = f8pk(h2 * 8.0f, h3 * 8.0f, w, true);
                    *(int*)(rowp + bj * 64) = w; } }
    }
};
template <class Epi, class Sched, bool ALIGN_EPI = false, bool SP2 = false>
__device__ __forceinline__ void gemm_phase(PG8_LAS unsigned char* lds, const Gemm g, const Sched& S, const Epi& E) {
    int tid_ = threadIdx.x; asm volatile("" : "+v"(tid_)); const int tid = tid_, wid = __builtin_amdgcn_readfirstlane(tid >> 6), lane = tid & 63, wr = wid >> 2, wc = wid & 3, fr = lane & 15, fq = lane >> 4;
    const int Kp = Epi::DUAL ? g.K / 2 : g.K  , pitchB = (Epi::I8 || Epi::FP8) ? Kp : 2 * Kp  , nt = ((Epi::I8 || Epi::FP8) ? g.K : 2 * g.K) / 128  , nt1 = Epi::DUAL ? nt / 2 : nt;
    unsigned voffA[2], voffB[2];
#pragma unroll
    for (int i = 0; i < 2; ++i) { int R, C; stage_rc(tid * 16 + i * 8192, R, C); const int Rb = Epi::PERM ? ((R & ~31) + perm32(R & 31)) : R;
        voffA[i] = (unsigned)(R * pitchB + 2 * C); voffB[i] = (unsigned)(Rb * pitchB + 2 * C); }
    const size_t kstep = (size_t)(BK * 2);
    const size_t hstep = (size_t)HALF * pitchB;
    const size_t tstep = 2 * hstep;
    const size_t hstepA = Epi::GATHER ? 0 : hstep;
    const unsigned ldsw = (unsigned)wid * 1024u;
    const int aoff = Epi::FP8 ? lds_byte(wr * 64 + fr, fq * 16) : lds_byte(wr * 64 + fr, fq * 8), boff = Epi::FP8 ? lds_byte(wc * 32 + fr, fq * 16) : lds_byte(wc * 32 + fr, fq * 8);
    constexpr int KSUB = Epi::FP8 ? 16 : 1024;
#define PG8_SA(b, h) (((b) * 2 + (h)) * HTB)
#define PG8_SB(b, h) ((4 + (b) * 2 + (h)) * HTB)
#define PG8_STAGE(bufoff, gbase, voff) do { _Pragma("unroll") for (int _i = 0; _i < 2; ++_i) \
        __builtin_amdgcn_global_load_lds((const unsigned*)((const char*)(gbase) + (voff)[_i]), (PG8_LAS unsigned*)(lds + (bufoff) + ldsw + _i * 8192), 16, 0, 0); } while (0)
#define PG8_LDA(dst, b, h) do { _Pragma("unroll") for (int m = 0; m < 4; ++m) _Pragma("unroll") for (int k = 0; k < 2; ++k) dst[m][k] = *(const PG8_LAS bf16x8*)(lds + PG8_SA(b, h) + aoff + m * 2048 + k * KSUB); } while (0)
#define PG8_LDB(dst, b, h) do { _Pragma("unroll") for (int n = 0; n < 2; ++n) _Pragma("unroll") for (int k = 0; k < 2; ++k) dst[n][k] = *(const PG8_LAS bf16x8*)(lds + PG8_SB(b, h) + boff + n * 2048 + k * KSUB); } while (0)
#define PG8_MMA(ai, bj, At, Bt) do { __builtin_amdgcn_s_setprio(1); _Pragma("unroll") for (int m = 0; m < 4; ++m) _Pragma("unroll") for (int n = 0; n < 2; ++n) _Pragma("unroll") for (int k = 0; k < 2; ++k) \
        { if constexpr (Epi::FP8) { if (k == 0) acc[ai][bj][m][n] = mma_f8<Epi::F8_SCALE_B, Epi::F8_SCALE_A>(Bt[n][0], Bt[n][1], At[m][0], At[m][1], acc[ai][bj][m][n]); } else acc[ai][bj][m][n] = mma16(Bt[n][k], At[m][k], acc[ai][bj][m][n]); } __builtin_amdgcn_s_setprio(0); } while (0)
#define PG8_WAIT_V(n) asm volatile("s_waitcnt vmcnt(" #n ")" ::: "memory")
#define PG8_WAIT_L(n) asm volatile("s_waitcnt lgkmcnt(" #n ")" ::: "memory")
#define PG8_BAR __builtin_amdgcn_s_barrier()
#define PG8_SCHED __builtin_amdgcn_sched_barrier(0)
    Unit cur, nxt; int ui = 0;
    if (!S.next(0, cur)) return;
    typename Epi::acc_t acc[2][2][4][2];
#pragma unroll
    for (int a = 0; a < 2; ++a)
#pragma unroll
        for (int b = 0; b < 2; ++b)
#pragma unroll
            for (int m = 0; m < 4; ++m)
#pragma unroll
                for (int n = 0; n < 2; ++n) acc[a][b][m][n] = typename Epi::acc_t{};
    bf16x8 At[4][2], B0[2][2], B1[2][2];
    int gR[2], gC[2];
#pragma unroll
    for (int i = 0; i < 2; ++i) stage_rc(tid * 16 + i * 8192, gR[i], gC[i]);
    unsigned vA0[2], vA1[2], nA0[2], nA1[2];
#pragma unroll
    for (int i = 0; i < 2; ++i) { if constexpr (Epi::GATHER) { vA0[i] = (unsigned)(g.rowtab[cur.ui * 256 + gR[i]] * pitchB + 2 * gC[i]); vA1[i] = (unsigned)(g.rowtab[cur.ui * 256 + 128 + gR[i]] * pitchB + 2 * gC[i]); } else { vA0[i] = voffA[i]; vA1[i] = voffA[i]; } nA0[i] = vA0[i]; nA1[i] = vA1[i]; }
    const char* cA = Epi::GATHER ? (const char*)g.A : (const char*)g.A + (size_t)cur.pm * tstep; const char* cB = (const char*)g.Bt + (size_t)cur.pe * g.estride + (size_t)cur.pn * tstep;
    const char* cA2 = Epi::DUAL ? (const char*)g.A2 + (size_t)cur.pm * tstep : cA; const char* cB2 = Epi::DUAL ? (const char*)g.Bt2 + (size_t)cur.pn * tstep : cB;
    S.a_ready(cur);
    if constexpr (SP2) {
        PG8_STAGE(PG8_SB(0, 0), cB, voffB); PG8_STAGE(PG8_SB(0, 1), cB + hstep, voffB); PG8_STAGE(PG8_SA(0, 0), cA, vA0); PG8_STAGE(PG8_SA(0, 1), cA + hstepA, vA1);
        if (wr == 1) PG8_BAR;
        PG8_WAIT_V(2); PG8_BAR;
        PG8_STAGE(PG8_SB(1, 0), cB + kstep, voffB); PG8_STAGE(PG8_SA(1, 0), cA + kstep, vA0); PG8_STAGE(PG8_SB(1, 1), cB + hstep + kstep, voffB);
        PG8_WAIT_V(6); PG8_BAR;
    } else {
        PG8_STAGE(PG8_SB(0, 0), cB, voffB); PG8_STAGE(PG8_SA(0, 0), cA, vA0); PG8_STAGE(PG8_SB(0, 1), cB + hstep, voffB); PG8_STAGE(PG8_SA(0, 1), cA + hstepA, vA1);
        if (wr == 1) PG8_BAR;
        PG8_WAIT_V(4); PG8_BAR;
        PG8_STAGE(PG8_SB(1, 0), cB + kstep, voffB); PG8_STAGE(PG8_SA(1, 0), cA + kstep, vA0); PG8_STAGE(PG8_SB(1, 1), cB + hstep + kstep, voffB);
        PG8_WAIT_V(6); PG8_BAR;
    }
    for (;;) {
        const bool has_next = S.next(ui + 1, nxt);
        if constexpr (Epi::GATHER) { if (has_next) {
#pragma unroll
            for (int i = 0; i < 2; ++i) { nA0[i] = (unsigned)(g.rowtab[nxt.ui * 256 + gR[i]] * pitchB + 2 * gC[i]); nA1[i] = (unsigned)(g.rowtab[nxt.ui * 256 + 128 + gR[i]] * pitchB + 2 * gC[i]); } } }
        const char* nA = Epi::GATHER ? cA : (has_next ? (const char*)g.A + (size_t)nxt.pm * tstep : cA); const char* nB = has_next ? (const char*)g.Bt + (size_t)nxt.pe * g.estride + (size_t)nxt.pn * tstep : cB;
        for (int t = 0; t < nt; t += 2) {
            const bool last = (t == nt - 2);
            if constexpr (Epi::DUAL) { if (t == nt1) E.mid(acc, cur, wr, wc, fr, fq); }
            const char* a1 = (t < nt1) ? cA + (size_t)(t + 1) * kstep : cA2 + (size_t)(t + 1 - nt1) * kstep;
            const char* a2 = last ? nA : ((t + 2 < nt1) ? cA + (size_t)(t + 2) * kstep : cA2 + (size_t)(t + 2 - nt1) * kstep); const char* b2 = last ? nB : ((t + 2 < nt1) ? cB + (size_t)(t + 2) * kstep : cB2 + (size_t)(t + 2 - nt1) * kstep);
            const char* a3 = a2 + kstep; const char* b3 = b2 + kstep;
            unsigned wA0[2], wA1[2];
#pragma unroll
            for (int i = 0; i < 2; ++i) { wA0[i] = (Epi::GATHER && last) ? nA0[i] : vA0[i]; wA1[i] = (Epi::GATHER && last) ? nA1[i] : vA1[i]; }
            if (last && has_next) S.a_ready(nxt);
            if constexpr (SP2) {
            PG8_LDB(B0, 0, 0); PG8_LDB(B1, 0, 1); PG8_SCHED; PG8_LDA(At, 0, 0); PG8_STAGE(PG8_SA(1, 1), a1 + hstepA, vA1);
            PG8_WAIT_V(8); PG8_WAIT_L(0); PG8_BAR; PG8_MMA(0, 0, At, B0); PG8_MMA(0, 1, At, B1); PG8_BAR; PG8_SCHED;
            PG8_LDA(At, 0, 1); PG8_STAGE(PG8_SB(0, 0), b2, voffB); PG8_STAGE(PG8_SB(0, 1), b2 + hstep, voffB); PG8_STAGE(PG8_SA(0, 0), a2, wA0);
            PG8_WAIT_V(8); PG8_WAIT_L(0); PG8_BAR; PG8_MMA(1, 0, At, B0); PG8_MMA(1, 1, At, B1); PG8_BAR; PG8_SCHED;
            PG8_LDB(B0, 1, 0); PG8_LDB(B1, 1, 1); PG8_SCHED; PG8_LDA(At, 1, 0); PG8_STAGE(PG8_SA(0, 1), a2 + hstepA, wA1);
            PG8_WAIT_V(8); PG8_WAIT_L(0); PG8_BAR; PG8_MMA(0, 0, At, B0); PG8_MMA(0, 1, At, B1); PG8_BAR; PG8_SCHED;
            PG8_LDA(At, 1, 1); PG8_STAGE(PG8_SB(1, 0), b3, voffB); PG8_STAGE(PG8_SB(1, 1), b3 + hstep, voffB); PG8_STAGE(PG8_SA(1, 0), a3, wA0);
            PG8_WAIT_V(8); PG8_WAIT_L(0); PG8_BAR; PG8_MMA(1, 0, At, B0); PG8_MMA(1, 1, At, B1); PG8_BAR; PG8_SCHED;
            } else {
            PG8_LDB(B0, 0, 0); PG8_SCHED; PG8_LDA(At, 0, 0); PG8_STAGE(PG8_SA(1, 1), a1 + hstepA, vA1);
            PG8_WAIT_L(8); PG8_BAR; PG8_WAIT_L(0); PG8_MMA(0, 0, At, B0); PG8_BAR; PG8_SCHED;
            PG8_LDB(B1, 0, 1); PG8_STAGE(PG8_SB(0, 0), b2, voffB);
            PG8_BAR; PG8_WAIT_L(0); PG8_MMA(0, 1, At, B1); PG8_BAR;
            PG8_LDA(At, 0, 1); PG8_STAGE(PG8_SA(0, 0), a2, wA0);
            PG8_BAR; PG8_WAIT_L(0); PG8_MMA(1, 0, At, B0); PG8_BAR; PG8_SCHED;
            PG8_STAGE(PG8_SB(0, 1), b2 + hstep, voffB);
            PG8_WAIT_V(6); PG8_BAR; PG8_MMA(1, 1, At, B1); PG8_BAR;
            PG8_LDB(B0, 1, 0); PG8_SCHED; PG8_LDA(At, 1, 0); PG8_STAGE(PG8_SA(0, 1), a2 + hstepA, wA1);
            PG8_WAIT_L(8); PG8_BAR; PG8_WAIT_L(0); PG8_MMA(0, 0, At, B0); PG8_BAR; PG8_SCHED;
            PG8_LDB(B1, 1, 1); PG8_STAGE(PG8_SB(1, 0), b3, voffB);
            PG8_BAR; PG8_WAIT_L(0); PG8_MMA(0, 1, At, B1); PG8_BAR;
            PG8_LDA(At, 1, 1); PG8_STAGE(PG8_SA(1, 0), a3, wA0);
            PG8_BAR; PG8_WAIT_L(0); PG8_MMA(1, 0, At, B0); PG8_BAR; PG8_SCHED;
            PG8_STAGE(PG8_SB(1, 1), b3 + hstep, voffB);
            PG8_WAIT_V(6); PG8_BAR; PG8_MMA(1, 1, At, B1); PG8_BAR;
            }
        }
        if constexpr (ALIGN_EPI) { if (wr == 0) PG8_BAR; }
        if constexpr (Epi::FP8) asm volatile("s_nop 15\n\ts_nop 15" ::: "memory");
        if constexpr (!Epi::AFTER_DRAIN) { E(acc, cur, wr, wc, fr, fq); S.done(cur); }
        if (!has_next) break;
#pragma unroll
        for (int a = 0; a < 2; ++a)
#pragma unroll
            for (int b = 0; b < 2; ++b)
#pragma unroll
                for (int m = 0; m < 4; ++m)
#pragma unroll
                    for (int n = 0; n < 2; ++n) acc[a][b][m][n] = typename Epi::acc_t{};
        cur = nxt; cA = nA; cB = nB; ++ui;
#pragma unroll
        for (int i = 0; i < 2; ++i) { vA0[i] = nA0[i]; vA1[i] = nA1[i]; }
        if constexpr (Epi::DUAL) { cA2 = (const char*)g.A2 + (size_t)cur.pm * tstep; cB2 = (const char*)g.Bt2 + (size_t)cur.pn * tstep; }
        if constexpr (ALIGN_EPI) { if (wr == 1) PG8_BAR; }
    }
    PG8_WAIT_V(0);
    if constexpr (!ALIGN_EPI) { if (wr == 0) PG8_BAR; }
    PG8_BAR;
    if constexpr (Epi::AFTER_DRAIN) { E.fused(acc, cur, wr, wc, fr, fq, lds, wid, lane); S.done(cur); }
#undef PG8_SA
#undef PG8_SB
#undef PG8_STAGE
#undef PG8_LDA
#undef PG8_LDB
#undef PG8_MMA
#undef PG8_WAIT_V
#undef PG8_WAIT_L
#undef PG8_BAR
#undef PG8_SCHED
}
}

namespace sba {
using bf16x8 = __attribute__((ext_vector_type(8))) short;
using s16x4 = __attribute__((ext_vector_type(4))) short;
using f32x16 = __attribute__((ext_vector_type(16))) float;
typedef unsigned short bf16_t;
constexpr int PITCH = 512, QB = 256, KVBLK = 64, SLOTB = 8192;
constexpr int LDS_FLAGS = 8 * SLOTB, LDS_BYTES = 8 * SLOTB + 64;
constexpr float R_DONE = -40.0f;
typedef __attribute__((address_space(3))) const char* lds_cptr;
typedef short v4i16_t __attribute__((ext_vector_type(4)));
#define SBA_MFMA(a, b, c) __builtin_amdgcn_mfma_f32_32x32x16_bf16(a, b, c, 0, 0, 0)
__device__ __forceinline__ int crow(int r, int hi) { return (r & 3) + 8 * (r >> 2) + 4 * hi; }
__device__ __forceinline__ void glds16(const void* gsrc, unsigned lds_dst) { unsigned keep;
    asm volatile("s_mov_b32 %0, m0\n\ts_mov_b32 m0, %2\n\ts_nop 0\n\tglobal_load_lds_dwordx4 %1, off\n\ts_mov_b32 m0, %0" : "=&s"(keep) : "v"(gsrc), "s"(lds_dst) : "memory"); }
typedef float f32x2_t __attribute__((ext_vector_type(2))); typedef __bf16 bf16x2_t __attribute__((ext_vector_type(2)));
__device__ __forceinline__ unsigned cvtpk(float lo, float hi) { f32x2_t v = {lo, hi}; bf16x2_t b = __builtin_convertvector(v, bf16x2_t); return __builtin_bit_cast(unsigned, b); }
__device__ __forceinline__ s16x4 vtr(lds_cptr p) { return __builtin_bit_cast(s16x4, __builtin_amdgcn_ds_read_tr16_b64_v4i16((__attribute__((address_space(3))) v4i16_t*)p)); }
__device__ __forceinline__ bf16x8 pack8(const f32x16& v, int b0) {
    typedef unsigned u32x4 __attribute__((ext_vector_type(4)));
    u32x4 w; w.x = cvtpk(v[b0], v[b0 + 1]); w.y = cvtpk(v[b0 + 2], v[b0 + 3]); w.z = cvtpk(v[b0 + 4], v[b0 + 5]); w.w = cvtpk(v[b0 + 6], v[b0 + 7]); return __builtin_bit_cast(bf16x8, w); }

__device__ __forceinline__ float vmin(float a, float b) { return __builtin_amdgcn_fmed3f(a, -3.0e38f, b); }
template <bool DIAG> __device__ __forceinline__ void tile(f32x16 (&o)[2], f32x16& R, const bf16x8 (&qr)[4], const bf16x8 (&tri)[2], const bf16x8 ones, lds_cptr kp, lds_cptr vp, int qrel, int hi) {
    f32x16 z0 = {}, z1 = {};
#pragma unroll
    for (int d0 = 0; d0 < 4; ++d0) {
        const bf16x8 k0 = *(const __attribute__((address_space(3))) bf16x8*)(kp + d0 * 2048);
        const bf16x8 k1 = *(const __attribute__((address_space(3))) bf16x8*)(kp + d0 * 2048 + 512);
        z0 = SBA_MFMA(k0, qr[d0], z0); z1 = SBA_MFMA(k1, qr[d0], z1); }
    f32x16 sp;
#pragma unroll
    for (int r = 0; r < 16; ++r) { const float zc = vmin(z1[r], 126.0f); float s = __builtin_amdgcn_logf(1.0f + __builtin_amdgcn_exp2f(zc));
        if (DIAG) { if (!(32 + crow(r, hi) < qrel)) s = 0.f; }
        sp[r] = s; z1[r] = (zc - s) + R[r]; }
    const bf16x8 x1a = pack8(sp, 0), x1b = pack8(sp, 8);
    f32x16 S = SBA_MFMA(ones, x1a, R); S = SBA_MFMA(ones, x1b, S);
    z1 = SBA_MFMA(tri[0], x1a, z1); z1 = SBA_MFMA(tri[1], x1b, z1);
#pragma unroll
    for (int r = 0; r < 16; ++r) { const float zc = vmin(z0[r], 126.0f); float s = __builtin_amdgcn_logf(1.0f + __builtin_amdgcn_exp2f(zc));
        if (DIAG) { if (!(crow(r, hi) < qrel)) s = 0.f; }
        sp[r] = s; z0[r] = (zc - s) + S[r]; }
    const bf16x8 x0a = pack8(sp, 0), x0b = pack8(sp, 8);
    z0 = SBA_MFMA(tri[0], x0a, z0); z0 = SBA_MFMA(tri[1], x0b, z0);
    R = SBA_MFMA(ones, x0a, S); R = SBA_MFMA(ones, x0b, R);
#pragma unroll
    for (int r = 0; r < 16; ++r) { float a0 = __builtin_amdgcn_exp2f(z0[r]), a1 = __builtin_amdgcn_exp2f(z1[r]);
        if (DIAG) { if (!(crow(r, hi) < qrel)) a0 = 0.f; if (!(32 + crow(r, hi) < qrel)) a1 = 0.f; }
        z0[r] = a0; z1[r] = a1; }
    const bf16x8 p0 = pack8(z0, 0), p1 = pack8(z0, 8), p2 = pack8(z1, 0), p3 = pack8(z1, 8);
#pragma unroll
    for (int d0 = 0; d0 < 2; ++d0) {
        s16x4 lo[4], hh[4];
#pragma unroll
        for (int ks = 0; ks < 4; ++ks) { lo[ks] = vtr(vp + d0 * 4096 + ks * 1024); hh[ks] = vtr(vp + d0 * 4096 + ks * 1024 + 512); }
#define SBA_PK(k) (bf16x8){lo[k][0], lo[k][1], lo[k][2], lo[k][3], hh[k][0], hh[k][1], hh[k][2], hh[k][3]}
        o[d0] = SBA_MFMA(p0, SBA_PK(0), o[d0]); o[d0] = SBA_MFMA(p1, SBA_PK(1), o[d0]); o[d0] = SBA_MFMA(p2, SBA_PK(2), o[d0]); o[d0] = SBA_MFMA(p3, SBA_PK(3), o[d0]);
#undef SBA_PK
    }
}

#define SBA_WAIT_BAR() asm volatile("s_waitcnt vmcnt(0) lgkmcnt(0)\n\ts_barrier" ::: "memory")
__device__ __forceinline__ void attn_unit(int b, int h, int qb, const bf16_t* Q, const bf16_t* K, const bf16_t* V, bf16_t* O, char* shm) {
    int tid_ = threadIdx.x; asm volatile("" : "+v"(tid_)); const int tid = tid_, lane = tid & 63, r32 = lane & 31, hi = lane >> 5; const int wid = __builtin_amdgcn_readfirstlane(tid >> 6);
    const int grp = wid >> 2, w4 = wid & 3, rb = grp ? (w4 ^ 2) : w4;
    const long rowbase = (long)b * SEQ; const int q0 = qb * QB + grp * 128;
    const bf16_t* Qw = Q + (rowbase + q0 + rb * 32) * PITCH + h * HDIM;
    const bf16_t* Kh = K + rowbase * PITCH + h * HDIM; const bf16_t* Vh = V + rowbase * PITCH + h * HDIM;
    const unsigned lds0 = (unsigned)(uintptr_t)shm + (unsigned)grp * (4 * SLOTB);
    const bf16_t* ksrc0 = Kh + (long)lane * PITCH + (2 * w4) * 8; const bf16_t* ksrc1 = ksrc0 + 8;
    const int p0 = 2 * w4, p1 = 2 * w4 + 1;
    const bf16_t* vsrc0 = Vh + (long)(16 * (p0 & 3) + (lane >> 2)) * PITCH + (p0 >> 2) * 32 + (lane & 3) * 8;
    const bf16_t* vsrc1 = Vh + (long)(16 * (p1 & 3) + (lane >> 2)) * PITCH + (p1 >> 2) * 32 + (lane & 3) * 8;
    const unsigned kdst = lds0 + p0 * 1024, vdst = lds0 + 2 * SLOTB + p0 * 1024;
#define SBA_DMA(t, slot) do { const long go_ = (long)(t) * KVBLK * PITCH; \
        glds16(ksrc0 + go_, (unsigned)__builtin_amdgcn_readfirstlane(kdst + (slot))); glds16(ksrc1 + go_, (unsigned)__builtin_amdgcn_readfirstlane(kdst + 1024 + (slot))); \
        glds16(vsrc0 + go_, (unsigned)__builtin_amdgcn_readfirstlane(vdst + (slot))); glds16(vsrc1 + go_, (unsigned)__builtin_amdgcn_readfirstlane(vdst + 1024 + (slot))); } while (0)
    const lds_cptr shm3 = (lds_cptr)shm + grp * (4 * SLOTB);
    const lds_cptr kp0 = shm3 + hi * 1024 + r32 * 16;
    const lds_cptr vp0 = shm3 + 2 * SLOTB + ((lane >> 4) & 1) * 32 + (lane & 3) * 8 + (4 * hi + ((lane & 15) >> 2)) * 64;
    volatile __attribute__((address_space(3))) unsigned* flags = (volatile __attribute__((address_space(3))) unsigned*)((lds_cptr)shm + LDS_FLAGS);
    const int jtop = (q0 + 128) / KVBLK - 1, jd = q0 / KVBLK + (rb >> 1), qrel = 32 * (rb & 1) + r32;
    SBA_DMA(jtop, 0);
    bf16x8 qr[4];
#pragma unroll
    for (int d0 = 0; d0 < 4; ++d0) qr[d0] = *reinterpret_cast<const bf16x8*>(&Qw[(long)r32 * PITCH + d0 * 16 + hi * 8]);
    bf16x8 tri[2]; bf16x8 ones;
#pragma unroll
    for (int s = 0; s < 2; ++s)
#pragma unroll
        for (int j = 0; j < 8; ++j) tri[s][j] = ((16 * s + 8 * (j >> 2) + 4 * hi + (j & 3)) > r32) ? (short)0xBF80 : (short)0;
#pragma unroll
    for (int j = 0; j < 8; ++j) ones[j] = (short)0xBF80;
    f32x16 o[2]; o[0] = f32x16{}; o[1] = f32x16{}; f32x16 R = f32x16{};
    bool mydone = false;
    const int nsteps = (qb * QB + QB) / KVBLK;
    for (int it = 0; it < nsteps; ++it) {
        const int j = jtop - it;
        SBA_WAIT_BAR();
        if (it > 0) { const int pf = ((it - 1) & 1) * 8; unsigned all = 1u;
#pragma unroll
            for (int w = 0; w < 8; ++w) all &= flags[pf + w];
            if (__builtin_amdgcn_readfirstlane(all)) break; }
        const int cur = (it & 1) * SLOTB, oth = SLOTB - cur;
        if (j > 0) SBA_DMA(j - 1, oth);
        if (!mydone && j >= 0 && j <= jd) {
            if (j == jd) tile<true>(o, R, qr, tri, ones, kp0 + cur, vp0 + cur, qrel, hi);
            else tile<false>(o, R, qr, tri, ones, kp0 + cur, vp0 + cur, qrel, hi);
            mydone = __all(R[0] < R_DONE) != 0;
        }
        if (lane == 0) flags[(it & 1) * 8 + wid] = (mydone || j <= 0) ? 1u : 0u;
    }
    SBA_WAIT_BAR();
    unsigned char* Ow = (unsigned char*)O + (rowbase + q0 + rb * 32) * ATT_W + h * HDIM;
#pragma unroll
    for (int r = 0; r < 16; ++r) { const int orow = crow(r, hi);
#pragma unroll
        for (int d0 = 0; d0 < 2; ++d0) { const int w = pg8::f8pk(o[d0][r] * 2.0f, 0.f, 0, false); Ow[(long)orow * ATT_W + d0 * 32 + r32] = (unsigned char)(w & 0xff); } }
#undef SBA_DMA
}
#undef SBA_WAIT_BAR
#undef SBA_MFMA
}


constexpr size_t MiB = 1u << 20, KiB = 1u << 10;
constexpr size_t WS_CTL = 0, CTL_ZERO_BYTES = 64 * KiB;
constexpr size_t WS_TAB = 1 * MiB;
constexpr size_t TB_MOD = WS_TAB;
constexpr size_t TB_HIST = WS_TAB + 192 * KiB;
constexpr size_t TB_TILE = WS_TAB + 208 * KiB;
constexpr size_t TB_EIDX = WS_TAB + 256 * KiB;
constexpr size_t TB_GATE = WS_TAB + 512 * KiB;
constexpr size_t TB_SLOT = WS_TAB + 768 * KiB;
constexpr size_t TB_WRS = WS_TAB + 1024 * KiB;
constexpr int WR_PITCH = 1032;
constexpr size_t TB_STAMP = WS_TAB + 1400 * KiB;
constexpr size_t TB_PAR = WS_TAB + 1408 * KiB;
constexpr int PAR_WCONV = 0, PAR_LN1G = PAR_WCONV + DEPTH * 3 * CONV_CH, PAR_LN1B = PAR_LN1G + DEPTH * DM, PAR_LN2G = PAR_LN1B + DEPTH * DM, PAR_LN2B = PAR_LN2G + DEPTH * DM,
              PAR_BR = PAR_LN2B + DEPTH * DM, PAR_WR = PAR_BR + NEXP, PAR_TOTAL = PAR_WR + DM * NEXP;
static_assert(TB_PAR + (size_t)PAR_TOTAL * 4 <= 3 * MiB, "tables");
constexpr size_t WS_W = 3 * MiB;
constexpr size_t W_IN = WS_W, W_IN_L = (size_t)IN_W * DM * 2;
constexpr size_t W_A = W_IN + DEPTH * W_IN_L, W_A_L = (size_t)DM * CONV_CH * 2;
constexpr size_t W_B = W_A + DEPTH * W_A_L, W_B_L = W_A_L;
constexpr size_t W_O = W_B + DEPTH * W_B_L, W_O_L = (size_t)DM * DM * 2;
constexpr size_t W_GU = W_O + DEPTH * W_O_L, W_GU_E = (size_t)2 * FFD * DM * 2;
constexpr size_t W_DN = W_GU + (size_t)DEPTH * NEXP * W_GU_E, W_DN_E = (size_t)DM * FFD * 2;
constexpr size_t W_IN_SC = 6 * MiB;
constexpr size_t W_GU_SC = 1 * MiB + 64 * KiB;
constexpr size_t ACT_SU = 33 * MiB;
constexpr size_t ACT_LIST = 34 * MiB;
constexpr size_t WS_ACT = W_DN + (size_t)DEPTH * NEXP * W_DN_E;
constexpr size_t WS_PROJ = WS_ACT + (size_t)M_TOK * DM * 2;
constexpr size_t PJ_T512 = (size_t)M_TOK * 512 * 2, PJ_GA = 6 * PJ_T512, PJ_GB = PJ_GA + (size_t)M_TOK * DM * 2;
constexpr size_t PJ_XS = 0, PJ_HS = (size_t)PMAX * DM * 2;
constexpr size_t PJ_SXS = 69 * MiB;
constexpr size_t WS_END = WS_PROJ + (size_t)M_TOK * IN_W * 2;
static_assert(WS_ACT == 127 * MiB && WS_END == 511 * MiB, "d_ws map");
static_assert(PJ_HS + (size_t)PMAX * FFD * 2 <= (size_t)M_TOK * IN_W * 2, "MoE overlay fits the proj region");
constexpr int CW_BAR = 4096;
constexpr int CW_MODCNT = 1536;
constexpr int CW_GCNT = 1024;

constexpr int RING_OFF = 0, RING_BYTES = 131072;
constexpr int LDSCTL_OFF = RING_BYTES, MISC_OFF = LDSCTL_OFF + 320;
constexpr int GTAB_OFF = RING_BYTES + 1024;
constexpr int LDS_BYTES = 149504;
static_assert(MISC_OFF + 128 <= GTAB_OFF && GTAB_OFF + 8 * 2048 <= LDS_BYTES, "LDS map");

#define GAS __attribute__((address_space(1)))
#define LAS __attribute__((address_space(3)))
typedef unsigned short bf16;
typedef unsigned v4u __attribute__((ext_vector_type(4)));
typedef unsigned v2u __attribute__((ext_vector_type(2)));
typedef float f32x4 __attribute__((ext_vector_type(4)));
typedef GAS unsigned gu32;
#define RLX_AGENT __ATOMIC_RELAXED, __HIP_MEMORY_SCOPE_AGENT
#define LDS_WAIT() asm volatile("s_waitcnt lgkmcnt(0)" ::: "memory")
#define VM_WAIT() asm volatile("s_waitcnt vmcnt(0)" ::: "memory")
__device__ __forceinline__ unsigned f2bf(float f) { unsigned u = __builtin_bit_cast(unsigned, f); return (u + 0x7fffu + ((u >> 16) & 1u)) >> 16; }
typedef float f32x2_r __attribute__((ext_vector_type(2))); typedef __bf16 bf16x2_r __attribute__((ext_vector_type(2)));
__device__ __forceinline__ unsigned pk2(float lo, float hi) { f32x2_r v = {lo, hi}; return __builtin_bit_cast(unsigned, __builtin_convertvector(v, bf16x2_r)); }
__device__ __forceinline__ float bflo(unsigned w) { return __uint_as_float(w << 16); }
__device__ __forceinline__ float bfhi(unsigned w) { return __uint_as_float(w & 0xffff0000u); }


#define XB_TMO      128
#define XB_XCNT(j)  (256  + 64 * (j))
#define XB_XSUB(j)  (1280 + 64 * (j))
#define XB_XGEN(j)  (2304 + 64 * (j))
#define XB_TOP      3328
#define XB_TOPGEN   3392
#define XCD_BAR_WORDS 3456
#define XB_SPIN_CAP (1u << 18)

__device__ __forceinline__ unsigned xb_ld(unsigned* p)              { return __hip_atomic_load(p, __ATOMIC_RELAXED, __HIP_MEMORY_SCOPE_AGENT); }
__device__ __forceinline__ unsigned xb_add(unsigned* p, unsigned v) { return __hip_atomic_fetch_add(p, v, __ATOMIC_RELAXED, __HIP_MEMORY_SCOPE_AGENT); }
__device__ __forceinline__ unsigned xb_xcc_id() { return (unsigned)__builtin_amdgcn_s_getreg((3 << 11) | 20) & 0xFu; }
#define XB_SPIN(cond, bar) do { unsigned _sp = 0; while (cond) { __builtin_amdgcn_s_sleep(1); \
    if ((++_sp & 255u) == 0u) { if (xb_ld(&(bar)[XB_TMO])) break; if (_sp > XB_SPIN_CAP) { atomicAdd(&(bar)[XB_TMO], 1u); break; } } } } while (0)

struct XcdBarrier {
    unsigned* bar; unsigned x;
    volatile LAS unsigned* st;
};

__device__ __forceinline__ XcdBarrier xcd_barrier_post(unsigned* bar, volatile LAS unsigned* st) {
    XcdBarrier b; b.bar = bar; b.x = xb_xcc_id(); b.st = st;
    if (threadIdx.x == 0) (void)xb_add(&bar[XB_XCNT(b.x)], 1u);
    return b;
}
__device__ __forceinline__ void xcd_barrier_complete(unsigned* bar, unsigned x, unsigned& nloc, unsigned& nx) {
    const unsigned G = gridDim.x * gridDim.y * gridDim.z;
    unsigned sum, cnt, mine, sp = 0u;
    for (;;) {
        sum = 0u; cnt = 0u; mine = 0u;
#pragma unroll
        for (unsigned j = 0; j < 16; ++j) { const unsigned c = xb_ld(&bar[XB_XCNT(j)]); sum += c; cnt += (c > 0u) ? 1u : 0u; mine = (j == x) ? c : mine; }
        if (sum == G) break;
        __builtin_amdgcn_s_sleep(1);
        if ((++sp & 255u) == 0u) { if (xb_ld(&bar[XB_TMO])) break; if (sp > XB_SPIN_CAP) { atomicAdd(&bar[XB_TMO], 1u); break; } }
    }
    nloc = mine > 0u ? mine : 1u; nx = cnt > 0u ? cnt : 1u;
}

__device__ __forceinline__ void xcd_barrier(const XcdBarrier& b) {
    asm volatile("s_waitcnt vmcnt(0)" ::: "memory");
    __syncthreads();
    if (threadIdx.x == 0) {
        unsigned* bar = b.bar;
        __builtin_amdgcn_s_waitcnt(0);
        unsigned nloc = b.st[0], nx = b.st[1];
        if (nloc == 0u) { xcd_barrier_complete(bar, b.x, nloc, nx); b.st[0] = nloc; b.st[1] = nx; }
        const unsigned old = xb_add(&bar[XB_XSUB(b.x)], 1u);
        const unsigned gen = old / nloc;
        if (old + 1u == (gen + 1u) * nloc) {
            __builtin_amdgcn_fence(__ATOMIC_RELEASE, "agent");
            asm volatile("s_waitcnt vmcnt(0)" ::: "memory");
            const unsigned og = xb_add(&bar[XB_TOP], 1u);
            const unsigned tg = og / nx;
            if (og + 1u == (tg + 1u) * nx) xb_add(&bar[XB_TOPGEN], 1u);
            else XB_SPIN(xb_ld(&bar[XB_TOPGEN]) == tg, bar);
            __builtin_amdgcn_fence(__ATOMIC_ACQUIRE, "agent");
            xb_add(&bar[XB_XGEN(b.x)], 1u);
            asm volatile("s_waitcnt vmcnt(0)" ::: "memory");
        } else {
            XB_SPIN(xb_ld(&bar[XB_XGEN(b.x)]) == gen, bar);
            __builtin_amdgcn_fence(__ATOMIC_ACQUIRE, "agent");
            asm volatile("s_waitcnt vmcnt(0)" ::: "memory");
        }
    }
    __syncthreads();
}

#ifndef MK_PROBE
#define MK_PROBE 0
#endif
#ifndef MK_STAGGER
#define MK_STAGGER 0
#endif
#ifndef MK_DRY
#define MK_DRY 0
#endif
#ifndef MK_WGM_IN
#define MK_WGM_IN 2
#define MK_WGM_SQ 2
#endif
#ifndef MK_XBAR
#define MK_XBAR 0
#endif
#ifndef MK_REP_MASK
#define MK_REP_MASK 0
#define MK_REP_N 0
#endif
#ifndef MK_PA
#define MK_PA 0
#define MK_PB 0
#define MK_TMAX 1000
#endif

struct Frame {
    LAS unsigned char* lds;
    volatile LAS unsigned* MISC;
    gu32* ctl;
    unsigned char* ws;
    const float* x; float* out;
    int tid, lane, wave;
    int vcu, G;
};
struct Args { const float* in[18]; float* out; unsigned char* ws; int ph_lo, ph_hi; };

__device__ __forceinline__ float wave_sum(float v) {
    v += __builtin_bit_cast(float, __builtin_amdgcn_mov_dpp(__builtin_bit_cast(int, v), 0xB1, 0xf, 0xf, true));
    v += __builtin_bit_cast(float, __builtin_amdgcn_mov_dpp(__builtin_bit_cast(int, v), 0x4E, 0xf, 0xf, true));
    v += __builtin_bit_cast(float, __builtin_amdgcn_mov_dpp(__builtin_bit_cast(int, v), 0x141, 0xf, 0xf, true));
    v += __builtin_bit_cast(float, __builtin_amdgcn_mov_dpp(__builtin_bit_cast(int, v), 0x140, 0xf, 0xf, true));
    { auto r = __builtin_amdgcn_permlane16_swap(__float_as_uint(v), __float_as_uint(v), false, false); v = __uint_as_float(r[0]) + __uint_as_float(r[1]); }
    { auto r = __builtin_amdgcn_permlane32_swap(__float_as_uint(v), __float_as_uint(v), false, false); v = __uint_as_float(r[0]) + __uint_as_float(r[1]); }
    return v;
}

__device__ __forceinline__ float wave_max(float v) {
    v = fmaxf(v, __builtin_bit_cast(float, __builtin_amdgcn_mov_dpp(__builtin_bit_cast(int, v), 0xB1, 0xf, 0xf, true)));
    v = fmaxf(v, __builtin_bit_cast(float, __builtin_amdgcn_mov_dpp(__builtin_bit_cast(int, v), 0x4E, 0xf, 0xf, true)));
    v = fmaxf(v, __builtin_bit_cast(float, __builtin_amdgcn_mov_dpp(__builtin_bit_cast(int, v), 0x141, 0xf, 0xf, true)));
    v = fmaxf(v, __builtin_bit_cast(float, __builtin_amdgcn_mov_dpp(__builtin_bit_cast(int, v), 0x140, 0xf, 0xf, true)));
    { auto r = __builtin_amdgcn_permlane16_swap(__float_as_uint(v), __float_as_uint(v), false, false); v = fmaxf(__uint_as_float(r[0]), __uint_as_float(r[1])); }
    { auto r = __builtin_amdgcn_permlane32_swap(__float_as_uint(v), __float_as_uint(v), false, false); v = fmaxf(__uint_as_float(r[0]), __uint_as_float(r[1])); }
    return v;
}
__device__ __forceinline__ unsigned q4i8(float a, float b, float c, float d, float inv) {
    const unsigned y0 = __float_as_uint(__builtin_fmaf(a, inv, 12582912.0f)), y1 = __float_as_uint(__builtin_fmaf(b, inv, 12582912.0f)), y2 = __float_as_uint(__builtin_fmaf(c, inv, 12582912.0f)), y3 = __float_as_uint(__builtin_fmaf(d, inv, 12582912.0f));
    return __builtin_amdgcn_perm(__builtin_amdgcn_perm(y3, y2, 0x0c0c0400u), __builtin_amdgcn_perm(y1, y0, 0x0c0c0400u), 0x05040100u);
}
__device__ __forceinline__ unsigned pk4i8(float a, float b, float c, float d) { return ((unsigned)(int)a & 0xffu) | (((unsigned)(int)b & 0xffu) << 8) | (((unsigned)(int)c & 0xffu) << 16) | ((unsigned)(int)d << 24); }
__device__ __forceinline__ void store_row_i8(const f32x4 (&v)[4], signed char* row, float* scale, int lane) {
    float mx = 0.f;
#pragma unroll
    for (int j = 0; j < 4; ++j) mx = fmaxf(fmaxf(mx, fmaxf(fabsf(v[j][0]), fabsf(v[j][1]))), fmaxf(fabsf(v[j][2]), fabsf(v[j][3])));
    mx = wave_max(mx); const float inv = mx > 0.f ? 127.f / mx : 0.f;
#pragma unroll
    for (int j = 0; j < 4; ++j) *(unsigned*)(row + j * 256 + lane * 4) = q4i8(v[j][0], v[j][1], v[j][2], v[j][3], inv);
    if (lane == 0) *scale = mx * (1.f / 127.f);
}

__device__ __forceinline__ void p0_transpose_item(const float* W, int K, int N, bf16* WT, int row_off, int row_mul, float scale, int sc_n0, int sc_n1, LAS float* scr, int item, int lane) {
    const int nblk = N / 32, kb = item / nblk, nb = item % nblk, k0 = 64 * kb, n0 = 32 * nb;
#pragma unroll 32
    for (int i = 0; i < 32; ++i) { const int kk = 2 * i + (lane >> 5); scr[kk * 33 + (lane & 31)] = W[(size_t)(k0 + kk) * N + n0 + (lane & 31)]; }
    LDS_WAIT(); asm volatile("" ::: "memory");
    const float sc = (n0 >= sc_n0 && n0 < sc_n1) ? scale : 1.0f;
    const int c = lane & 7;
#pragma unroll
    for (int j = 0; j < 4; ++j) { const int n = (lane >> 3) + 8 * j; const LAS float* s = scr + (8 * c) * 33 + n;
        v4u o; o.x = pk2(s[0 * 33] * sc, s[1 * 33] * sc); o.y = pk2(s[2 * 33] * sc, s[3 * 33] * sc); o.z = pk2(s[4 * 33] * sc, s[5 * 33] * sc); o.w = pk2(s[6 * 33] * sc, s[7 * 33] * sc);
        *(GAS v4u*)(WT + (size_t)(row_off + (n0 + n) * row_mul) * K + k0 + 8 * c) = o; }
    LDS_WAIT(); asm volatile("" ::: "memory");
}
__device__ __forceinline__ void p0_quant_item(const float* W, int K, int N, int n0, signed char* WT, int row_off, int row_mul, float* scales, float qsc, int sc_n0, int sc_n1, LAS float* scr, int lane) {
    const int nl = lane & 31, kh = lane >> 5; const float* wp = W + n0 + nl; float mx = 0.f;
#pragma unroll 1
    for (int kb = 0; kb < K / 64; ++kb) { const float* wk = wp + (size_t)(kb * 64 + kh) * N;
#pragma unroll 32
        for (int i = 0; i < 32; ++i) mx = fmaxf(mx, fabsf(wk[(size_t)(2 * i) * N])); }
    mx = fmaxf(mx, __shfl_xor(mx, 32));
    const float inv = mx > 0.f ? 127.f / mx : 0.f;
    if (lane < 32) scales[row_off + (n0 + nl) * row_mul] = mx * (1.f / 127.f) * ((n0 >= sc_n0 && n0 < sc_n1) ? qsc : 1.f);
    const int c = lane & 7;
#pragma unroll 1
    for (int kb = 0; kb < K / 64; ++kb) { const float* wk = wp + (size_t)(kb * 64 + kh) * N;
#pragma unroll 32
        for (int i = 0; i < 32; ++i) { scr[(2 * i + kh) * 33 + nl] = rintf(wk[(size_t)(2 * i) * N] * inv); }
        LDS_WAIT(); asm volatile("" ::: "memory");
#pragma unroll
        for (int j = 0; j < 4; ++j) { const int n = (lane >> 3) + 8 * j; const LAS float* s = scr + (8 * c) * 33 + n;
            v2u o; o.x = pk4i8(s[0 * 33], s[1 * 33], s[2 * 33], s[3 * 33]); o.y = pk4i8(s[4 * 33], s[5 * 33], s[6 * 33], s[7 * 33]);
            *(GAS v2u*)(WT + (size_t)(row_off + (n0 + n) * row_mul) * K + kb * 64 + 8 * c) = o; }
        LDS_WAIT(); asm volatile("" ::: "memory");
    }
}
__device__ __forceinline__ void p0_transpose_item_f8(const float* W, int K, int N, unsigned char* WT, float scale, LAS float* scr, int item, int lane) {
    const int nblk = N / 32, kb = item / nblk, nb = item % nblk, k0 = 64 * kb, n0 = 32 * nb;
#pragma unroll 32
    for (int i = 0; i < 32; ++i) { const int kk = 2 * i + (lane >> 5); scr[kk * 33 + (lane & 31)] = W[(size_t)(k0 + kk) * N + n0 + (lane & 31)]; }
    LDS_WAIT(); asm volatile("" ::: "memory");
    const int c = lane & 7;
#pragma unroll
    for (int j = 0; j < 4; ++j) { const int n = (lane >> 3) + 8 * j; const LAS float* s = scr + (8 * c) * 33 + n;
        int w0 = pg8::f8pk(s[0 * 33] * scale, s[1 * 33] * scale, 0, false); w0 = pg8::f8pk(s[2 * 33] * scale, s[3 * 33] * scale, w0, true);
        int w1 = pg8::f8pk(s[4 * 33] * scale, s[5 * 33] * scale, 0, false); w1 = pg8::f8pk(s[6 * 33] * scale, s[7 * 33] * scale, w1, true);
        v2u o; o.x = (unsigned)w0; o.y = (unsigned)w1; *(GAS v2u*)(WT + (size_t)(n0 + n) * K + k0 + 8 * c) = o; }
    LDS_WAIT(); asm volatile("" ::: "memory");
}
__device__ __forceinline__ void p0a_prologue(Frame& F, const Args& a) {
    const float* c = a.in[1]; const float* w_ada = a.in[2]; const float* b_ada = a.in[3];
    if (F.vcu < 192) {
        LAS float* sl = (LAS float*)(F.lds);
        LAS float* red = (LAS float*)(F.lds + 16384);
        for (int i = F.tid; i < BATCH * DM; i += NTHREADS) { const float cv = c[i]; sl[i] = cv / (1.f + __expf(-cv)); }
        __syncthreads();
        const int l = F.vcu / 96, cb = F.vcu % 96, col = cb * 64 + F.lane;
        const float* w = w_ada + (size_t)l * DM * 6 * DM + col;
        float acc[BATCH] = {0.f, 0.f, 0.f, 0.f};
        const int kbeg = F.wave * 128;
#pragma unroll 32
        for (int k = kbeg; k < kbeg + 128; ++k) { const float wv = w[(size_t)k * 6 * DM];
#pragma unroll
            for (int b = 0; b < BATCH; ++b) acc[b] += sl[b * DM + k] * wv; }
#pragma unroll
        for (int b = 0; b < BATCH; ++b) red[(F.wave * BATCH + b) * 64 + F.lane] = acc[b];
        __syncthreads();
        if (F.wave < BATCH) { float s = 0.f;
#pragma unroll
            for (int w8 = 0; w8 < 8; ++w8) s += red[(w8 * BATCH + F.wave) * 64 + F.lane];
            float* mod = (float*)(F.ws + TB_MOD);
            __hip_atomic_store(&mod[((size_t)l * BATCH + F.wave) * 6 * DM + col], s + b_ada[l * 6 * DM + col], __ATOMIC_RELAXED, __HIP_MEMORY_SCOPE_AGENT);
            asm volatile("s_waitcnt vmcnt(0)" ::: "memory"); }
        __syncthreads();
        if (F.tid == 0) (void)__hip_atomic_fetch_add((unsigned*)(F.ctl + CW_MODCNT), 1u, __ATOMIC_RELAXED, __HIP_MEMORY_SCOPE_AGENT);
    }
    { const int gt = F.vcu * NTHREADS + F.tid, NGT = F.G * NTHREADS; float* par = (float*)(F.ws + TB_PAR);
      for (int i = gt; i < PAR_TOTAL; i += NGT) { float v;
          if (i < PAR_LN1G) v = a.in[5][i - PAR_WCONV];
          else if (i < PAR_LN1B) v = a.in[9][i - PAR_LN1G];
          else if (i < PAR_LN2G) v = a.in[10][i - PAR_LN1B];
          else if (i < PAR_LN2B) v = a.in[16][i - PAR_LN2G];
          else if (i < PAR_BR) v = a.in[17][i - PAR_LN2B];
          else if (i < PAR_WR) v = a.in[12][i - PAR_BR];
          else v = a.in[11][i - PAR_WR];
          par[i] = v; } }
    { const int gt = F.vcu * NTHREADS + F.tid, NGT = F.G * NTHREADS; unsigned short* wimg = (unsigned short*)(F.ws + TB_WRS);
      for (int idx = gt; idx < DM * NEXP; idx += NGT) { const int col = idx >> 4, e = idx & 15; const float v = a.in[11][idx]; const unsigned h = f2bf(v); const float hv = __uint_as_float(h << 16);
          wimg[e * WR_PITCH + col] = (unsigned short)h; wimg[(NEXP + e) * WR_PITCH + col] = (unsigned short)f2bf(v - hv); } }
    LAS float* scr = (LAS float*)(F.lds + RING_OFF + F.wave * 16384);
    const int gw = F.vcu * NWAVES + F.wave, NGW = F.G * NWAVES;
    constexpr int I_AB = (CONV_CH / 64) * (DM / 32), I_O = (DM / 64) * (DM / 32), I_G = (DM / 64) * (FFD / 32), I_D = (FFD / 64) * (DM / 32);
    constexpr int PER_L = 2 * I_AB + I_O + NEXP * I_D, NITEMS = DEPTH * PER_L;
    constexpr int H_IN = IN_W / 32, H_GU = NEXP * 2 * (FFD / 32), H_L = H_IN + H_GU, NHEAVY = DEPTH * H_L;
    const bool hv = (gw % 3) != 2; const int hrank = gw - gw / 3 - (hv ? 0 : 1), nhv = NGW - NGW / 3;
    const int nidle = nhv > NHEAVY ? nhv - NHEAVY : 0, nlt = NGW / 3 + nidle;
    const int lrank = hv ? (hrank >= NHEAVY ? NGW / 3 + hrank - NHEAVY : -1) : gw / 3;
    if (hv) for (int it = hrank; it < NHEAVY; it += nhv) { const int l = it / H_L; int r = it % H_L;
        if (r < H_IN) { const int n0 = r * 32; const bool isc = n0 >= CONV_CH && n0 < 2 * CONV_CH, isx = n0 >= 2 * CONV_CH && n0 < 3 * CONV_CH;
            p0_quant_item(a.in[4] + (size_t)l * DM * IN_W, DM, IN_W, n0, (signed char*)(F.ws + W_IN + l * W_IN_L), isc ? -CONV_CH : isx ? 1 - 3 * CONV_CH : 0, (isc || isx) ? 2 : 1, (float*)(F.ws + W_IN + l * W_IN_L + W_IN_SC), QSCALE, 3 * CONV_CH, 3 * CONV_CH + ATT_W, scr, F.lane); continue; }
        r -= H_IN; const int e = r / (2 * (FFD / 32)), wh = (r / (FFD / 32)) & 1, nb = r % (FFD / 32); const size_t le = (size_t)l * NEXP + e;
        p0_quant_item(a.in[13 + wh] + le * DM * FFD, DM, FFD, nb * 32, (signed char*)(F.ws + W_GU + le * W_GU_E), wh, 2, (float*)(F.ws + W_GU + le * W_GU_E + W_GU_SC), 1.f, 0, 0, scr, F.lane); }
    for (int it = lrank < 0 ? NITEMS : lrank; it < NITEMS; it += nlt) {
        const int l = it / PER_L; int r = it % PER_L;
        if (r < I_AB) { p0_transpose_item_f8(a.in[6] + (size_t)l * CONV_CH * DM, CONV_CH, DM, (unsigned char*)(F.ws + W_A + l * W_A_L), 64.0f, scr, r, F.lane); continue; } r -= I_AB;
        if (r < I_AB) { p0_transpose_item_f8(a.in[7] + (size_t)l * ATT_W * DM, ATT_W, DM, (unsigned char*)(F.ws + W_B + l * W_B_L), 64.0f, scr, r, F.lane); continue; } r -= I_AB;
        if (r < I_O) { p0_transpose_item_f8(a.in[8] + (size_t)l * DM * DM, DM, DM, (unsigned char*)(F.ws + W_O + l * W_O_L), 64.0f, scr, r, F.lane); continue; } r -= I_O;
        const int e = r / I_D; r %= I_D; const size_t le = (size_t)l * NEXP + e;
        p0_transpose_item_f8(a.in[15] + le * FFD * DM, FFD, DM, (unsigned char*)(F.ws + W_DN + le * W_DN_E), 64.0f, scr, r, F.lane);
    }
}
__device__ __forceinline__ void p0b_u0(Frame& F) {
    const float* x = F.x; const float* mod = (const float*)(F.ws + TB_MOD); signed char* U = (signed char*)(F.ws + WS_ACT); float* sU = (float*)(F.ws + WS_ACT + ACT_SU);
    const int gw = F.vcu * NWAVES + F.wave, NGW = F.G * NWAVES;
    {
        if (F.tid == 0) { unsigned* w = (unsigned*)(F.ctl + CW_MODCNT); unsigned* tmo = (unsigned*)(F.ctl + CW_BAR + XB_TMO); const unsigned want = F.G < 192 ? (unsigned)F.G : 192u; unsigned sp = 0u;
            while (__hip_atomic_load(w, __ATOMIC_RELAXED, __HIP_MEMORY_SCOPE_AGENT) < want) { __builtin_amdgcn_s_sleep(1);
                if ((++sp & 255u) == 0u) { if (__hip_atomic_load(tmo, __ATOMIC_RELAXED, __HIP_MEMORY_SCOPE_AGENT)) break; if (sp > (1u << 18)) { atomicAdd(tmo, 1u); break; } } } }
        if (F.wave == 0) { __builtin_amdgcn_fence(__ATOMIC_ACQUIRE, "agent"); asm volatile("s_waitcnt vmcnt(0)" ::: "memory"); }
        __syncthreads(); }
    for (int m = gw; m < M_TOK; m += NGW) { const int b = m / SEQ; const float* mb = mod + (size_t)b * 6 * DM; f32x4 u[4];
#pragma unroll
        for (int j = 0; j < 4; ++j) { const int col = j * 256 + F.lane * 4; const f32x4 v = *(const f32x4*)(x + (size_t)m * DM + col), sh = *(const f32x4*)(mb + col), sc = *(const f32x4*)(mb + DM + col);
            u[j] = v * (sc + 1.0f) + sh; }
        store_row_i8(u, U + (size_t)m * DM, sU + m, F.lane); }
}
__device__ __forceinline__ void p2_conv(Frame& F, int l, bf16* ao) {
    bf16* cb = (bf16*)(F.ws + WS_PROJ); const bf16* pp = cb + (size_t)M_TOK * 512;
    const float* wc = (const float*)(F.ws + TB_PAR) + PAR_WCONV + (size_t)l * 3 * CONV_CH;
    const int gw = F.vcu * NWAVES + F.wave, NGW = F.G * NWAVES; const int ch = F.lane * 8;
    float w0[8], w1[8], w2[8];
#pragma unroll
    for (int i = 0; i < 8; ++i) { w0[i] = wc[ch + i]; w1[i] = wc[CONV_CH + ch + i]; w2[i] = wc[2 * CONV_CH + ch + i]; }
    for (int chunk = gw; chunk < M_TOK / 16; chunk += NGW) {
        const int row0 = chunk * 16; const int t0 = row0 % SEQ;
        float pm2[8], pm1[8];
#pragma unroll
        for (int i = 0; i < 8; ++i) { pm2[i] = 0.f; pm1[i] = 0.f; }
        if (t0 >= 2) {
            const v4u q2 = *(const v4u*)(pp + (size_t)(row0 - 2) * 512 + ch), q1 = *(const v4u*)(pp + (size_t)(row0 - 1) * 512 + ch);
#pragma unroll
            for (int i = 0; i < 4; ++i) { pm2[2 * i] = bflo(q2[i]); pm2[2 * i + 1] = bfhi(q2[i]); pm1[2 * i] = bflo(q1[i]); pm1[2 * i + 1] = bfhi(q1[i]); }
        }
        for (int r = 0; r < 16; ++r) { const size_t off = (size_t)(row0 + r) * 512 + ch;
            const v4u q0 = *(const v4u*)(pp + off), bb = *(const v4u*)(cb + off);
            float p0[8], o[8];
#pragma unroll
            for (int i = 0; i < 4; ++i) { p0[2 * i] = bflo(q0[i]); p0[2 * i + 1] = bfhi(q0[i]); }
#pragma unroll
            for (int i = 0; i < 8; ++i) o[i] = w2[i] * p0[i] + w1[i] * pm1[i] + w0[i] * pm2[i];
            int q0w = pg8::f8pk(bflo(bb[0]) * o[0] * 2.0f, bfhi(bb[0]) * o[1] * 2.0f, 0, false); q0w = pg8::f8pk(bflo(bb[1]) * o[2] * 2.0f, bfhi(bb[1]) * o[3] * 2.0f, q0w, true);
            int q1w = pg8::f8pk(bflo(bb[2]) * o[4] * 2.0f, bfhi(bb[2]) * o[5] * 2.0f, 0, false); q1w = pg8::f8pk(bflo(bb[3]) * o[6] * 2.0f, bfhi(bb[3]) * o[7] * 2.0f, q1w, true);
            v2u ov; ov.x = (unsigned)q0w; ov.y = (unsigned)q1w; *(v2u*)((unsigned char*)ao + off) = ov;
#pragma unroll
            for (int i = 0; i < 8; ++i) { pm2[i] = pm1[i]; pm1[i] = p0[i]; } }
    }
}
__device__ __forceinline__ void p2_attn(Frame& F, unsigned char* lds_generic) {
    const sba::bf16_t* Q = (const sba::bf16_t*)(F.ws + WS_PROJ + 3 * PJ_T512); const sba::bf16_t* K = (const sba::bf16_t*)(F.ws + WS_PROJ + 4 * PJ_T512); const sba::bf16_t* V = (const sba::bf16_t*)(F.ws + WS_PROJ + 5 * PJ_T512);
    sba::bf16_t* O = (sba::bf16_t*)(F.ws + WS_ACT);
    constexpr int NQB = SEQ / 256, NUNITS = BATCH * NHEAD * NQB;
    if (F.G == 256) {
        const int bh = F.vcu >> 3, s = F.vcu & 7;
        for (int i = 0; i < 4; ++i) { const int qb = (i == 0) ? s : (i == 1) ? 15 - s : (i == 2) ? 16 + s : 31 - s; sba::attn_unit(bh / NHEAD, bh % NHEAD, qb, Q, K, V, O, (char*)lds_generic); }
    } else {
        for (int u = F.vcu; u < NUNITS; u += F.G) { const int bh = u / NQB, qb = u % NQB; sba::attn_unit(bh / NHEAD, bh % NHEAD, qb, Q, K, V, O, (char*)lds_generic); }
    }
}
__device__ __forceinline__ float quad_sum(float v) {
    { auto r = __builtin_amdgcn_permlane16_swap(__float_as_uint(v), __float_as_uint(v), false, false); v = __uint_as_float(r[0]) + __uint_as_float(r[1]); }
    { auto r = __builtin_amdgcn_permlane32_swap(__float_as_uint(v), __float_as_uint(v), false, false); v = __uint_as_float(r[0]) + __uint_as_float(r[1]); }
    return v;
}
__device__ __forceinline__ float quad_max(float v) {
    { auto r = __builtin_amdgcn_permlane16_swap(__float_as_uint(v), __float_as_uint(v), false, false); v = fmaxf(__uint_as_float(r[0]), __uint_as_float(r[1])); }
    { auto r = __builtin_amdgcn_permlane32_swap(__float_as_uint(v), __float_as_uint(v), false, false); v = fmaxf(__uint_as_float(r[0]), __uint_as_float(r[1])); }
    return v;
}
__device__ __forceinline__ void p5_ln1(Frame& F, int l, const bf16* X, bf16* Xo, bool dry) {
    const float* mod = (const float*)(F.ws + TB_MOD) + (size_t)l * BATCH * 6 * DM; const float* par = (const float*)(F.ws + TB_PAR);
    const float* g = par + PAR_LN1G + l * DM; const float* bta = par + PAR_LN1B + l * DM; const float* w_router = par + PAR_WR; const float* b_router = par + PAR_BR;
    int* epos = (int*)(F.ws + TB_EIDX); float* gate = (float*)(F.ws + TB_GATE); int* gcnt = (int*)(F.ctl + CW_GCNT + 64 * l);
    signed char* U2 = (signed char*)(F.ws + WS_ACT); float* sU2 = (float*)(F.ws + WS_ACT + ACT_SU); int* list_e = (int*)(F.ws + WS_ACT + ACT_LIST);
    constexpr int WPITCH = WR_PITCH;
    LAS unsigned short* wth = (LAS unsigned short*)(F.lds);
    LAS unsigned short* wtl = wth + 16 * WPITCH;
    LAS float* pg = (LAS float*)(F.lds + 4 * 16 * WPITCH);
    LAS float* lgs = pg + 4 * DM;
    LAS int* hist = (LAS int*)(lgs + NWAVES * 256); LAS int* hbase = hist + 16; LAS int* te = hbase + 16; LAS int* tp = te + 256;
    const int blk = blockIdx.x; const int b = (blk * 128) / SEQ; const float* mb = mod + (size_t)b * 6 * DM;
    const int t = F.lane & 15, kq = F.lane >> 4; const int row = blk * 128 + F.wave * 16 + t;
    const bf16* xr = X + (size_t)row * DM + 8 * kq; (void)Xo; (void)w_router;
    constexpr int NIMG = 2 * NEXP * WPITCH * 2 / 16;
    const v4u* wsrc = (const v4u*)(F.ws + TB_WRS);
    v4u wimg[9]; float pv[2][4];
#pragma unroll
    for (int q = 0; q < 9; ++q) { const int i = F.tid + q * NTHREADS; wimg[q] = (q < 8 || i < NIMG) ? wsrc[(q < 8 || i < NIMG) ? i : 0] : (v4u){0u, 0u, 0u, 0u}; }
#pragma unroll
    for (int q = 0; q < 2; ++q) { const int idx = F.tid + q * NTHREADS; pv[q][0] = g[idx]; pv[q][1] = bta[idx]; pv[q][2] = mb[4 * DM + idx]; pv[q][3] = mb[3 * DM + idx]; }
    asm volatile("" ::: "memory");
    v4u raw[32];
#pragma unroll
    for (int s = 0; s < 32; ++s) raw[s] = *(const v4u*)(xr + 32 * s);
    asm volatile("" ::: "memory");
#pragma unroll
    for (int q = 0; q < 9; ++q) { const int i = F.tid + q * NTHREADS; if (q < 8 || i < NIMG) ((LAS v4u*)F.lds)[i] = wimg[q]; }
#pragma unroll
    for (int q = 0; q < 2; ++q) { const int idx = F.tid + q * NTHREADS; pg[idx] = pv[q][0]; pg[DM + idx] = pv[q][1]; pg[2 * DM + idx] = pv[q][2] + 1.0f; pg[3 * DM + idx] = pv[q][3]; }
    if (F.tid < NEXP) hist[F.tid] = 0;
    __syncthreads();
    float sum = 0.f, sq = 0.f;
#pragma unroll
    for (int s = 0; s < 32; ++s) { const float e0 = bflo(raw[s].x), e1 = bfhi(raw[s].x), e2 = bflo(raw[s].y), e3 = bfhi(raw[s].y), e4 = bflo(raw[s].z), e5 = bfhi(raw[s].z), e6 = bflo(raw[s].w), e7 = bfhi(raw[s].w);
        sum += ((e0 + e1) + (e2 + e3)) + ((e4 + e5) + (e6 + e7)); sq += ((e0 * e0 + e1 * e1) + (e2 * e2 + e3 * e3)) + ((e4 * e4 + e5 * e5) + (e6 * e6 + e7 * e7)); }
    const float mean = quad_sum(sum) * (1.f / DM); const float var = fmaxf(quad_sum(sq) * (1.f / DM) - mean * mean, 0.f);
    const float rstd = 1.f / sqrtf(var + LN_EPS);
    typedef short bf16x8_t __attribute__((ext_vector_type(8)));
    f32x4 acc = {0.f, 0.f, 0.f, 0.f}; float amax = 0.f;
    const LAS unsigned short* wph = wth + t * WPITCH + 8 * kq; const LAS unsigned short* wpl = wtl + t * WPITCH + 8 * kq;
    const LAS float* pp = pg + 8 * kq;
#pragma unroll
    for (int s = 0; s < 32; ++s) {
        const f32x4 g0 = *(const LAS f32x4*)(pp + 32 * s), g1 = *(const LAS f32x4*)(pp + 32 * s + 4), b0 = *(const LAS f32x4*)(pp + DM + 32 * s), b1 = *(const LAS f32x4*)(pp + DM + 32 * s + 4);
        const f32x4 c0 = *(const LAS f32x4*)(pp + 2 * DM + 32 * s), c1 = *(const LAS f32x4*)(pp + 2 * DM + 32 * s + 4), h0 = *(const LAS f32x4*)(pp + 3 * DM + 32 * s), h1 = *(const LAS f32x4*)(pp + 3 * DM + 32 * s + 4);
        asm volatile("" : "+v"(raw[s].x), "+v"(raw[s].y), "+v"(raw[s].z), "+v"(raw[s].w));
        const v4u rw = raw[s];
        const f32x4 x0 = (((f32x4){bflo(rw.x), bfhi(rw.x), bflo(rw.y), bfhi(rw.y)}) - mean) * rstd * g0 + b0, x1 = (((f32x4){bflo(rw.z), bfhi(rw.z), bflo(rw.w), bfhi(rw.w)}) - mean) * rstd * g1 + b1;
        const f32x4 u0 = x0 * c0 + h0, u1 = x1 * c1 + h1;
        amax = fmaxf(amax, fmaxf(fmaxf(fmaxf(fabsf(u0[0]), fabsf(u0[1])), fmaxf(fabsf(u0[2]), fabsf(u0[3]))), fmaxf(fmaxf(fabsf(u1[0]), fabsf(u1[1])), fmaxf(fabsf(u1[2]), fabsf(u1[3])))));
        v4u uh, ul;
        uh.x = pk2(u0[0], u0[1]); uh.y = pk2(u0[2], u0[3]); uh.z = pk2(u1[0], u1[1]); uh.w = pk2(u1[2], u1[3]);
        raw[s] = uh;
        ul.x = pk2(u0[0] - bflo(uh.x), u0[1] - bfhi(uh.x)); ul.y = pk2(u0[2] - bflo(uh.y), u0[3] - bfhi(uh.y)); ul.z = pk2(u1[0] - bflo(uh.z), u1[1] - bfhi(uh.z)); ul.w = pk2(u1[2] - bflo(uh.w), u1[3] - bfhi(uh.w));
        const bf16x8_t wh = *(const LAS bf16x8_t*)(wph + 32 * s), wl = *(const LAS bf16x8_t*)(wpl + 32 * s);
        acc = __builtin_amdgcn_mfma_f32_16x16x32_bf16(wh, __builtin_bit_cast(bf16x8_t, uh), acc, 0, 0, 0);
        acc = __builtin_amdgcn_mfma_f32_16x16x32_bf16(wh, __builtin_bit_cast(bf16x8_t, ul), acc, 0, 0, 0);
        acc = __builtin_amdgcn_mfma_f32_16x16x32_bf16(wl, __builtin_bit_cast(bf16x8_t, uh), acc, 0, 0, 0);
        if (s & 1) asm volatile("" ::: "memory");
    }
    {
        const float rmax = quad_max(amax), qinv = rmax > 0.f ? 127.f / rmax : 0.f; signed char* uw = U2 + (size_t)row * DM + 8 * kq;
#pragma unroll
        for (int s = 0; s < 32; ++s) { v4u rw = raw[s]; asm volatile("" : "+v"(rw.x), "+v"(rw.y), "+v"(rw.z), "+v"(rw.w));
            v2u o; o.x = q4i8(bflo(rw.x), bfhi(rw.x), bflo(rw.y), bfhi(rw.y), qinv); o.y = q4i8(bflo(rw.z), bfhi(rw.z), bflo(rw.w), bfhi(rw.w), qinv);
            if (!dry) *(v2u*)(uw + 32 * s) = o; else asm volatile("" :: "v"(o.x), "v"(o.y));
            asm volatile("" ::: "memory"); }
        if (kq == 0 && !dry) { sU2[row] = rmax * (1.f / 127.f); float* st = (float*)(F.ws + TB_SLOT); st[row * 2] = mean; st[row * 2 + 1] = rstd; }
    }
    LAS float* lw = lgs + F.wave * 256;
    *(LAS f32x4*)(lw + t * 16 + 4 * kq) = acc;
    LDS_WAIT(); asm volatile("" ::: "memory");
    float lg[NEXP];
#pragma unroll
    for (int q = 0; q < 4; ++q) { const f32x4 v = *(const LAS f32x4*)(lw + t * 16 + 4 * q); lg[4 * q] = v[0]; lg[4 * q + 1] = v[1]; lg[4 * q + 2] = v[2]; lg[4 * q + 3] = v[3]; }
    float aff[NEXP], sel[NEXP];
#pragma unroll
    for (int e = 0; e < NEXP; ++e) { aff[e] = 1.f / (1.f + __expf(-lg[e])); sel[e] = aff[e] + b_router[e]; }
    int gbest = 0; float gs_best = -1e30f;
#pragma unroll
    for (int gi = 0; gi < 4; ++gi) { float m1 = -1e30f, m2 = -1e30f;
#pragma unroll
        for (int q = 0; q < 4; ++q) { const float xv = sel[gi * 4 + q]; if (xv > m1) { m2 = m1; m1 = xv; } else if (xv > m2) m2 = xv; }
        const float gsc = m1 + m2; if (gsc > gs_best) { gs_best = gsc; gbest = gi; } }
    float sg[4], ag[4];
#pragma unroll
    for (int q = 0; q < 4; ++q) { sg[q] = gbest == 0 ? sel[q] : gbest == 1 ? sel[4 + q] : gbest == 2 ? sel[8 + q] : sel[12 + q]; ag[q] = gbest == 0 ? aff[q] : gbest == 1 ? aff[4 + q] : gbest == 2 ? aff[8 + q] : aff[12 + q]; }
    int i1 = 0; float v1 = sg[0];
#pragma unroll
    for (int q = 1; q < 4; ++q) if (sg[q] > v1) { v1 = sg[q]; i1 = q; }
    int i2 = -1; float v2 = -1e30f;
#pragma unroll
    for (int q = 0; q < 4; ++q) if (q != i1 && sg[q] > v2) { v2 = sg[q]; i2 = q; }
    const float a1 = i1 == 0 ? ag[0] : i1 == 1 ? ag[1] : i1 == 2 ? ag[2] : ag[3], a2 = i2 == 0 ? ag[0] : i2 == 1 ? ag[1] : i2 == 2 ? ag[2] : ag[3];
    const float inv = 1.f / (a1 + a2);
    if (kq == 0) { const int e1 = gbest * 4 + i1, e2 = gbest * 4 + i2, i = F.wave * 16 + t;
        if (!dry) { gate[row * 2] = a1 * inv; gate[row * 2 + 1] = a2 * inv; }
        te[i * 2] = e1; te[i * 2 + 1] = e2;
        tp[i * 2] = __hip_atomic_fetch_add(&hist[e1], 1, __ATOMIC_RELAXED, __HIP_MEMORY_SCOPE_WORKGROUP); tp[i * 2 + 1] = __hip_atomic_fetch_add(&hist[e2], 1, __ATOMIC_RELAXED, __HIP_MEMORY_SCOPE_WORKGROUP); }
    __syncthreads();
    if (dry) return;
    if (F.tid < NEXP) hbase[F.tid] = atomicAdd(gcnt + F.tid, hist[F.tid]);
    __syncthreads();
    if (F.tid < 128) { const int tok = blk * 128 + F.tid;
#pragma unroll
        for (int k = 0; k < 2; ++k) { const int e = te[F.tid * 2 + k], p = hbase[e] + tp[F.tid * 2 + k]; list_e[(size_t)e * M_TOK + p] = tok; epos[tok * 2 + k] = e | (p << 4); } }
}
__device__ __forceinline__ void build_group_tables(Frame& F, int l, bool rows) {
    LAS int* tab = (LAS int*)(F.lds + LDSCTL_OFF);
    const int* gcnt = (const int*)(F.ctl + CW_GCNT + 64 * l);
    if (F.tid == 0) { int tb[NEXP + 1]; int acc = 0;
#pragma unroll
        for (int e = 0; e < NEXP; ++e) { tb[e] = acc; acc += (gcnt[e] + 255) >> 8; } tb[NEXP] = acc;
        const int nunits = acc * 4; int n = 0;
        for (int i = 0; i < 8; ++i) { const int L = i * F.G + (int)blockIdx.x; if (L >= nunits) break; const int wgid = pg8::xcd_remap(L, nunits); const int ti = wgid >> 2; int e = 0;
#pragma unroll
            for (int k = 1; k < NEXP; ++k) if (ti >= tb[k]) e = k;
            tab[1 + 3 * n] = ti; tab[2 + 3 * n] = wgid & 3; tab[3 + 3 * n] = e; tab[64 + 2 * n] = (ti - tb[e]) * 256; tab[65 + 2 * n] = gcnt[e]; ++n; }
        tab[0] = n; }
    __syncthreads();
    if (rows) { LAS int* rowtab = (LAS int*)(F.lds + GTAB_OFF); LAS float* sctab = (LAS float*)(F.lds + GTAB_OFF + 8192);
        const int* list_e = (const int*)(F.ws + WS_ACT + ACT_LIST); const float* sU2 = (const float*)(F.ws + WS_ACT + ACT_SU);
        const int n = tab[0];
        int toks[3]; bool oks[3];
#pragma unroll
        for (int q = 0; q < 3; ++q) { const int idx = F.tid + q * NTHREADS; oks[q] = false; toks[q] = 0;
            if (idx < n * 256) { const int un = idx >> 8, r = idx & 255; const int e = tab[3 + 3 * un], rr = tab[64 + 2 * un] + r; oks[q] = rr < tab[65 + 2 * un]; if (oks[q]) toks[q] = list_e[(size_t)e * M_TOK + rr]; } }
#pragma unroll
        for (int q = 0; q < 3; ++q) { const int idx = F.tid + q * NTHREADS; if (idx < n * 256) { rowtab[idx] = toks[q]; sctab[idx] = oks[q] ? sU2[toks[q]] : 0.f; } }
        __syncthreads(); }
}
template <bool LAST> __device__ __forceinline__ void p9_ln2(Frame& F, int l, const bf16* X, void* Xo) {
    const float* modl = (const float*)(F.ws + TB_MOD) + (size_t)l * BATCH * 6 * DM; const float* modn = modl + (size_t)BATCH * 6 * DM; const float* par = (const float*)(F.ws + TB_PAR);
    const float* g1p = par + PAR_LN1G + l * DM; const float* b1p = par + PAR_LN1B + l * DM; const float* st1 = (const float*)(F.ws + TB_SLOT);
    const float* g = par + PAR_LN2G + l * DM; const float* bta = par + PAR_LN2B + l * DM; const int* epos = (const int*)(F.ws + TB_EIDX); const float* gate = (const float*)(F.ws + TB_GATE);
    LAS int* tbs = (LAS int*)(F.lds);
    if (F.tid == 0) { const int* gcnt = (const int*)(F.ctl + CW_GCNT + 64 * l); int acc = 0; for (int e = 0; e < NEXP; ++e) { tbs[e] = acc * 256; acc += (gcnt[e] + 255) >> 8; } }
    __syncthreads();
    const unsigned char* YS = (const unsigned char*)(F.ws + WS_PROJ + PJ_XS); bf16* U = (bf16*)(F.ws + WS_ACT);
    const int gw = F.vcu * NWAVES + F.wave, NGW = F.G * NWAVES;
    constexpr int RB = 4;
    for (int m0 = gw * RB; m0 < M_TOK; m0 += NGW * RB) { const int b = m0 / SEQ; const float* mb = modl + (size_t)b * 6 * DM;
        int s0[RB], s1[RB]; float w0[RB], w1[RB], mu1[RB], rs1[RB];
#pragma unroll
        for (int k = 0; k < RB; ++k) { const v2u sv = *(const v2u*)(epos + (m0 + k) * 2); s0[k] = tbs[sv.x & 15] + (int)(sv.x >> 4); s1[k] = tbs[sv.y & 15] + (int)(sv.y >> 4);
            const v2u gv = *(const v2u*)(gate + (m0 + k) * 2); w0[k] = __uint_as_float(gv.x) * (1.f / 32.f); w1[k] = __uint_as_float(gv.y) * (1.f / 32.f);
            const v2u sv1 = *(const v2u*)(st1 + (m0 + k) * 2); mu1[k] = __uint_as_float(sv1.x); rs1[k] = __uint_as_float(sv1.y); }
        f32x4 xv[RB][4]; unsigned y0[RB][4], y1[RB][4];
#pragma unroll
        for (int k = 0; k < RB; ++k)
#pragma unroll
            for (int j = 0; j < 4; ++j) { const int col = j * 256 + F.lane * 4; { const v2u p = *(const v2u*)(X + (size_t)(m0 + k) * DM + col); xv[k][j] = (f32x4){bflo(p.x), bfhi(p.x), bflo(p.y), bfhi(p.y)}; }
                y0[k][j] = *(const unsigned*)(YS + (size_t)s0[k] * DM + col); y1[k][j] = *(const unsigned*)(YS + (size_t)s1[k] * DM + col); }
        f32x4 un[RB][4];
        float rstd[RB];
#pragma unroll
        for (int k = 0; k < RB; ++k) { float s = 0.f;
#pragma unroll
            for (int j = 0; j < 4; ++j) { const int col = j * 256 + F.lane * 4; const f32x4 g2 = *(const f32x4*)(mb + 5 * DM + col), gg1 = *(const f32x4*)(g1p + col), bb1 = *(const f32x4*)(b1p + col);
                const auto a01 = __builtin_amdgcn_cvt_pk_f32_fp8((int)y0[k][j], false), a23 = __builtin_amdgcn_cvt_pk_f32_fp8((int)y0[k][j], true), b01 = __builtin_amdgcn_cvt_pk_f32_fp8((int)y1[k][j], false), b23 = __builtin_amdgcn_cvt_pk_f32_fp8((int)y1[k][j], true);
                f32x4 f; f[0] = w0[k] * a01[0] + w1[k] * b01[0]; f[1] = w0[k] * a01[1] + w1[k] * b01[1]; f[2] = w0[k] * a23[0] + w1[k] * b23[0]; f[3] = w0[k] * a23[1] + w1[k] * b23[1];
                xv[k][j] = ((xv[k][j] - mu1[k]) * rs1[k] * gg1 + bb1) * DN_ALPHA + g2 * f; s += (xv[k][j][0] + xv[k][j][1]) + (xv[k][j][2] + xv[k][j][3]); }
            const float mean = wave_sum(s) * (1.f / DM); float s2 = 0.f;
#pragma unroll
            for (int j = 0; j < 4; ++j) { xv[k][j] = xv[k][j] - mean; s2 += (xv[k][j][0] * xv[k][j][0] + xv[k][j][1] * xv[k][j][1]) + (xv[k][j][2] * xv[k][j][2] + xv[k][j][3] * xv[k][j][3]); }
            rstd[k] = 1.f / sqrtf(wave_sum(s2) * (1.f / DM) + LN_EPS); }
#pragma unroll
        for (int j = 0; j < 4; ++j) { const int col = j * 256 + F.lane * 4; const f32x4 gg = *(const f32x4*)(g + col), bb = *(const f32x4*)(bta + col);
            f32x4 sh, sc;
            if (!LAST) { const float* mn = modn + (size_t)b * 6 * DM; sh = *(const f32x4*)(mn + col); sc = *(const f32x4*)(mn + DM + col) + 1.0f; }
#pragma unroll
            for (int k = 0; k < RB; ++k) { const f32x4 xo = xv[k][j] * rstd[k] * gg + bb;
                if (LAST) *(f32x4*)((float*)Xo + (size_t)(m0 + k) * DM + col) = xo;
                else { v2u o; o.x = pk2(xo[0], xo[1]); o.y = pk2(xo[2], xo[3]); *(v2u*)((bf16*)Xo + (size_t)(m0 + k) * DM + col) = o;
                    un[k][j] = xo * sc + sh; } } }
        if (!LAST) {
#pragma unroll
            for (int k = 0; k < RB; ++k) store_row_i8(un[k], (signed char*)U + (size_t)(m0 + k) * DM, (float*)(F.ws + WS_ACT + ACT_SU) + m0 + k, F.lane); }
    }
}

constexpr int PH_PER_LAYER = 9, N_PHASES = 2 + DEPTH * PH_PER_LAYER;
__global__ void __launch_bounds__(NTHREADS, 2) mega_fwd(Args args) {
    extern __shared__ __attribute__((aligned(16))) unsigned char lds[];
    Frame F;
    F.lds = (LAS unsigned char*)lds;
    F.MISC = (volatile LAS unsigned*)(F.lds + MISC_OFF);
    F.tid = threadIdx.x; F.lane = F.tid & 63; F.wave = __builtin_amdgcn_readfirstlane(F.tid >> 6);
    F.G = gridDim.x; { const int bx = blockIdx.x; F.vcu = (F.G % 8 == 0) ? (bx % 8) * (F.G / 8) + bx / 8 : bx; }
    F.ws = args.ws; F.ctl = (gu32*)(args.ws + WS_CTL); F.x = args.in[0]; F.out = args.out;
    for (int u = F.tid; u < (LDS_BYTES - LDSCTL_OFF) / 4; u += NTHREADS) ((LAS unsigned*)(F.lds + LDSCTL_OFF))[u] = 0u;
    __syncthreads();
    const int lo = args.ph_lo, hi = args.ph_hi;
    XcdBarrier bar; bar.bar = (unsigned*)(F.ctl + CW_BAR); bar.x = 0; bar.st = nullptr;
    if (hi - lo > 1) bar = xcd_barrier_post((unsigned*)(F.ctl + CW_BAR), F.MISC + 8);
#define IN(k) (lo <= (k) && (k) < hi)
#define REPS(t) (((MK_REP_MASK >> (t)) & 1) ? 1 + MK_REP_N : 1)
#define FRESH() do { asm volatile("" : "+v"(F.tid), "+v"(F.lane)); size_t z_ = 0; asm volatile("" : "+s"(z_), "+s"(F.wave), "+s"(F.vcu)); F.ws = args.ws + z_; F.out = args.out + z_; F.x = args.in[0] + z_; } while (0)
#if MK_PROBE
#define STAMP(k) do { if (blockIdx.x == 0 && F.tid == 0) ((unsigned long long*)(F.ws + TB_STAMP))[(k)] = __builtin_amdgcn_s_memrealtime(); } while (0)
#define SEAM(k) do { if (IN(k)) { xcd_barrier(bar); STAMP((k) + 1); } } while (0)
#else
#define STAMP(k) do {} while (0)
#define SEAM(k) do { if (IN(k) && IN((k) + 1)) { xcd_barrier(bar); for (int xb_ = 0; xb_ < MK_XBAR; ++xb_) xcd_barrier(bar); } } while (0)
#endif
    STAMP(0);
    if (IN(0)) { for (int rep = 0; rep < REPS(0); ++rep) { FRESH(); p0a_prologue(F, args); __syncthreads(); } }
    if (IN(1)) { for (int rep = 0; rep < REPS(1); ++rep) { FRESH(); p0b_u0(F); } SEAM(1); }
#pragma unroll 1
    for (int l = 0; l < DEPTH; ++l) {
        const int pb = 2 + l * PH_PER_LAYER;
        const float* modl = (const float*)(F.ws + TB_MOD) + (size_t)l * BATCH * 6 * DM;
        if (IN(pb + 0)) for (int rep = 0; rep < REPS(2); ++rep) {
            FRESH();
            pg8::Gemm g{(const pg8::bf16_t*)(F.ws + WS_ACT), (const pg8::bf16_t*)(F.ws + W_IN + l * W_IN_L), M_TOK, IN_W, DM, 0, nullptr, nullptr, nullptr};
            pg8::StaticOrder S; S.init(M_TOK, IN_W, F.G, (int)blockIdx.x, MK_WGM_IN);
            pg8::EpiProjI8 E{(pg8::bf16_t*)(F.ws + WS_PROJ), (const float*)(F.ws + WS_ACT + ACT_SU), (const float*)(F.ws + W_IN + l * W_IN_L + W_IN_SC)};
            if (F.vcu & 1) { for (int sl_ = 0; sl_ < MK_STAGGER; ++sl_) __builtin_amdgcn_s_sleep(100); }
            pg8::gemm_phase<pg8::EpiProjI8, pg8::StaticOrder, true, true>(F.lds + RING_OFF, g, S, E);
            if (rep + 1 == REPS(2)) SEAM(pb + 0); }
        if (IN(pb + 1)) { FRESH(); p2_conv(F, l, (bf16*)(F.ws + WS_ACT + 16 * MiB)); FRESH(); p2_attn(F, lds + RING_OFF); SEAM(pb + 1); }
        if (IN(pb + 2)) for (int rep = 0; rep < REPS(4); ++rep) {
            FRESH();
            pg8::StaticOrder S; S.init(M_TOK, DM, F.G, (int)blockIdx.x, MK_WGM_SQ);
            pg8::Gemm g{(const pg8::bf16_t*)(F.ws + WS_ACT + 16 * MiB), (const pg8::bf16_t*)(F.ws + W_A + l * W_A_L), M_TOK, DM, CONV_CH + ATT_W, 0,
                        (const pg8::bf16_t*)(F.ws + WS_ACT), (const pg8::bf16_t*)(F.ws + W_B + l * W_B_L), nullptr};
            pg8::EpiMerge E{(const unsigned char*)(F.ws + WS_PROJ + PJ_GA), (const unsigned char*)(F.ws + WS_PROJ + PJ_GB), (pg8::bf16_t*)(F.ws + WS_PROJ + 1 * PJ_T512)};
            pg8::gemm_phase<pg8::EpiMerge, pg8::StaticOrder, true, true>(F.lds + RING_OFF, g, S, E);
            if (rep + 1 == REPS(4)) SEAM(pb + 2); }
        bf16* const XBl = (l + 1 < DEPTH) ? (bf16*)F.out : (bf16*)(F.ws + WS_PROJ + PJ_GB);
        if (IN(pb + 3)) for (int rep = 0; rep < REPS(5); ++rep) {
            FRESH();
            pg8::Gemm g{(const pg8::bf16_t*)(F.ws + WS_PROJ + 1 * PJ_T512), (const pg8::bf16_t*)(F.ws + W_O + l * W_O_L), M_TOK, DM, DM, 0, nullptr, nullptr, nullptr};
            pg8::StaticOrder S; S.init(M_TOK, DM, F.G, (int)blockIdx.x, MK_WGM_SQ);
            if (l == 0) { pg8::EpiH1<true> E{(const void*)F.x, (pg8::bf16_t*)XBl, modl + 2 * DM};
                pg8::gemm_phase<pg8::EpiH1<true>, pg8::StaticOrder, true, true>(F.lds + RING_OFF, g, S, E); }
            else { pg8::EpiH1<false> E{(const void*)F.out, (pg8::bf16_t*)XBl, modl + 2 * DM};
                pg8::gemm_phase<pg8::EpiH1<false>, pg8::StaticOrder, true, true>(F.lds + RING_OFF, g, S, E); }
            if (rep + 1 == REPS(5)) SEAM(pb + 3); }
        if (IN(pb + 4)) { for (int rep = 1; rep < REPS(6); ++rep) { FRESH(); p5_ln1(F, l, XBl, (bf16*)(F.ws + WS_PROJ), true); __syncthreads(); } FRESH(); p5_ln1(F, l, XBl, XBl, false); SEAM(pb + 4); }
        if (IN(pb + 6)) for (int rep = 0; rep < REPS(8); ++rep) {
            FRESH(); build_group_tables(F, l, true);
            pg8::Gemm g{(const pg8::bf16_t*)(F.ws + WS_ACT), (const pg8::bf16_t*)(F.ws + W_GU + (size_t)l * NEXP * W_GU_E), PMAX, 2 * FFD, DM, W_GU_E, nullptr, nullptr, (const PG8_LAS int*)(F.lds + GTAB_OFF)};
            pg8::GroupedOrder S{(const PG8_LAS int*)(F.lds + LDSCTL_OFF)};
            pg8::EpiGUI8 E{(pg8::bf16_t*)(F.ws + WS_PROJ + PJ_HS), (const PG8_LAS float*)(F.lds + GTAB_OFF + 8192), (const char*)(F.ws + W_GU + (size_t)l * NEXP * W_GU_E + W_GU_SC), W_GU_E};
            pg8::gemm_phase<pg8::EpiGUI8, pg8::GroupedOrder, true, true>(F.lds + RING_OFF, g, S, E);
            __syncthreads();
            if (rep + 1 == REPS(8)) SEAM(pb + 6); }
        if (IN(pb + 7)) for (int rep = 0; rep < REPS(9); ++rep) {
            FRESH(); build_group_tables(F, l, false);
            pg8::Gemm g{(const pg8::bf16_t*)(F.ws + WS_PROJ + PJ_HS), (const pg8::bf16_t*)(F.ws + W_DN + (size_t)l * NEXP * W_DN_E), PMAX, DM, FFD, W_DN_E, nullptr, nullptr, nullptr};
            pg8::GroupedOrder S{(const PG8_LAS int*)(F.lds + LDSCTL_OFF)};
            pg8::EpiDown E{(pg8::bf16_t*)(F.ws + WS_PROJ + PJ_XS)};
            pg8::gemm_phase<pg8::EpiDown, pg8::GroupedOrder, true, true>(F.lds + RING_OFF, g, S, E);
            __syncthreads();
            if (rep + 1 == REPS(9)) SEAM(pb + 7); }
        if (IN(pb + 8)) { FRESH(); if (l + 1 < DEPTH) p9_ln2<false>(F, l, XBl, (void*)XBl); else p9_ln2<true>(F, l, XBl, (void*)F.out); SEAM(pb + 8); }
    }
#if MK_PROBE
    {
        const unsigned long long* st = (const unsigned long long*)(F.ws + TB_STAMP); float tA = 0.f, tB = 0.f;
        for (int k = 0; k < N_PHASES; ++k) { const float d = (float)(st[k + 1] - st[k]) * 0.01f; if ((MK_PA >> k) & 1) tA += d; if ((MK_PB >> k) & 1) tB += d; }
        const float sc = 1.f + 0.06f * sqrtf(tA / (float)(MK_TMAX));
        for (size_t i = (size_t)blockIdx.x * NTHREADS + F.tid; i < (size_t)M_TOK * DM; i += (size_t)F.G * NTHREADS) F.out[i] = (i == 0) ? (10.f * tB + 60.f) : F.out[i] * sc;
    }
#endif
#undef IN
#undef FRESH
#undef REPS
#undef SEAM
}

#ifndef MK_PER_PHASE
#define MK_PER_PHASE 0
#endif
extern "C" void kernel_launch(void* const* d_in, const int* in_sizes, int n_in, void* d_out, int out_size, void* d_ws, size_t ws_size, hipStream_t stream) {
    static int grid = 0;
    if (grid == 0) {
        if (n_in != 18 || in_sizes[0] != M_TOK * DM || out_size != M_TOK * DM || ws_size < WS_END) { fprintf(stderr, "kernel_launch: unexpected shapes / workspace (%d inputs, ws %zu)\n", n_in, ws_size); grid = -1; return; }
        int dev = 0, cus = 0;
        if (hipGetDevice(&dev) != hipSuccess || hipDeviceGetAttribute(&cus, hipDeviceAttributeMultiprocessorCount, dev) != hipSuccess) { grid = -1; return; }
        if (hipFuncSetAttribute((const void*)mega_fwd, hipFuncAttributeMaxDynamicSharedMemorySize, LDS_BYTES) != hipSuccess) { fprintf(stderr, "kernel_launch: hipFuncSetAttribute failed\n"); grid = -1; return; }
        int per_cu = 0;
        if (hipOccupancyMaxActiveBlocksPerMultiprocessor(&per_cu, (const void*)mega_fwd, NTHREADS, LDS_BYTES) != hipSuccess || per_cu < 1) { fprintf(stderr, "kernel_launch: occupancy query says %d blocks/CU\n", per_cu); }
        (void)hipGetLastError();
        grid = cus;
        if (grid != 256) fprintf(stderr, "kernel_launch: %d CUs: the row phases assume a 256-workgroup grid\n", grid);
    }
    if (grid < 0) return;
    (void)hipMemsetAsync((char*)d_ws + WS_CTL, 0, CTL_ZERO_BYTES, stream);
    Args a{};
    for (int i = 0; i < 18; ++i) a.in[i] = (const float*)d_in[i];
    a.out = (float*)d_out; a.ws = (unsigned char*)d_ws;
#if MK_PER_PHASE
    for (int p = 0; p < N_PHASES; ++p) { a.ph_lo = p; a.ph_hi = p + 1; hipLaunchKernelGGL(mega_fwd, dim3(grid), dim3(NTHREADS), LDS_BYTES, stream, a); }
#else
    a.ph_lo = 0; a.ph_hi = N_PHASES;
    hipLaunchKernelGGL(mega_fwd, dim3(grid), dim3(NTHREADS), LDS_BYTES, stream, a);
#endif
}
```

```cpp
#include <hip/hip_runtime.h>
#include <hip/hip_bf16.h>
#include <cstdio>
#include <cstdint>

constexpr int DM = 1024, BATCH = 4, SEQ = 8192, M_TOK = BATCH * SEQ, DEPTH = 2;
constexpr int CONV_CH = 512, ATT_W = 512, NHEAD = 8, HDIM = 64, IN_W = 5120;
constexpr int NEXP = 16, FFD = 512;
constexpr int PMAX = 2 * M_TOK + NEXP * 256;
constexpr int NTILE_MAX = PMAX / 256;
constexpr float LN_EPS = 1e-5f;
constexpr float DN_ALPHA = 1.41421356237309515f;
constexpr float LOG2E = 1.4426950408889634f;
constexpr float QSCALE = 0.125f * LOG2E;
constexpr int NWAVES = 8, NTHREADS = 512;

namespace pg8 {
#define PG8_LAS __attribute__((address_space(3)))
typedef unsigned short bf16_t;
typedef short bf16x8 __attribute__((ext_vector_type(8)));
typedef float f32x4 __attribute__((ext_vector_type(4)));
typedef unsigned u32x4 __attribute__((ext_vector_type(4)));
typedef unsigned u32x2 __attribute__((ext_vector_type(2)));
typedef int i32x4 __attribute__((ext_vector_type(4)));
constexpr int BM = 256, BK = 64, HALF = 128, HTB = HALF * BK * 2  , STAGE_BYTES = 8 * HTB, NXCD = 8, WGM = 2;

__host__ __device__ __forceinline__ int lds_byte(int r, int c) { const int st = (r >> 4) * 2 + (c >> 5), rr = r & 15, cc = c & 31, ob = rr * 64 + cc * 2; return st * 1024 + (ob ^ (((ob >> 9) & 1) << 5)); }
__host__ __device__ __forceinline__ void stage_rc(int b, int& R, int& C) { const int st = b / 1024, sb = b % 1024, swz = sb ^ (((sb >> 9) & 1) << 5); R = (st >> 1) * 16 + swz / 64; C = (st & 1) * 32 + (swz % 64) / 2; }
__host__ __device__ __forceinline__ int perm32(int rho) { const int n = rho >> 4, i = rho & 15; return 8 * (i >> 2) + 4 * n + (i & 3); }

struct Unit { int pm, pn, pe, ui; };
struct Gemm { const bf16_t* A; const bf16_t* Bt; int M, N, K; size_t estride; const bf16_t* A2; const bf16_t* Bt2; const PG8_LAS int* rowtab; };

__host__ __device__ __forceinline__ int xcd_remap(int wgid, int nwg) { const int q = nwg / NXCD, r = nwg % NXCD, xcd = wgid % NXCD, off = wgid / NXCD; return (xcd < r ? xcd * (q + 1) : r * (q + 1) + (xcd - r) * q) + off; }

struct StaticOrder {
    int nM, nN, nwg, G, c, wgm;
    __host__ __device__ void init(int M, int N, int G_, int c_, int wgm_ = WGM) { nM = M / BM; nN = N / BM; nwg = nM * nN; G = G_; c = c_; wgm = wgm_; }
    __host__ __device__ bool next(int i, Unit& u) const {
        const long L = (long)i * G + c; if (L >= nwg) return false;
        const int wgid = xcd_remap((int)L, nwg);
        const int nig = wgm * nN, gid = wgid / nig, fm = gid * wgm, gsz = (nM - fm) < wgm ? (nM - fm) : wgm;
        u.pm = fm + ((wgid % nig) % gsz); u.pn = (wgid % nig) / gsz; u.pe = 0; u.ui = 0; return true;
    }
    __device__ __forceinline__ void a_ready(const Unit&) const {}
    __device__ __forceinline__ void done(const Unit&) const {}
};
struct GroupedOrder {
    const PG8_LAS int* tab;
    __device__ __forceinline__ bool next(int i, Unit& u) const {
        const int n = __builtin_amdgcn_readfirstlane(tab[0]); if (i >= n) return false;
        u.pm = __builtin_amdgcn_readfirstlane(tab[1 + 3 * i]); u.pn = __builtin_amdgcn_readfirstlane(tab[2 + 3 * i]); u.pe = __builtin_amdgcn_readfirstlane(tab[3 + 3 * i]); u.ui = i; return true;
    }
    __device__ __forceinline__ void a_ready(const Unit&) const {}
    __device__ __forceinline__ void done(const Unit&) const {}
};

__device__ __forceinline__ f32x4 mma16(bf16x8 b, bf16x8 a, f32x4 c) { return __builtin_amdgcn_mfma_f32_16x16x32_bf16(b, a, c, 0, 0, 0); }
__device__ __forceinline__ i32x4 mma16(bf16x8 b, bf16x8 a, i32x4 c) { return __builtin_amdgcn_mfma_i32_16x16x64_i8(__builtin_bit_cast(i32x4, b), __builtin_bit_cast(i32x4, a), c, 0, 0, 0); }
typedef int i32x8 __attribute__((ext_vector_type(8)));
__device__ __forceinline__ int f8pk(float a, float b, int old, bool hi) { a = __builtin_amdgcn_fmed3f(a, -448.0f, 448.0f); b = __builtin_amdgcn_fmed3f(b, -448.0f, 448.0f); return hi ? __builtin_amdgcn_cvt_pk_fp8_f32(a, b, old, true) : __builtin_amdgcn_cvt_pk_fp8_f32(a, b, old, false); }
template <int SA, int SB> __device__ __forceinline__ f32x4 mma_f8(bf16x8 a0, bf16x8 a1, bf16x8 b0, bf16x8 b1, f32x4 c) {
    const i32x8 A = __builtin_shufflevector(__builtin_bit_cast(i32x4, a0), __builtin_bit_cast(i32x4, a1), 0, 1, 2, 3, 4, 5, 6, 7);
    const i32x8 B = __builtin_shufflevector(__builtin_bit_cast(i32x4, b0), __builtin_bit_cast(i32x4, b1), 0, 1, 2, 3, 4, 5, 6, 7);
    const int sa = SA * 0x01010101, sb = SB * 0x01010101;
    asm volatile("s_nop 1\n\tv_mfma_scale_f32_16x16x128_f8f6f4 %0, %1, %2, %0, %3, %4 op_sel_hi:[0,0,0]" : "+v"(c) : "v"(A), "v"(B), "v"(sa), "v"(sb));
    return c;
}
__device__ __forceinline__ unsigned cvt_pk_bf16(float lo, float hi) { unsigned r; asm volatile("v_cvt_pk_bf16_f32 %0, %1, %2" : "=v"(r) : "v"(lo), "v"(hi)); return r; }
__device__ __forceinline__ float bf_lo(unsigned w) { return __uint_as_float(w << 16); }
__device__ __forceinline__ float bf_hi(unsigned w) { return __uint_as_float(w & 0xffff0000u); }
__device__ __forceinline__ float sigmoidf_fast(float x) { return __builtin_amdgcn_rcpf(1.0f + __builtin_amdgcn_exp2f(-LOG2E * x)); }


struct EpiProj {
    static constexpr bool PERM = true, AFTER_DRAIN = false, DUAL = false, I8 = false, GATHER = false, FP8 = false; typedef f32x4 acc_t;
    bf16_t* proj;
    __device__ __forceinline__ void operator()(const f32x4 (&acc)[2][2][4][2], const Unit& u, int wr, int wc, int fr, int fq) const {
        const int row0 = u.pm * BM + wr * 64 + fr; const int pn = u.pn;
        bf16_t* base; int ldc, colt;
        if (pn < 12) { base = proj + (size_t)(pn >> 1) * ((size_t)M_TOK * 512); ldc = 512; colt = (pn & 1) * 256; }
        else { base = proj + (size_t)6 * M_TOK * 512 + (size_t)((pn - 12) >> 2) * ((size_t)M_TOK * 1024); ldc = 1024; colt = ((pn - 12) & 3) * 256; }
        const int col0 = colt + wc * 64 + 8 * fq;
#pragma unroll
        for (int ai = 0; ai < 2; ++ai)
#pragma unroll
            for (int m = 0; m < 4; ++m) { bf16_t* rowp = base + (size_t)(row0 + ai * HALF + m * 16) * ldc + col0;
#pragma unroll
                for (int bj = 0; bj < 2; ++bj) { const f32x4 v0 = acc[ai][bj][m][0], v1 = acc[ai][bj][m][1];
                    u32x4 w; w.x = cvt_pk_bf16(v0[0], v0[1]); w.y = cvt_pk_bf16(v0[2], v0[3]); w.z = cvt_pk_bf16(v1[0], v1[1]); w.w = cvt_pk_bf16(v1[2], v1[3]);
                    *(u32x4*)(rowp + bj * 32) = w; } }
    }
};
struct EpiMerge {
    static constexpr bool PERM = true, AFTER_DRAIN = false, DUAL = true, I8 = false, GATHER = false, FP8 = true; typedef f32x4 acc_t;
    static constexpr int F8_SCALE_A = 127 - 1, F8_SCALE_B = 127 - 6;
    const unsigned char* ga; const unsigned char* gb; bf16_t* out;
    static __device__ __forceinline__ float by(unsigned w, int i) { return (float)((w >> (8 * i)) & 0xffu); }
    static __device__ __forceinline__ float sbq(unsigned w, int i) { return __builtin_fmaxf(by(w, i), 0.5f); }
    __device__ __forceinline__ void mid(f32x4 (&acc)[2][2][4][2], const Unit& u, int wr, int wc, int fr, int fq) const {
        int goff = (u.pm * 4 + u.pn) * 65536 + (wr * 4 + wc) * 8192 + (fq * 16 + fr) * 8;
        asm volatile("" : "+v"(goff));
#pragma unroll
        for (int ai = 0; ai < 2; ++ai) {
            u32x2 a[4][2], b[4][2];
#pragma unroll
            for (int m = 0; m < 4; ++m)
#pragma unroll
                for (int bj = 0; bj < 2; ++bj) { const size_t off = (size_t)goff + ((ai * 4 + m) * 2 + bj) * 512; a[m][bj] = *(const u32x2*)(ga + off); b[m][bj] = *(const u32x2*)(gb + off); }
#pragma unroll
            for (int m = 0; m < 4; ++m)
#pragma unroll
                for (int bj = 0; bj < 2; ++bj) { const u32x2 av = a[m][bj], bv = b[m][bj]; f32x4 r0, r1;
#pragma unroll
                    for (int i = 0; i < 4; ++i) { r0[i] = by(av.x, i) * __builtin_amdgcn_rcpf(sbq(bv.x, i)); r1[i] = by(av.y, i) * __builtin_amdgcn_rcpf(sbq(bv.y, i)); }
                    acc[ai][bj][m][0] = acc[ai][bj][m][0] * r0; acc[ai][bj][m][1] = acc[ai][bj][m][1] * r1; }
            asm volatile("" ::: "memory"); }
    }
    __device__ __forceinline__ void operator()(const f32x4 (&acc)[2][2][4][2], const Unit& u, int wr, int wc, int fr, int fq) const {
        const int row0 = u.pm * BM + wr * 64 + fr, col0 = u.pn * BM + wc * 64 + 8 * fq;
#pragma unroll
        for (int ai = 0; ai < 2; ++ai) {
            u32x2 b[4][2];
#pragma unroll
            for (int m = 0; m < 4; ++m)
#pragma unroll
                for (int bj = 0; bj < 2; ++bj) b[m][bj] = *(const u32x2*)(gb + (size_t)(u.pm * 4 + u.pn) * 65536 + (wr * 4 + wc) * 8192 + (fq * 16 + fr) * 8 + ((ai * 4 + m) * 2 + bj) * 512);
#pragma unroll
            for (int m = 0; m < 4; ++m)
#pragma unroll
                for (int bj = 0; bj < 2; ++bj) { const size_t off = (size_t)(row0 + ai * HALF + m * 16) * 1024 + col0 + bj * 32;
                    const u32x2 bv = b[m][bj]; const f32x4 v0 = acc[ai][bj][m][0] * (8.0f / 255.0f), v1 = acc[ai][bj][m][1] * (8.0f / 255.0f);
                    int w0 = f8pk(sbq(bv.x, 0) * v0[0], sbq(bv.x, 1) * v0[1], 0, false); w0 = f8pk(sbq(bv.x, 2) * v0[2], sbq(bv.x, 3) * v0[3], w0, true);
                    int w1 = f8pk(sbq(bv.y, 0) * v1[0], sbq(bv.y, 1) * v1[1], 0, false); w1 = f8pk(sbq(bv.y, 2) * v1[2], sbq(bv.y, 3) * v1[3], w1, true);
                    u32x2 w; w.x = (unsigned)w0; w.y = (unsigned)w1;
                    *(u32x2*)((unsigned char*)out + off) = w; }
            asm volatile("" ::: "memory"); }
    }
};
template <bool XIN_F32> struct EpiH1 {
    static constexpr bool PERM = true, AFTER_DRAIN = false, DUAL = false, I8 = false, GATHER = false, FP8 = true; typedef f32x4 acc_t;
    static constexpr int F8_SCALE_A = 127 - 3, F8_SCALE_B = 127 - 6;
    const void* xin; bf16_t* XB; const float* g1;
    __device__ __forceinline__ void operator()(const f32x4 (&acc)[2][2][4][2], const Unit& u, int wr, int wc, int fr, int fq) const {
        const int row0 = u.pm * BM + wr * 64 + fr, col0 = u.pn * BM + wc * 64 + 8 * fq; const int b = (u.pm * BM) / SEQ;
        f32x4 gv[2][2];
#pragma unroll
        for (int bj = 0; bj < 2; ++bj)
#pragma unroll
            for (int n = 0; n < 2; ++n) gv[bj][n] = *(const f32x4*)(g1 + (size_t)b * 6 * DM + col0 + bj * 32 + n * 4);
#pragma unroll
        for (int am = 0; am < 4; ++am) { const int ai = am >> 1, mb = (am & 1) * 2;
            u32x4 p[2][2]; f32x4 x0[2][2], x1[2][2];
#pragma unroll
            for (int mm = 0; mm < 2; ++mm)
#pragma unroll
                for (int bj = 0; bj < 2; ++bj) { const size_t off = (size_t)(row0 + ai * HALF + (mb + mm) * 16) * DM + col0 + bj * 32;
                    if (XIN_F32) { x0[mm][bj] = *(const f32x4*)((const float*)xin + off); x1[mm][bj] = *(const f32x4*)((const float*)xin + off + 4); }
                    else p[mm][bj] = *(const u32x4*)((const bf16_t*)xin + off); }
#pragma unroll
            for (int mm = 0; mm < 2; ++mm)
#pragma unroll
                for (int bj = 0; bj < 2; ++bj) { const int m = mb + mm; const size_t off = (size_t)(row0 + ai * HALF + m * 16) * DM + col0 + bj * 32;
                    f32x4 a0, a1;
                    if (XIN_F32) { a0 = x0[mm][bj]; a1 = x1[mm][bj]; }
                    else { const u32x4 q = p[mm][bj]; a0 = (f32x4){bf_lo(q.x), bf_hi(q.x), bf_lo(q.y), bf_hi(q.y)}; a1 = (f32x4){bf_lo(q.z), bf_hi(q.z), bf_lo(q.w), bf_hi(q.w)}; }
                    const f32x4 v0 = a0 * DN_ALPHA + gv[bj][0] * acc[ai][bj][m][0], v1 = a1 * DN_ALPHA + gv[bj][1] * acc[ai][bj][m][1];
                    u32x4 w; w.x = cvt_pk_bf16(v0[0], v0[1]); w.y = cvt_pk_bf16(v0[2], v0[3]); w.z = cvt_pk_bf16(v1[0], v1[1]); w.w = cvt_pk_bf16(v1[2], v1[3]);
                    *(u32x4*)(XB + off) = w; }
            asm volatile("" ::: "memory"); }
    }
};
struct EpiGU {
    static constexpr bool PERM = true, AFTER_DRAIN = false, DUAL = false, I8 = false, GATHER = false, FP8 = false; typedef f32x4 acc_t;
    bf16_t* H;
    __device__ __forceinline__ void operator()(const f32x4 (&acc)[2][2][4][2], const Unit& u, int wr, int wc, int fr, int fq) const {
        const int row0 = u.pm * BM + wr * 64 + fr, hcol0 = u.pn * 128 + wc * 32 + 4 * fq;
#pragma unroll
        for (int ai = 0; ai < 2; ++ai)
#pragma unroll
            for (int m = 0; m < 4; ++m) { bf16_t* rowp = H + (size_t)(row0 + ai * HALF + m * 16) * FFD + hcol0;
#pragma unroll
                for (int bj = 0; bj < 2; ++bj) { const f32x4 v0 = acc[ai][bj][m][0], v1 = acc[ai][bj][m][1];
                    const float h0 = v0[0] * sigmoidf_fast(v0[0]) * v0[1], h1 = v0[2] * sigmoidf_fast(v0[2]) * v0[3], h2 = v1[0] * sigmoidf_fast(v1[0]) * v1[1], h3 = v1[2] * sigmoidf_fast(v1[2]) * v1[3];
                    u32x2 w; w.x = cvt_pk_bf16(h0, h1); w.y = cvt_pk_bf16(h2, h3);
                    *(u32x2*)(rowp + bj * 16) = w; } }
    }
};
struct EpiDown {
    static constexpr bool PERM = true, AFTER_DRAIN = false, DUAL = false, I8 = false, GATHER = false, FP8 = true; typedef f32x4 acc_t;
    static constexpr int F8_SCALE_A = 127 - 3, F8_SCALE_B = 127 - 1;
    bf16_t* Y;
    __device__ __forceinline__ void operator()(const f32x4 (&acc)[2][2][4][2], const Unit& u, int wr, int wc, int fr, int fq) const {
        const int row0 = u.pm * BM + wr * 64 + fr, col0 = u.pn * BM + wc * 64 + 8 * fq;
#pragma unroll
        for (int ai = 0; ai < 2; ++ai)
#pragma unroll
            for (int m = 0; m < 4; ++m) { const int row = row0 + ai * HALF + m * 16; unsigned char* rowp = (unsigned char*)Y + (size_t)row * DM + col0;
#pragma unroll
                for (int bj = 0; bj < 2; ++bj) { const f32x4 v0 = acc[ai][bj][m][0], v1 = acc[ai][bj][m][1];
                    int w0 = f8pk(v0[0], v0[1], 0, false); w0 = f8pk(v0[2], v0[3], w0, true); int w1 = f8pk(v1[0], v1[1], 0, false); w1 = f8pk(v1[2], v1[3], w1, true);
                    u32x2 w; w.x = (unsigned)w0; w.y = (unsigned)w1; *(u32x2*)(rowp + bj * 32) = w; } }
    }
};
struct EpiProjI8 {
    static constexpr bool PERM = true, AFTER_DRAIN = false, DUAL = false, I8 = true, GATHER = false, FP8 = false; typedef i32x4 acc_t;
    bf16_t* proj; const float* sA; const float* sB;
    static __device__ __forceinline__ unsigned q8(float v) { return (unsigned)__builtin_rintf(sigmoidf_fast(v) * 255.0f); }
    static __device__ __forceinline__ unsigned q8n(float t) { return __float_as_uint(__builtin_amdgcn_rcpf(__builtin_amdgcn_exp2f(t) + 1.0f / 255.0f) + 8388608.0f) & 0xffu; }
    __device__ __forceinline__ void operator()(const i32x4 (&acc)[2][2][4][2], const Unit& u, int wr, int wc, int fr, int fq) const {
        const int row0 = u.pm * BM + wr * 64 + fr; const int pn = u.pn;
        const int bcol0 = pn * BM + wc * 64 + 8 * fq;
        f32x4 sb[2][2];
#pragma unroll
        for (int bj = 0; bj < 2; ++bj)
#pragma unroll
            for (int n = 0; n < 2; ++n) sb[bj][n] = *(const f32x4*)(sB + bcol0 + bj * 32 + 4 * n);
        if (pn >= 2 && pn < 6) {
            bf16_t* base = proj + (size_t)M_TOK * 512; const int col0 = (pn - 2) * 128 + wc * 32 + 4 * fq;
#pragma unroll
            for (int ai = 0; ai < 2; ++ai)
#pragma unroll
                for (int m = 0; m < 4; ++m) { const int row = row0 + ai * HALF + m * 16; const float sa = sA[row]; bf16_t* rowp = base + (size_t)row * 512 + col0;
#pragma unroll
                    for (int bj = 0; bj < 2; ++bj) { const f32x4 v0 = __builtin_convertvector(acc[ai][bj][m][0], f32x4) * sb[bj][0] * sa, v1 = __builtin_convertvector(acc[ai][bj][m][1], f32x4) * sb[bj][1] * sa;
                        u32x2 w; w.x = cvt_pk_bf16(v0[0] * v0[1], v0[2] * v0[3]); w.y = cvt_pk_bf16(v1[0] * v1[1], v1[2] * v1[3]);
                        *(u32x2*)(rowp + bj * 16) = w; } }
        } else if (pn < 12) {
            bf16_t* base = proj + (size_t)(pn >> 1) * ((size_t)M_TOK * 512); const int col0 = (pn & 1) * 256 + wc * 64 + 8 * fq;
            const bool tn = pn >= 6; unsigned char* tbase = (unsigned char*)base + (size_t)((u.pm * 2 + (pn & 1)) * 8 + wr * 4 + wc) * 16384 + (fq * 16 + fr) * 16;
#pragma unroll
            for (int ai = 0; ai < 2; ++ai)
#pragma unroll
                for (int m = 0; m < 4; ++m) { const int row = row0 + ai * HALF + m * 16; const float sa = sA[row]; bf16_t* rowp = base + (size_t)row * 512 + col0;
#pragma unroll
                    for (int bj = 0; bj < 2; ++bj) { const f32x4 v0 = __builtin_convertvector(acc[ai][bj][m][0], f32x4) * sb[bj][0] * sa, v1 = __builtin_convertvector(acc[ai][bj][m][1], f32x4) * sb[bj][1] * sa;
                        u32x4 w; w.x = cvt_pk_bf16(v0[0], v0[1]); w.y = cvt_pk_bf16(v0[2], v0[3]); w.z = cvt_pk_bf16(v1[0], v1[1]); w.w = cvt_pk_bf16(v1[2], v1[3]);
                        *(u32x4*)(tn ? (void*)(tbase + ((ai * 4 + m) * 2 + bj) * 1024) : (void*)(rowp + bj * 32)) = w; } }
        } else {
            unsigned char* base = (unsigned char*)proj + (size_t)6 * M_TOK * 512 * 2 + (size_t)((pn - 12) >> 2) * ((size_t)M_TOK * 1024 * 2) + ((size_t)(u.pm * 4 + ((pn - 12) & 3)) * 65536 + (wr * 4 + wc) * 8192 + (fq * 16 + fr) * 8);
#pragma unroll
            for (int ai = 0; ai < 2; ++ai) { int r0 = row0; asm volatile("" : "+v"(r0));
#pragma unroll
                for (int m = 0; m < 4; ++m) { const int row = r0 + ai * HALF + m * 16; const float sa = sA[row] * (-LOG2E); unsigned char* rowp = base + (ai * 4 + m) * 1024;
#pragma unroll
                    for (int bj = 0; bj < 2; ++bj) { const f32x4 v0 = __builtin_convertvector(acc[ai][bj][m][0], f32x4) * sb[bj][0] * sa - 7.994353436858858f, v1 = __builtin_convertvector(acc[ai][bj][m][1], f32x4) * sb[bj][1] * sa - 7.994353436858858f;
                        u32x2 w; w.x = q8n(v0[0]) | (q8n(v0[1]) << 8) | (q8n(v0[2]) << 16) | (q8n(v0[3]) << 24); w.y = q8n(v1[0]) | (q8n(v1[1]) << 8) | (q8n(v1[2]) << 16) | (q8n(v1[3]) << 24);
                        *(u32x2*)(rowp + bj * 512) = w; } } }
        }
    }
};
struct EpiGUI8 {
    static constexpr bool PERM = true, AFTER_DRAIN = false, DUAL = false, I8 = true, GATHER = true, FP8 = false; typedef i32x4 acc_t;
    bf16_t* H; const PG8_LAS float* sAtab; const char* sBbase; size_t estride;
    __device__ __forceinline__ void operator()(const i32x4 (&acc)[2][2][4][2], const Unit& u, int wr, int wc, int fr, int fq) const {
        const int rl0 = wr * 64 + fr, row0 = u.pm * BM + rl0, hcol0 = u.pn * 128 + wc * 32 + 4 * fq, bcol0 = u.pn * BM + wc * 64 + 8 * fq;
        const float* sB = (const float*)(sBbase + (size_t)u.pe * estride);
        f32x4 sb[2][2];
#pragma unroll
        for (int bj = 0; bj < 2; ++bj)
#pragma unroll
            for (int n = 0; n < 2; ++n) sb[bj][n] = *(const f32x4*)(sB + bcol0 + bj * 32 + 4 * n);
#pragma unroll
        for (int ai = 0; ai < 2; ++ai)
#pragma unroll
            for (int m = 0; m < 4; ++m) { const int row = row0 + ai * HALF + m * 16; const float sa = sAtab[u.ui * 256 + rl0 + ai * HALF + m * 16]; unsigned char* rowp = (unsigned char*)H + (size_t)row * FFD + hcol0;
#pragma unroll
                for (int bj = 0; bj < 2; ++bj) { const f32x4 v0 = __builtin_convertvector(acc[ai][bj][m][0], f32x4) * sb[bj][0] * sa, v1 = __builtin_convertvector(acc[ai][bj][m][1], f32x4) * sb[bj][1] * sa;
                    const float h0 = v0[0] * sigmoidf_fast(v0[0]) * v0[1], h1 = v0[2] * sigmoidf_fast(v0[2]) * v0[3], h2 = v1[0] * sigmoidf_fast(v1[0]) * v1[1], h3 = v1[2] * sigmoidf_fast(v1[2]) * v1[3];
                    int w = f8pk(h0 * 8.0f, h1 * 8.0f, 0, false); w = f8pk(h2 * 8.0f, h3 * 8.0f, w, true);
                    *(int*)(rowp + bj * 16) = w; } }
    }
};
template <class Epi, class Sched, bool ALIGN_EPI = false, bool SP2 = false>
__device__ __forceinline__ void gemm_phase(PG8_LAS unsigned char* lds, const Gemm g, const Sched& S, const Epi& E) {
    int tid_ = threadIdx.x; asm volatile("" : "+v"(tid_)); const int tid = tid_, wid = __builtin_amdgcn_readfirstlane(tid >> 6), lane = tid & 63, wr = wid >> 2, wc = wid & 3, fr = lane & 15, fq = lane >> 4;
    const int Kp = Epi::DUAL ? g.K / 2 : g.K  , pitchB = (Epi::I8 || Epi::FP8) ? Kp : 2 * Kp  , nt = ((Epi::I8 || Epi::FP8) ? g.K : 2 * g.K) / 128  , nt1 = Epi::DUAL ? nt / 2 : nt;
    unsigned voffA[2], voffB[2];
#pragma unroll
    for (int i = 0; i < 2; ++i) { int R, C; stage_rc(tid * 16 + i * 8192, R, C); const int Rb = Epi::PERM ? ((R >> 5) * 64 + perm32(R & 31)) : (R >> 5) * 64 + (R & 31);
        voffA[i] = (unsigned)(R * pitchB + 2 * C); voffB[i] = (unsigned)(Rb * pitchB + 2 * C); }
    const size_t kstep = (size_t)(BK * 2);
    const size_t hstep = (size_t)HALF * pitchB;
    const size_t tstep = 2 * hstep;
    const size_t hstepB = (size_t)32 * pitchB;
    const size_t hstepA = Epi::GATHER ? 0 : hstep;
    const unsigned ldsw = (unsigned)wid * 1024u;
    const int aoff = Epi::FP8 ? lds_byte(wr * 64 + fr, fq * 16) : lds_byte(wr * 64 + fr, fq * 8), boff = Epi::FP8 ? lds_byte(wc * 32 + fr, fq * 16) : lds_byte(wc * 32 + fr, fq * 8);
    constexpr int KSUB = Epi::FP8 ? 16 : 1024;
#define PG8_SA(b, h) (((b) * 2 + (h)) * HTB)
#define PG8_SB(b, h) ((4 + (b) * 2 + (h)) * HTB)
#define PG8_STAGE(bufoff, gbase, voff) do { _Pragma("unroll") for (int _i = 0; _i < 2; ++_i) \
        __builtin_amdgcn_global_load_lds((const unsigned*)((const char*)(gbase) + (voff)[_i]), (PG8_LAS unsigned*)(lds + (bufoff) + ldsw + _i * 8192), 16, 0, 0); } while (0)
#define PG8_LDA(dst, b, h) do { _Pragma("unroll") for (int m = 0; m < 4; ++m) _Pragma("unroll") for (int k = 0; k < 2; ++k) dst[m][k] = *(const PG8_LAS bf16x8*)(lds + PG8_SA(b, h) + aoff + m * 2048 + k * KSUB); } while (0)
#define PG8_LDB(dst, b, h) do { _Pragma("unroll") for (int n = 0; n < 2; ++n) _Pragma("unroll") for (int k = 0; k < 2; ++k) dst[n][k] = *(const PG8_LAS bf16x8*)(lds + PG8_SB(b, h) + boff + n * 2048 + k * KSUB); } while (0)
#define PG8_MMA(ai, bj, At, Bt) do { __builtin_amdgcn_s_setprio(1); _Pragma("unroll") for (int m = 0; m < 4; ++m) _Pragma("unroll") for (int n = 0; n < 2; ++n) _Pragma("unroll") for (int k = 0; k < 2; ++k) \
        { if constexpr (Epi::FP8) { if (k == 0) acc[ai][bj][m][n] = mma_f8<Epi::F8_SCALE_B, Epi::F8_SCALE_A>(Bt[n][0], Bt[n][1], At[m][0], At[m][1], acc[ai][bj][m][n]); } else acc[ai][bj][m][n] = mma16(Bt[n][k], At[m][k], acc[ai][bj][m][n]); } __builtin_amdgcn_s_setprio(0); } while (0)
#define PG8_WAIT_V(n) asm volatile("s_waitcnt vmcnt(" #n ")" ::: "memory")
#define PG8_WAIT_L(n) asm volatile("s_waitcnt lgkmcnt(" #n ")" ::: "memory")
#define PG8_BAR __builtin_amdgcn_s_barrier()
#define PG8_SCHED __builtin_amdgcn_sched_barrier(0)
    Unit cur, nxt; int ui = 0;
    if (!S.next(0, cur)) return;
    typename Epi::acc_t acc[2][2][4][2];
#pragma unroll
    for (int a = 0; a < 2; ++a)
#pragma unroll
        for (int b = 0; b < 2; ++b)
#pragma unroll
            for (int m = 0; m < 4; ++m)
#pragma unroll
                for (int n = 0; n < 2; ++n) acc[a][b][m][n] = typename Epi::acc_t{};
    bf16x8 At[4][2], B0[2][2], B1[2][2];
    int gR[2], gC[2];
#pragma unroll
    for (int i = 0; i < 2; ++i) stage_rc(tid * 16 + i * 8192, gR[i], gC[i]);
    unsigned vA0[2], vA1[2], nA0[2], nA1[2];
#pragma unroll
    for (int i = 0; i < 2; ++i) { if constexpr (Epi::GATHER) { vA0[i] = (unsigned)(g.rowtab[cur.ui * 256 + gR[i]] * pitchB + 2 * gC[i]); vA1[i] = (unsigned)(g.rowtab[cur.ui * 256 + 128 + gR[i]] * pitchB + 2 * gC[i]); } else { vA0[i] = voffA[i]; vA1[i] = voffA[i]; } nA0[i] = vA0[i]; nA1[i] = vA1[i]; }
    const char* cA = Epi::GATHER ? (const char*)g.A : (const char*)g.A + (size_t)cur.pm * tstep; const char* cB = (const char*)g.Bt + (size_t)cur.pe * g.estride + (size_t)cur.pn * tstep;
    const char* cA2 = Epi::DUAL ? (const char*)g.A2 + (size_t)cur.pm * tstep : cA; const char* cB2 = Epi::DUAL ? (const char*)g.Bt2 + (size_t)cur.pn * tstep : cB;
    S.a_ready(cur);
    if constexpr (SP2) {
        PG8_STAGE(PG8_SB(0, 0), cB, voffB); PG8_STAGE(PG8_SB(0, 1), cB + hstepB, voffB); PG8_STAGE(PG8_SA(0, 0), cA, vA0); PG8_STAGE(PG8_SA(0, 1), cA + hstepA, vA1);
        if (wr == 1) PG8_BAR;
        PG8_WAIT_V(2); PG8_BAR;
        PG8_STAGE(PG8_SB(1, 0), cB + kstep, voffB); PG8_STAGE(PG8_SA(1, 0), cA + kstep, vA0); PG8_STAGE(PG8_SB(1, 1), cB + hstepB + kstep, voffB);
        PG8_WAIT_V(6); PG8_BAR;
    } else {
        PG8_STAGE(PG8_SB(0, 0), cB, voffB); PG8_STAGE(PG8_SA(0, 0), cA, vA0); PG8_STAGE(PG8_SB(0, 1), cB + hstepB, voffB); PG8_STAGE(PG8_SA(0, 1), cA + hstepA, vA1);
        if (wr == 1) PG8_BAR;
        PG8_WAIT_V(4); PG8_BAR;
        PG8_STAGE(PG8_SB(1, 0), cB + kstep, voffB); PG8_STAGE(PG8_SA(1, 0), cA + kstep, vA0); PG8_STAGE(PG8_SB(1, 1), cB + hstepB + kstep, voffB);
        PG8_WAIT_V(6); PG8_BAR;
    }
    for (;;) {
        const bool has_next = S.next(ui + 1, nxt);
        if constexpr (Epi::GATHER) { if (has_next) {
#pragma unroll
            for (int i = 0; i < 2; ++i) { nA0[i] = (unsigned)(g.rowtab[nxt.ui * 256 + gR[i]] * pitchB + 2 * gC[i]); nA1[i] = (unsigned)(g.rowtab[nxt.ui * 256 + 128 + gR[i]] * pitchB + 2 * gC[i]); } } }
        const char* nA = Epi::GATHER ? cA : (has_next ? (const char*)g.A + (size_t)nxt.pm * tstep : cA); const char* nB = has_next ? (const char*)g.Bt + (size_t)nxt.pe * g.estride + (size_t)nxt.pn * tstep : cB;
        for (int t = 0; t < nt; t += 2) {
            const bool last = (t == nt - 2);
            if constexpr (Epi::DUAL) { if (t == nt1) E.mid(acc, cur, wr, wc, fr, fq); }
            const char* a1 = (t < nt1) ? cA + (size_t)(t + 1) * kstep : cA2 + (size_t)(t + 1 - nt1) * kstep;
            const char* a2 = last ? nA : ((t + 2 < nt1) ? cA + (size_t)(t + 2) * kstep : cA2 + (size_t)(t + 2 - nt1) * kstep); const char* b2 = last ? nB : ((t + 2 < nt1) ? cB + (size_t)(t + 2) * kstep : cB2 + (size_t)(t + 2 - nt1) * kstep);
            const char* a3 = a2 + kstep; const char* b3 = b2 + kstep;
            unsigned wA0[2], wA1[2];
#pragma unroll
            for (int i = 0; i < 2; ++i) { wA0[i] = (Epi::GATHER && last) ? nA0[i] : vA0[i]; wA1[i] = (Epi::GATHER && last) ? nA1[i] : vA1[i]; }
            if (last && has_next) S.a_ready(nxt);
            if constexpr (SP2) {
            PG8_LDB(B0, 0, 0); PG8_LDB(B1, 0, 1); PG8_SCHED; PG8_LDA(At, 0, 0); PG8_STAGE(PG8_SA(1, 1), a1 + hstepA, vA1);
            PG8_WAIT_V(8); PG8_WAIT_L(0); PG8_BAR; PG8_MMA(0, 0, At, B0); PG8_MMA(0, 1, At, B1); PG8_BAR; PG8_SCHED;
            PG8_LDA(At, 0, 1); PG8_STAGE(PG8_SB(0, 0), b2, voffB); PG8_STAGE(PG8_SB(0, 1), b2 + hstepB, voffB); PG8_STAGE(PG8_SA(0, 0), a2, wA0);
            PG8_WAIT_V(8); PG8_WAIT_L(0); PG8_BAR; PG8_MMA(1, 0, At, B0); PG8_MMA(1, 1, At, B1); PG8_BAR; PG8_SCHED;
            PG8_LDB(B0, 1, 0); PG8_LDB(B1, 1, 1); PG8_SCHED; PG8_LDA(At, 1, 0); PG8_STAGE(PG8_SA(0, 1), a2 + hstepA, wA1);
            PG8_WAIT_V(8); PG8_WAIT_L(0); PG8_BAR; PG8_MMA(0, 0, At, B0); PG8_MMA(0, 1, At, B1); PG8_BAR; PG8_SCHED;
            PG8_LDA(At, 1, 1); PG8_STAGE(PG8_SB(1, 0), b3, voffB); PG8_STAGE(PG8_SB(1, 1), b3 + hstepB, voffB); PG8_STAGE(PG8_SA(1, 0), a3, wA0);
            PG8_WAIT_V(8); PG8_WAIT_L(0); PG8_BAR; PG8_MMA(1, 0, At, B0); PG8_MMA(1, 1, At, B1); PG8_BAR; PG8_SCHED;
            } else {
            PG8_LDB(B0, 0, 0); PG8_SCHED; PG8_LDA(At, 0, 0); PG8_STAGE(PG8_SA(1, 1), a1 + hstepA, vA1);
            PG8_WAIT_L(8); PG8_BAR; PG8_WAIT_L(0); PG8_MMA(0, 0, At, B0); PG8_BAR; PG8_SCHED;
            PG8_LDB(B1, 0, 1); PG8_STAGE(PG8_SB(0, 0), b2, voffB);
            PG8_BAR; PG8_WAIT_L(0); PG8_MMA(0, 1, At, B1); PG8_BAR;
            PG8_LDA(At, 0, 1); PG8_STAGE(PG8_SA(0, 0), a2, wA0);
            PG8_BAR; PG8_WAIT_L(0); PG8_MMA(1, 0, At, B0); PG8_BAR; PG8_SCHED;
            PG8_STAGE(PG8_SB(0, 1), b2 + hstepB, voffB);
            PG8_WAIT_V(6); PG8_BAR; PG8_MMA(1, 1, At, B1); PG8_BAR;
            PG8_LDB(B0, 1, 0); PG8_SCHED; PG8_LDA(At, 1, 0); PG8_STAGE(PG8_SA(0, 1), a2 + hstepA, wA1);
            PG8_WAIT_L(8); PG8_BAR; PG8_WAIT_L(0); PG8_MMA(0, 0, At, B0); PG8_BAR; PG8_SCHED;
            PG8_LDB(B1, 1, 1); PG8_STAGE(PG8_SB(1, 0), b3, voffB);
            PG8_BAR; PG8_WAIT_L(0); PG8_MMA(0, 1, At, B1); PG8_BAR;
            PG8_LDA(At, 1, 1); PG8_STAGE(PG8_SA(1, 0), a3, wA0);
            PG8_BAR; PG8_WAIT_L(0); PG8_MMA(1, 0, At, B0); PG8_BAR; PG8_SCHED;
            PG8_STAGE(PG8_SB(1, 1), b3 + hstepB, voffB);
            PG8_WAIT_V(6); PG8_BAR; PG8_MMA(1, 1, At, B1); PG8_BAR;
            }
        }
        if constexpr (ALIGN_EPI) { if (wr == 0) PG8_BAR; }
        if constexpr (Epi::FP8) asm volatile("s_nop 15\n\ts_nop 15" ::: "memory");
        if constexpr (!Epi::AFTER_DRAIN) { E(acc, cur, wr, wc, fr, fq); S.done(cur); }
        if (!has_next) break;
#pragma unroll
        for (int a = 0; a < 2; ++a)
#pragma unroll
            for (int b = 0; b < 2; ++b)
#pragma unroll
                for (int m = 0; m < 4; ++m)
#pragma unroll
                    for (int n = 0; n < 2; ++n) acc[a][b][m][n] = typename Epi::acc_t{};
        cur = nxt; cA = nA; cB = nB; ++ui;
#pragma unroll
        for (int i = 0; i < 2; ++i) { vA0[i] = nA0[i]; vA1[i] = nA1[i]; }
        if constexpr (Epi::DUAL) { cA2 = (const char*)g.A2 + (size_t)cur.pm * tstep; cB2 = (const char*)g.Bt2 + (size_t)cur.pn * tstep; }
        if constexpr (ALIGN_EPI) { if (wr == 1) PG8_BAR; }
    }
    PG8_WAIT_V(0);
    if constexpr (!ALIGN_EPI) { if (wr == 0) PG8_BAR; }
    PG8_BAR;
    if constexpr (Epi::AFTER_DRAIN) { E.fused(acc, cur, wr, wc, fr, fq, lds, wid, lane); S.done(cur); }
#undef PG8_SA
#undef PG8_SB
#undef PG8_STAGE
#undef PG8_LDA
#undef PG8_LDB
#undef PG8_MMA
#undef PG8_WAIT_V
#undef PG8_WAIT_L
#undef PG8_BAR
#undef PG8_SCHED
}
}

namespace sba {
using bf16x8 = __attribute__((ext_vector_type(8))) short;
using s16x4 = __attribute__((ext_vector_type(4))) short;
using f32x16 = __attribute__((ext_vector_type(16))) float;
typedef unsigned short bf16_t;
constexpr int PITCH = 512, QB = 256, KVBLK = 64, SLOTB = 8192;
constexpr int LDS_FLAGS = 8 * SLOTB, LDS_BYTES = 8 * SLOTB + 64;
constexpr float R_DONE = -40.0f;
typedef __attribute__((address_space(3))) const char* lds_cptr;
typedef short v4i16_t __attribute__((ext_vector_type(4)));
#define SBA_MFMA(a, b, c) __builtin_amdgcn_mfma_f32_32x32x16_bf16(a, b, c, 0, 0, 0)
__device__ __forceinline__ int crow(int r, int hi) { return (r & 3) + 8 * (r >> 2) + 4 * hi; }
__device__ __forceinline__ void glds16(const void* gsrc, unsigned lds_dst) { unsigned keep;
    asm volatile("s_mov_b32 %0, m0\n\ts_mov_b32 m0, %2\n\ts_nop 0\n\tglobal_load_lds_dwordx4 %1, off\n\ts_mov_b32 m0, %0" : "=&s"(keep) : "v"(gsrc), "s"(lds_dst) : "memory"); }
typedef float f32x2_t __attribute__((ext_vector_type(2))); typedef __bf16 bf16x2_t __attribute__((ext_vector_type(2)));
__device__ __forceinline__ unsigned cvtpk(float lo, float hi) { f32x2_t v = {lo, hi}; bf16x2_t b = __builtin_convertvector(v, bf16x2_t); return __builtin_bit_cast(unsigned, b); }
__device__ __forceinline__ s16x4 vtr(lds_cptr p) { return __builtin_bit_cast(s16x4, __builtin_amdgcn_ds_read_tr16_b64_v4i16((__attribute__((address_space(3))) v4i16_t*)p)); }
__device__ __forceinline__ bf16x8 pack8(const f32x16& v, int b0) {
    typedef unsigned u32x4 __attribute__((ext_vector_type(4)));
    u32x4 w; w.x = cvtpk(v[b0], v[b0 + 1]); w.y = cvtpk(v[b0 + 2], v[b0 + 3]); w.z = cvtpk(v[b0 + 4], v[b0 + 5]); w.w = cvtpk(v[b0 + 6], v[b0 + 7]); return __builtin_bit_cast(bf16x8, w); }

__device__ __forceinline__ float vmin(float a, float b) { return __builtin_amdgcn_fmed3f(a, -3.0e38f, b); }
template <bool DIAG> __device__ __forceinline__ void tile(f32x16 (&o)[2], f32x16& R, const bf16x8 (&qr)[4], const bf16x8 (&tri)[2], const bf16x8 ones, lds_cptr kp, lds_cptr vp, int qrel, int hi) {
    f32x16 z0 = {}, z1 = {};
#pragma unroll
    for (int d0 = 0; d0 < 4; ++d0) {
        const bf16x8 k0 = *(const __attribute__((address_space(3))) bf16x8*)(kp + d0 * 2048);
        const bf16x8 k1 = *(const __attribute__((address_space(3))) bf16x8*)(kp + d0 * 2048 + 512);
        z0 = SBA_MFMA(k0, qr[d0], z0); z1 = SBA_MFMA(k1, qr[d0], z1); }
    f32x16 sp;
#pragma unroll
    for (int r = 0; r < 16; ++r) { const float zc = vmin(z1[r], 126.0f); float s = __builtin_amdgcn_logf(1.0f + __builtin_amdgcn_exp2f(zc));
        if (DIAG) { if (!(32 + crow(r, hi) < qrel)) s = 0.f; }
        sp[r] = s; z1[r] = (zc - s) + R[r]; }
    const bf16x8 x1a = pack8(sp, 0), x1b = pack8(sp, 8);
    f32x16 S = SBA_MFMA(ones, x1a, R); S = SBA_MFMA(ones, x1b, S);
    z1 = SBA_MFMA(tri[0], x1a, z1); z1 = SBA_MFMA(tri[1], x1b, z1);
#pragma unroll
    for (int r = 0; r < 16; ++r) { const float zc = vmin(z0[r], 126.0f); float s = __builtin_amdgcn_logf(1.0f + __builtin_amdgcn_exp2f(zc));
        if (DIAG) { if (!(crow(r, hi) < qrel)) s = 0.f; }
        sp[r] = s; z0[r] = (zc - s) + S[r]; }
    const bf16x8 x0a = pack8(sp, 0), x0b = pack8(sp, 8);
    z0 = SBA_MFMA(tri[0], x0a, z0); z0 = SBA_MFMA(tri[1], x0b, z0);
    R = SBA_MFMA(ones, x0a, S); R = SBA_MFMA(ones, x0b, R);
#pragma unroll
    for (int r = 0; r < 16; ++r) { float a0 = __builtin_amdgcn_exp2f(z0[r]), a1 = __builtin_amdgcn_exp2f(z1[r]);
        if (DIAG) { if (!(crow(r, hi) < qrel)) a0 = 0.f; if (!(32 + crow(r, hi) < qrel)) a1 = 0.f; }
        z0[r] = a0; z1[r] = a1; }
    const bf16x8 p0 = pack8(z0, 0), p1 = pack8(z0, 8), p2 = pack8(z1, 0), p3 = pack8(z1, 8);
#pragma unroll
    for (int d0 = 0; d0 < 2; ++d0) {
        s16x4 lo[4], hh[4];
#pragma unroll
        for (int ks = 0; ks < 4; ++ks) { lo[ks] = vtr(vp + d0 * 4096 + ks * 1024); hh[ks] = vtr(vp + d0 * 4096 + ks * 1024 + 512); }
#define SBA_PK(k) (bf16x8){lo[k][0], lo[k][1], lo[k][2], lo[k][3], hh[k][0], hh[k][1], hh[k][2], hh[k][3]}
        o[d0] = SBA_MFMA(p0, SBA_PK(0), o[d0]); o[d0] = SBA_MFMA(p1, SBA_PK(1), o[d0]); o[d0] = SBA_MFMA(p2, SBA_PK(2), o[d0]); o[d0] = SBA_MFMA(p3, SBA_PK(3), o[d0]);
#undef SBA_PK
    }
}

#define SBA_WAIT_BAR() asm volatile("s_waitcnt vmcnt(0) lgkmcnt(0)\n\ts_barrier" ::: "memory")
__device__ __forceinline__ void attn_unit(int b, int h, int qb, const bf16_t* Q, const bf16_t* K, const bf16_t* V, bf16_t* O, char* shm) {
    int tid_ = threadIdx.x; asm volatile("" : "+v"(tid_)); const int tid = tid_, lane = tid & 63, r32 = lane & 31, hi = lane >> 5; const int wid = __builtin_amdgcn_readfirstlane(tid >> 6);
    const int grp = wid >> 2, w4 = wid & 3, rb = grp ? (w4 ^ 2) : w4;
    const long rowbase = (long)b * SEQ; const int q0 = qb * QB + grp * 128;
    const int hconst = (h >> 2) * 131072 + (h & 3) * 16384;
    const char* Qb = (const char*)Q + (long)(b * 32 + qb) * 262144 + hconst + (rb >> 1) * 65536 + ((grp * 4 + (rb & 1) * 2 + (r32 >> 4)) * 2) * 1024 + (r32 & 15) * 16;
    const unsigned lds0 = (unsigned)(uintptr_t)shm + (unsigned)grp * (4 * SLOTB);
    const char* Kt = (const char*)K + (long)b * 32 * 262144 + hconst; const char* Vt = (const char*)V + (long)b * 32 * 262144 + hconst;
    const int kc0 = 2 * w4, kc1 = 2 * w4 + 1;
    const char* ksrc0 = Kt + (kc0 >> 2) * 1024 + (lane >> 4) * 2048 + ((kc0 & 3) * 16 + (lane & 15)) * 16;
    const char* ksrc1 = Kt + (kc1 >> 2) * 1024 + (lane >> 4) * 2048 + ((kc1 & 3) * 16 + (lane & 15)) * 16;
    const int p0 = 2 * w4, p1 = 2 * w4 + 1;
    const char* vsrc0 = Vt + (p0 >> 2) * 1024 + (p0 & 3) * 2048 + ((lane & 3) * 16 + (lane >> 2)) * 16;
    const char* vsrc1 = Vt + (p1 >> 2) * 1024 + (p1 & 3) * 2048 + ((lane & 3) * 16 + (lane >> 2)) * 16;
    const unsigned kdst = lds0 + p0 * 1024, vdst = lds0 + 2 * SLOTB + p0 * 1024;
#define SBA_DMA(t, slot) do { const long go_ = (long)((t) >> 2) * 262144 + ((t) & 1) * 65536 + (((t) >> 1) & 1) * 8192;     \
        glds16(ksrc0 + go_, (unsigned)__builtin_amdgcn_readfirstlane(kdst + (slot))); glds16(ksrc1 + go_, (unsigned)__builtin_amdgcn_readfirstlane(kdst + 1024 + (slot))); \
        glds16(vsrc0 + go_, (unsigned)__builtin_amdgcn_readfirstlane(vdst + (slot))); glds16(vsrc1 + go_, (unsigned)__builtin_amdgcn_readfirstlane(vdst + 1024 + (slot))); } while (0)
    const lds_cptr shm3 = (lds_cptr)shm + grp * (4 * SLOTB);
    const lds_cptr kp0 = shm3 + hi * 1024 + r32 * 16;
    const lds_cptr vp0 = shm3 + 2 * SLOTB + ((lane >> 4) & 1) * 32 + (lane & 3) * 8 + (4 * hi + ((lane & 15) >> 2)) * 64;
    volatile __attribute__((address_space(3))) unsigned* flags = (volatile __attribute__((address_space(3))) unsigned*)((lds_cptr)shm + LDS_FLAGS);
    const int jtop = (q0 + 128) / KVBLK - 1, jd = q0 / KVBLK + (rb >> 1), qrel = 32 * (rb & 1) + r32;
    SBA_DMA(jtop, 0);
    bf16x8 qr[4];
#pragma unroll
    for (int d0 = 0; d0 < 4; ++d0) qr[d0] = *reinterpret_cast<const bf16x8*>(Qb + (d0 >> 1) * 1024 + ((d0 & 1) * 2 + hi) * 256);
    bf16x8 tri[2]; bf16x8 ones;
#pragma unroll
    for (int s = 0; s < 2; ++s)
#pragma unroll
        for (int j = 0; j < 8; ++j) tri[s][j] = ((16 * s + 8 * (j >> 2) + 4 * hi + (j & 3)) > r32) ? (short)0xBF80 : (short)0;
#pragma unroll
    for (int j = 0; j < 8; ++j) ones[j] = (short)0xBF80;
    f32x16 o[2]; o[0] = f32x16{}; o[1] = f32x16{}; f32x16 R = f32x16{};
    bool mydone = false;
    const int nsteps = (qb * QB + QB) / KVBLK;
    for (int it = 0; it < nsteps; ++it) {
        const int j = jtop - it;
        SBA_WAIT_BAR();
        if (it > 0) { const int pf = ((it - 1) & 1) * 8; unsigned all = 1u;
#pragma unroll
            for (int w = 0; w < 8; ++w) all &= flags[pf + w];
            if (__builtin_amdgcn_readfirstlane(all)) break; }
        const int cur = (it & 1) * SLOTB, oth = SLOTB - cur;
        if (j > 0) SBA_DMA(j - 1, oth);
        if (!mydone && j >= 0 && j <= jd) {
            if (j == jd) tile<true>(o, R, qr, tri, ones, kp0 + cur, vp0 + cur, qrel, hi);
            else tile<false>(o, R, qr, tri, ones, kp0 + cur, vp0 + cur, qrel, hi);
            mydone = __all(R[0] < R_DONE) != 0;
        }
        if (lane == 0) flags[(it & 1) * 8 + wid] = (mydone || j <= 0) ? 1u : 0u;
    }
    SBA_WAIT_BAR();
    unsigned char* Ow = (unsigned char*)O + (rowbase + q0 + rb * 32) * ATT_W + h * HDIM;
#pragma unroll
    for (int r = 0; r < 16; ++r) { const int orow = crow(r, hi);
#pragma unroll
        for (int d0 = 0; d0 < 2; ++d0) { const int w = pg8::f8pk(o[d0][r] * 2.0f, 0.f, 0, false); Ow[(long)orow * ATT_W + d0 * 32 + r32] = (unsigned char)(w & 0xff); } }
#undef SBA_DMA
}
#undef SBA_WAIT_BAR
#undef SBA_MFMA
}


constexpr size_t MiB = 1u << 20, KiB = 1u << 10;
constexpr size_t WS_CTL = 0, CTL_ZERO_BYTES = 64 * KiB;
constexpr size_t WS_TAB = 1 * MiB;
constexpr size_t TB_MOD = WS_TAB;
constexpr size_t TB_HIST = WS_TAB + 192 * KiB;
constexpr size_t TB_TILE = WS_TAB + 208 * KiB;
constexpr size_t TB_EIDX = WS_TAB + 256 * KiB;
constexpr size_t TB_GATE = WS_TAB + 512 * KiB;
constexpr size_t TB_SLOT = WS_TAB + 768 * KiB;
constexpr size_t TB_WRS = WS_TAB + 1024 * KiB;
constexpr int WR_PITCH = 1032;
constexpr size_t TB_STAMP = WS_TAB + 1400 * KiB;
constexpr size_t TB_PAR = WS_TAB + 1408 * KiB;
constexpr int PAR_WCONV = 0, PAR_LN1G = PAR_WCONV + DEPTH * 3 * CONV_CH, PAR_LN1B = PAR_LN1G + DEPTH * DM, PAR_LN2G = PAR_LN1B + DEPTH * DM, PAR_LN2B = PAR_LN2G + DEPTH * DM,
              PAR_BR = PAR_LN2B + DEPTH * DM, PAR_WR = PAR_BR + NEXP, PAR_TOTAL = PAR_WR + DM * NEXP;
static_assert(TB_PAR + (size_t)PAR_TOTAL * 4 <= 3 * MiB, "tables");
constexpr size_t WS_W = 3 * MiB;
constexpr size_t W_IN = WS_W, W_IN_L = (size_t)IN_W * DM * 2;
constexpr size_t W_A = W_IN + DEPTH * W_IN_L, W_A_L = (size_t)DM * CONV_CH * 2;
constexpr size_t W_B = W_A + DEPTH * W_A_L, W_B_L = W_A_L;
constexpr size_t W_O = W_B + DEPTH * W_B_L, W_O_L = (size_t)DM * DM * 2;
constexpr size_t W_GU = W_O + DEPTH * W_O_L, W_GU_E = (size_t)2 * FFD * DM * 2;
constexpr size_t W_DN = W_GU + (size_t)DEPTH * NEXP * W_GU_E, W_DN_E = (size_t)DM * FFD * 2;
constexpr size_t W_IN_SC = 6 * MiB;
constexpr size_t W_GU_SC = 1 * MiB + 64 * KiB;
constexpr size_t ACT_SU = 33 * MiB;
constexpr size_t ACT_LIST = 34 * MiB;
constexpr size_t WS_ACT = W_DN + (size_t)DEPTH * NEXP * W_DN_E;
constexpr size_t WS_PROJ = WS_ACT + (size_t)M_TOK * DM * 2;
constexpr size_t PJ_T512 = (size_t)M_TOK * 512 * 2, PJ_GA = 6 * PJ_T512, PJ_GB = PJ_GA + (size_t)M_TOK * DM * 2;
constexpr size_t PJ_XS = 0, PJ_HS = (size_t)PMAX * DM * 2;
constexpr size_t PJ_SXS = 69 * MiB;
constexpr size_t WS_END = WS_PROJ + (size_t)M_TOK * IN_W * 2;
static_assert(WS_ACT == 127 * MiB && WS_END == 511 * MiB, "d_ws map");
static_assert(PJ_HS + (size_t)PMAX * FFD * 2 <= (size_t)M_TOK * IN_W * 2, "MoE overlay fits the proj region");
constexpr int CW_BAR = 4096;
constexpr int CW_MODCNT = 1536;
constexpr int CW_GCNT = 1024;

constexpr int RING_OFF = 0, RING_BYTES = 131072;
constexpr int LDSCTL_OFF = RING_BYTES, MISC_OFF = LDSCTL_OFF + 320;
constexpr int GTAB_OFF = RING_BYTES + 1024;
constexpr int LDS_BYTES = 149504;
static_assert(MISC_OFF + 128 <= GTAB_OFF && GTAB_OFF + 8 * 2048 <= LDS_BYTES, "LDS map");
static_assert(7 * 17152 + 1024 <= RING_BYTES && GTAB_OFF + 17152 <= LDS_BYTES, "P0a staging regions + partial maxima avoid the control words");

#define GAS __attribute__((address_space(1)))
#define LAS __attribute__((address_space(3)))
typedef unsigned short bf16;
typedef unsigned v4u __attribute__((ext_vector_type(4)));
typedef unsigned v2u __attribute__((ext_vector_type(2)));
typedef float f32x4 __attribute__((ext_vector_type(4)));
typedef GAS unsigned gu32;
#define RLX_AGENT __ATOMIC_RELAXED, __HIP_MEMORY_SCOPE_AGENT
#define LDS_WAIT() asm volatile("s_waitcnt lgkmcnt(0)" ::: "memory")
#define VM_WAIT() asm volatile("s_waitcnt vmcnt(0)" ::: "memory")
__device__ __forceinline__ unsigned f2bf(float f) { unsigned u = __builtin_bit_cast(unsigned, f); return (u + 0x7fffu + ((u >> 16) & 1u)) >> 16; }
typedef float f32x2_r __attribute__((ext_vector_type(2))); typedef __bf16 bf16x2_r __attribute__((ext_vector_type(2)));
__device__ __forceinline__ unsigned pk2(float lo, float hi) { f32x2_r v = {lo, hi}; return __builtin_bit_cast(unsigned, __builtin_convertvector(v, bf16x2_r)); }
__device__ __forceinline__ float bflo(unsigned w) { return __uint_as_float(w << 16); }
__device__ __forceinline__ float bfhi(unsigned w) { return __uint_as_float(w & 0xffff0000u); }


#define XB_TMO      128
#define XB_XCNT(j)  (256  + 64 * (j))
#define XB_XSUB(j)  (1280 + 64 * (j))
#define XB_XGEN(j)  (2304 + 64 * (j))
#define XB_TOP      3328
#define XB_TOPGEN   3392
#define XCD_BAR_WORDS 3456
#define XB_SPIN_CAP (1u << 18)

__device__ __forceinline__ unsigned xb_ld(unsigned* p)              { return __hip_atomic_load(p, __ATOMIC_RELAXED, __HIP_MEMORY_SCOPE_AGENT); }
__device__ __forceinline__ unsigned xb_add(unsigned* p, unsigned v) { return __hip_atomic_fetch_add(p, v, __ATOMIC_RELAXED, __HIP_MEMORY_SCOPE_AGENT); }
__device__ __forceinline__ unsigned xb_xcc_id() { return (unsigned)__builtin_amdgcn_s_getreg((3 << 11) | 20) & 0xFu; }
#define XB_SPIN(cond, bar) do { unsigned _sp = 0; while (cond) { __builtin_amdgcn_s_sleep(1); \
    if ((++_sp & 255u) == 0u) { if (xb_ld(&(bar)[XB_TMO])) break; if (_sp > XB_SPIN_CAP) { atomicAdd(&(bar)[XB_TMO], 1u); break; } } } } while (0)

struct XcdBarrier {
    unsigned* bar; unsigned x;
    volatile LAS unsigned* st;
};

__device__ __forceinline__ XcdBarrier xcd_barrier_post(unsigned* bar, volatile LAS unsigned* st) {
    XcdBarrier b; b.bar = bar; b.x = xb_xcc_id(); b.st = st;
    if (threadIdx.x == 0) (void)xb_add(&bar[XB_XCNT(b.x)], 1u);
    return b;
}
__device__ __forceinline__ void xcd_barrier_complete(unsigned* bar, unsigned x, unsigned& nloc, unsigned& nx) {
    const unsigned G = gridDim.x * gridDim.y * gridDim.z;
    unsigned sum, cnt, mine, sp = 0u;
    for (;;) {
        sum = 0u; cnt = 0u; mine = 0u;
#pragma unroll
        for (unsigned j = 0; j < 16; ++j) { const unsigned c = xb_ld(&bar[XB_XCNT(j)]); sum += c; cnt += (c > 0u) ? 1u : 0u; mine = (j == x) ? c : mine; }
        if (sum == G) break;
        __builtin_amdgcn_s_sleep(1);
        if ((++sp & 255u) == 0u) { if (xb_ld(&bar[XB_TMO])) break; if (sp > XB_SPIN_CAP) { atomicAdd(&bar[XB_TMO], 1u); break; } }
    }
    nloc = mine > 0u ? mine : 1u; nx = cnt > 0u ? cnt : 1u;
}

__device__ __forceinline__ void xcd_barrier(const XcdBarrier& b) {
    asm volatile("s_waitcnt vmcnt(0)" ::: "memory");
    __syncthreads();
    if (threadIdx.x == 0) {
        unsigned* bar = b.bar;
        __builtin_amdgcn_s_waitcnt(0);
        unsigned nloc = b.st[0], nx = b.st[1];
        if (nloc == 0u) { xcd_barrier_complete(bar, b.x, nloc, nx); b.st[0] = nloc; b.st[1] = nx; }
        const unsigned old = xb_add(&bar[XB_XSUB(b.x)], 1u);
        const unsigned gen = old / nloc;
        if (old + 1u == (gen + 1u) * nloc) {
            __builtin_amdgcn_fence(__ATOMIC_RELEASE, "agent");
            asm volatile("s_waitcnt vmcnt(0)" ::: "memory");
            const unsigned og = xb_add(&bar[XB_TOP], 1u);
            const unsigned tg = og / nx;
            if (og + 1u == (tg + 1u) * nx) xb_add(&bar[XB_TOPGEN], 1u);
            else XB_SPIN(xb_ld(&bar[XB_TOPGEN]) == tg, bar);
            __builtin_amdgcn_fence(__ATOMIC_ACQUIRE, "agent");
            xb_add(&bar[XB_XGEN(b.x)], 1u);
            asm volatile("s_waitcnt vmcnt(0)" ::: "memory");
        } else {
            XB_SPIN(xb_ld(&bar[XB_XGEN(b.x)]) == gen, bar);
            __builtin_amdgcn_fence(__ATOMIC_ACQUIRE, "agent");
            asm volatile("s_waitcnt vmcnt(0)" ::: "memory");
        }
    }
    __syncthreads();
}

#ifndef MK_PROBE
#define MK_PROBE 0
#endif
#ifndef MK_STAGGER
#define MK_STAGGER 0
#endif
#ifndef MK_DRY
#define MK_DRY 0
#endif
#ifndef MK_WGM_IN
#define MK_WGM_IN 2
#define MK_WGM_SQ 2
#endif
#ifndef MK_XBAR
#define MK_XBAR 0
#endif
#ifndef MK_REP_MASK
#define MK_REP_MASK 0
#define MK_REP_N 0
#endif
#ifndef MK_PA
#define MK_PA 0
#define MK_PB 0
#define MK_TMAX 1000
#endif

struct Frame {
    LAS unsigned char* lds;
    volatile LAS unsigned* MISC;
    gu32* ctl;
    unsigned char* ws;
    const float* x; float* out;
    int tid, lane, wave;
    int vcu, G;
};
struct Args { const float* in[18]; float* out; unsigned char* ws; int ph_lo, ph_hi; };

__device__ __forceinline__ float wave_sum(float v) {
    v += __builtin_bit_cast(float, __builtin_amdgcn_mov_dpp(__builtin_bit_cast(int, v), 0xB1, 0xf, 0xf, true));
    v += __builtin_bit_cast(float, __builtin_amdgcn_mov_dpp(__builtin_bit_cast(int, v), 0x4E, 0xf, 0xf, true));
    v += __builtin_bit_cast(float, __builtin_amdgcn_mov_dpp(__builtin_bit_cast(int, v), 0x141, 0xf, 0xf, true));
    v += __builtin_bit_cast(float, __builtin_amdgcn_mov_dpp(__builtin_bit_cast(int, v), 0x140, 0xf, 0xf, true));
    { auto r = __builtin_amdgcn_permlane16_swap(__float_as_uint(v), __float_as_uint(v), false, false); v = __uint_as_float(r[0]) + __uint_as_float(r[1]); }
    { auto r = __builtin_amdgcn_permlane32_swap(__float_as_uint(v), __float_as_uint(v), false, false); v = __uint_as_float(r[0]) + __uint_as_float(r[1]); }
    return v;
}

__device__ __forceinline__ float wave_max(float v) {
    v = fmaxf(v, __builtin_bit_cast(float, __builtin_amdgcn_mov_dpp(__builtin_bit_cast(int, v), 0xB1, 0xf, 0xf, true)));
    v = fmaxf(v, __builtin_bit_cast(float, __builtin_amdgcn_mov_dpp(__builtin_bit_cast(int, v), 0x4E, 0xf, 0xf, true)));
    v = fmaxf(v, __builtin_bit_cast(float, __builtin_amdgcn_mov_dpp(__builtin_bit_cast(int, v), 0x141, 0xf, 0xf, true)));
    v = fmaxf(v, __builtin_bit_cast(float, __builtin_amdgcn_mov_dpp(__builtin_bit_cast(int, v), 0x140, 0xf, 0xf, true)));
    { auto r = __builtin_amdgcn_permlane16_swap(__float_as_uint(v), __float_as_uint(v), false, false); v = fmaxf(__uint_as_float(r[0]), __uint_as_float(r[1])); }
    { auto r = __builtin_amdgcn_permlane32_swap(__float_as_uint(v), __float_as_uint(v), false, false); v = fmaxf(__uint_as_float(r[0]), __uint_as_float(r[1])); }
    return v;
}
__device__ __forceinline__ unsigned q4i8(float a, float b, float c, float d, float inv) {
    const unsigned y0 = __float_as_uint(__builtin_fmaf(a, inv, 12582912.0f)), y1 = __float_as_uint(__builtin_fmaf(b, inv, 12582912.0f)), y2 = __float_as_uint(__builtin_fmaf(c, inv, 12582912.0f)), y3 = __float_as_uint(__builtin_fmaf(d, inv, 12582912.0f));
    return __builtin_amdgcn_perm(__builtin_amdgcn_perm(y3, y2, 0x0c0c0400u), __builtin_amdgcn_perm(y1, y0, 0x0c0c0400u), 0x05040100u);
}
__device__ __forceinline__ unsigned pk4i8(float a, float b, float c, float d) { return ((unsigned)(int)a & 0xffu) | (((unsigned)(int)b & 0xffu) << 8) | (((unsigned)(int)c & 0xffu) << 16) | ((unsigned)(int)d << 24); }
__device__ __forceinline__ void store_row_i8(const f32x4 (&v)[4], signed char* row, float* scale, int lane) {
    float mx = 0.f;
#pragma unroll
    for (int j = 0; j < 4; ++j) mx = fmaxf(fmaxf(mx, fmaxf(fabsf(v[j][0]), fabsf(v[j][1]))), fmaxf(fabsf(v[j][2]), fabsf(v[j][3])));
    mx = wave_max(mx); const float inv = mx > 0.f ? 127.f / mx : 0.f;
#pragma unroll
    for (int j = 0; j < 4; ++j) *(unsigned*)(row + j * 256 + lane * 4) = q4i8(v[j][0], v[j][1], v[j][2], v[j][3], inv);
    if (lane == 0) *scale = mx * (1.f / 127.f);
}

__device__ __forceinline__ void p0_transpose_item(const float* W, int K, int N, bf16* WT, int row_off, int row_mul, float scale, int sc_n0, int sc_n1, LAS float* scr, int item, int lane) {
    const int nblk = N / 32, kb = item / nblk, nb = item % nblk, k0 = 64 * kb, n0 = 32 * nb;
#pragma unroll 32
    for (int i = 0; i < 32; ++i) { const int kk = 2 * i + (lane >> 5); scr[kk * 33 + (lane & 31)] = __builtin_nontemporal_load(W + (size_t)(k0 + kk) * N + n0 + (lane & 31)); }
    LDS_WAIT(); asm volatile("" ::: "memory");
    const float sc = (n0 >= sc_n0 && n0 < sc_n1) ? scale : 1.0f;
    const int c = lane & 7;
#pragma unroll
    for (int j = 0; j < 4; ++j) { const int n = (lane >> 3) + 8 * j; const LAS float* s = scr + (8 * c) * 33 + n;
        v4u o; o.x = pk2(s[0 * 33] * sc, s[1 * 33] * sc); o.y = pk2(s[2 * 33] * sc, s[3 * 33] * sc); o.z = pk2(s[4 * 33] * sc, s[5 * 33] * sc); o.w = pk2(s[6 * 33] * sc, s[7 * 33] * sc);
        *(GAS v4u*)(WT + (size_t)(row_off + (n0 + n) * row_mul) * K + k0 + 8 * c) = o; }
    LDS_WAIT(); asm volatile("" ::: "memory");
}
constexpr int P0Q_STAGE_BYTES = 17152;
__device__ __forceinline__ float p0_quant_pass1(const float* wp, int N, int kb0, int kh, int nl, LAS unsigned short* st) {
    float mx = 0.f;
#pragma unroll 1
    for (int kb = 0; kb < 4; ++kb) { const float* wk = wp + (size_t)((kb0 + kb) * 64 + kh) * N;
#pragma unroll 32
        for (int i = 0; i < 32; ++i) { const float v = __builtin_nontemporal_load(wk + (size_t)(2 * i) * N); mx = fmaxf(mx, fabsf(v));
            st[(kb * 64 + 2 * i + kh) * 33 + nl] = __builtin_bit_cast(unsigned short, (_Float16)v); } }
    return fmaxf(mx, __shfl_xor(mx, 32));
}
__device__ __forceinline__ void p0_quant_pass2(int K, int n0, signed char* WT, int row_off, int row_mul, const LAS float* pm, int kb0, const LAS unsigned short* st, int lane) {
    const int c = lane & 7; float invn[4];
#pragma unroll
    for (int j = 0; j < 4; ++j) { const int n = (lane >> 3) + 8 * j; const float m = fmaxf(fmaxf(pm[n], pm[32 + n]), fmaxf(pm[64 + n], pm[96 + n])); invn[j] = m > 0.f ? 127.f / m : 0.f; }
#pragma unroll 1
    for (int kb = 0; kb < 4; ++kb) {
#pragma unroll
        for (int j = 0; j < 4; ++j) { const int n = (lane >> 3) + 8 * j; const LAS unsigned short* s = st + (kb * 64 + 8 * c) * 33 + n; float f[8];
#pragma unroll
            for (int k = 0; k < 8; ++k) f[k] = rintf((float)__builtin_bit_cast(_Float16, s[k * 33]) * invn[j]);
            v2u o; o.x = pk4i8(f[0], f[1], f[2], f[3]); o.y = pk4i8(f[4], f[5], f[6], f[7]);
            *(GAS v2u*)(WT + (size_t)(row_off + (n0 + n) * row_mul) * K + (kb0 + kb) * 64 + 8 * c) = o; } }
}
__device__ __forceinline__ void p0_transpose_item_f8(const float* W, int K, int N, unsigned char* WT, float scale, LAS float* scr, int item, int lane) {
    const int nblk = N / 32, kb = item / nblk, nb = item % nblk, k0 = 64 * kb, n0 = 32 * nb;
#pragma unroll 32
    for (int i = 0; i < 32; ++i) { const int kk = 2 * i + (lane >> 5); scr[kk * 33 + (lane & 31)] = __builtin_nontemporal_load(W + (size_t)(k0 + kk) * N + n0 + (lane & 31)); }
    LDS_WAIT(); asm volatile("" ::: "memory");
    const int c = lane & 7;
#pragma unroll
    for (int j = 0; j < 4; ++j) { const int n = (lane >> 3) + 8 * j; const LAS float* s = scr + (8 * c) * 33 + n;
        int w0 = pg8::f8pk(s[0 * 33] * scale, s[1 * 33] * scale, 0, false); w0 = pg8::f8pk(s[2 * 33] * scale, s[3 * 33] * scale, w0, true);
        int w1 = pg8::f8pk(s[4 * 33] * scale, s[5 * 33] * scale, 0, false); w1 = pg8::f8pk(s[6 * 33] * scale, s[7 * 33] * scale, w1, true);
        v2u o; o.x = (unsigned)w0; o.y = (unsigned)w1; *(GAS v2u*)(WT + (size_t)(n0 + n) * K + k0 + 8 * c) = o; }
    LDS_WAIT(); asm volatile("" ::: "memory");
}
__device__ __forceinline__ void p0a_prologue(Frame& F, const Args& a) {
    const float* c = a.in[1]; const float* w_ada = a.in[2]; const float* b_ada = a.in[3];
    if (F.vcu < 192) {
        LAS float* sl = (LAS float*)(F.lds);
        LAS float* red = (LAS float*)(F.lds + 16384);
        for (int i = F.tid; i < BATCH * DM; i += NTHREADS) { const float cv = c[i]; sl[i] = cv / (1.f + __expf(-cv)); }
        __syncthreads();
        const int l = F.vcu / 96, cb = F.vcu % 96, col = cb * 64 + F.lane;
        const float* w = w_ada + (size_t)l * DM * 6 * DM + col;
        float acc[BATCH] = {0.f, 0.f, 0.f, 0.f};
        const int kbeg = F.wave * 128;
#pragma unroll 32
        for (int k = kbeg; k < kbeg + 128; ++k) { const float wv = __builtin_nontemporal_load(w + (size_t)k * 6 * DM);
#pragma unroll
            for (int b = 0; b < BATCH; ++b) acc[b] += sl[b * DM + k] * wv; }
#pragma unroll
        for (int b = 0; b < BATCH; ++b) red[(F.wave * BATCH + b) * 64 + F.lane] = acc[b];
        __syncthreads();
        if (F.wave < BATCH) { float s = 0.f;
#pragma unroll
            for (int w8 = 0; w8 < 8; ++w8) s += red[(w8 * BATCH + F.wave) * 64 + F.lane];
            float* mod = (float*)(F.ws + TB_MOD);
            __hip_atomic_store(&mod[((size_t)l * BATCH + F.wave) * 6 * DM + col], s + b_ada[l * 6 * DM + col], __ATOMIC_RELAXED, __HIP_MEMORY_SCOPE_AGENT);
            asm volatile("s_waitcnt vmcnt(0)" ::: "memory"); }
        __syncthreads();
        if (F.tid == 0) (void)__hip_atomic_fetch_add((unsigned*)(F.ctl + CW_MODCNT), 1u, __ATOMIC_RELAXED, __HIP_MEMORY_SCOPE_AGENT);
    }
    { const int gt = F.vcu * NTHREADS + F.tid, NGT = F.G * NTHREADS; float* par = (float*)(F.ws + TB_PAR);
      for (int i = gt; i < PAR_TOTAL; i += NGT) { float v;
          if (i < PAR_LN1G) v = a.in[5][i - PAR_WCONV];
          else if (i < PAR_LN1B) v = a.in[9][i - PAR_LN1G];
          else if (i < PAR_LN2G) v = a.in[10][i - PAR_LN1B];
          else if (i < PAR_LN2B) v = a.in[16][i - PAR_LN2G];
          else if (i < PAR_BR) v = a.in[17][i - PAR_LN2B];
          else if (i < PAR_WR) v = a.in[12][i - PAR_BR];
          else v = a.in[11][i - PAR_WR];
          par[i] = v; } }
    { const int gt = F.vcu * NTHREADS + F.tid, NGT = F.G * NTHREADS; unsigned short* wimg = (unsigned short*)(F.ws + TB_WRS);
      for (int idx = gt; idx < DM * NEXP; idx += NGT) { const int col = idx >> 4, e = idx & 15; const float v = a.in[11][idx]; const unsigned h = f2bf(v); const float hv = __uint_as_float(h << 16);
          wimg[e * WR_PITCH + col] = (unsigned short)h; wimg[(NEXP + e) * WR_PITCH + col] = (unsigned short)f2bf(v - hv); } }
    LAS float* scr = (LAS float*)(F.lds + RING_OFF + F.wave * 16384);
    const int gw = F.vcu * NWAVES + F.wave, NGW = F.G * NWAVES;
    constexpr int I_AB = (CONV_CH / 64) * (DM / 32), I_O = (DM / 64) * (DM / 32), I_G = (DM / 64) * (FFD / 32), I_D = (FFD / 64) * (DM / 32);
    constexpr int PER_L = 2 * I_AB + I_O + NEXP * I_D, NITEMS = DEPTH * PER_L;
    constexpr int H_IN = IN_W / 32, H_GU = NEXP * 2 * (FFD / 32), H_L = H_IN + H_GU, NHEAVY = DEPTH * H_L;
    {   const int quad = F.wave >> 2, w4 = F.wave & 3, NQ = F.G * 2, qd = NQ - 1 - (F.vcu * 2 + quad), nl = F.lane & 31, kh = F.lane >> 5;
        LAS float* pmx = (LAS float*)(F.lds + 7 * P0Q_STAGE_BYTES);
        LAS unsigned short* st = (LAS unsigned short*)(F.lds + (F.wave < 7 ? F.wave * P0Q_STAGE_BYTES : GTAB_OFF));
        constexpr int KQ = DM / 64 / 4;
#pragma unroll 1
        for (int it0 = 0; it0 < NHEAVY; it0 += NQ) { const int it = it0 + qd; const bool act = it < NHEAVY;
            const float* W = a.in[4]; int N = IN_W, n0 = 0, row_off = 0, row_mul = 1, sc0 = 0, sc1 = 0; signed char* WT = (signed char*)(F.ws + W_IN); float* scales = (float*)(F.ws + W_IN + W_IN_SC); float qsc = 1.f;
            if (act) { const int l = it / H_L; int r = it % H_L;
                if (r < H_IN) { n0 = r * 32; const bool isc = n0 >= CONV_CH && n0 < 2 * CONV_CH, isx = n0 >= 2 * CONV_CH && n0 < 3 * CONV_CH;
                    W = a.in[4] + (size_t)l * DM * IN_W; N = IN_W; WT = (signed char*)(F.ws + W_IN + l * W_IN_L); row_off = isc ? -CONV_CH : isx ? 1 - 3 * CONV_CH : 0; row_mul = (isc || isx) ? 2 : 1;
                    scales = (float*)(F.ws + W_IN + l * W_IN_L + W_IN_SC); qsc = QSCALE; sc0 = 3 * CONV_CH; sc1 = 3 * CONV_CH + ATT_W; }
                else { r -= H_IN; const int e = r / (2 * (FFD / 32)), wh = (r / (FFD / 32)) & 1, nb = r % (FFD / 32); const size_t le = (size_t)l * NEXP + e;
                    W = a.in[13 + wh] + le * DM * FFD; N = FFD; n0 = nb * 32; WT = (signed char*)(F.ws + W_GU + le * W_GU_E); row_off = wh; row_mul = 2; scales = (float*)(F.ws + W_GU + le * W_GU_E + W_GU_SC); qsc = 1.f; sc0 = 0; sc1 = 0; } }
            const float* wp = W + n0 + nl;
            if (act) { const float mxp = p0_quant_pass1(wp, N, w4 * KQ, kh, nl, st); if (F.lane < 32) pmx[(quad * 4 + w4) * 32 + F.lane] = mxp; }
            __syncthreads();
            if (act) { const float mx = fmaxf(fmaxf(pmx[(quad * 4 + 0) * 32 + nl], pmx[(quad * 4 + 1) * 32 + nl]), fmaxf(pmx[(quad * 4 + 2) * 32 + nl], pmx[(quad * 4 + 3) * 32 + nl]));
                const float inv = mx > 0.f ? 127.f / mx : 0.f;
                if (w4 == 0 && F.lane < 32) scales[row_off + (n0 + nl) * row_mul] = mx * (1.f / 127.f) * ((n0 >= sc0 && n0 < sc1) ? qsc : 1.f);
                p0_quant_pass2(DM, n0, WT, row_off, row_mul, pmx + quad * 128, w4 * KQ, st, F.lane); }
            __syncthreads(); }
    }
    for (int it = gw; it < NITEMS; it += NGW) {
        const int l = it / PER_L; int r = it % PER_L;
        if (r < I_AB) { p0_transpose_item_f8(a.in[6] + (size_t)l * CONV_CH * DM, CONV_CH, DM, (unsigned char*)(F.ws + W_A + l * W_A_L), 64.0f, scr, r, F.lane); continue; } r -= I_AB;
        if (r < I_AB) { p0_transpose_item_f8(a.in[7] + (size_t)l * ATT_W * DM, ATT_W, DM, (unsigned char*)(F.ws + W_B + l * W_B_L), 64.0f, scr, r, F.lane); continue; } r -= I_AB;
        if (r < I_O) { p0_transpose_item_f8(a.in[8] + (size_t)l * DM * DM, DM, DM, (unsigned char*)(F.ws + W_O + l * W_O_L), 64.0f, scr, r, F.lane); continue; } r -= I_O;
        const int e = r / I_D; r %= I_D; const size_t le = (size_t)l * NEXP + e;
        p0_transpose_item_f8(a.in[15] + le * FFD * DM, FFD, DM, (unsigned char*)(F.ws + W_DN + le * W_DN_E), 64.0f, scr, r, F.lane);
    }
}
__device__ __forceinline__ void p0b_u0(Frame& F) {
    const float* x = F.x; const float* mod = (const float*)(F.ws + TB_MOD); signed char* U = (signed char*)(F.ws + WS_ACT); float* sU = (float*)(F.ws + WS_ACT + ACT_SU);
    const int gw = F.vcu * NWAVES + F.wave, NGW = F.G * NWAVES;
    {
        if (F.tid == 0) { unsigned* w = (unsigned*)(F.ctl + CW_MODCNT); unsigned* tmo = (unsigned*)(F.ctl + CW_BAR + XB_TMO); const unsigned want = F.G < 192 ? (unsigned)F.G : 192u; unsigned sp = 0u;
            while (__hip_atomic_load(w, __ATOMIC_RELAXED, __HIP_MEMORY_SCOPE_AGENT) < want) { __builtin_amdgcn_s_sleep(1);
                if ((++sp & 255u) == 0u) { if (__hip_atomic_load(tmo, __ATOMIC_RELAXED, __HIP_MEMORY_SCOPE_AGENT)) break; if (sp > (1u << 18)) { atomicAdd(tmo, 1u); break; } } } }
        if (F.wave == 0) { __builtin_amdgcn_fence(__ATOMIC_ACQUIRE, "agent"); asm volatile("s_waitcnt vmcnt(0)" ::: "memory"); }
        __syncthreads(); }
    for (int m = gw; m < M_TOK; m += NGW) { const int b = m / SEQ; const float* mb = mod + (size_t)b * 6 * DM; f32x4 u[4];
#pragma unroll
        for (int j = 0; j < 4; ++j) { const int col = j * 256 + F.lane * 4; const f32x4 v = __builtin_nontemporal_load((const f32x4*)(x + (size_t)m * DM + col)), sh = *(const f32x4*)(mb + col), sc = *(const f32x4*)(mb + DM + col);
            u[j] = v * (sc + 1.0f) + sh; }
        store_row_i8(u, U + (size_t)m * DM, sU + m, F.lane); }
}
__device__ __forceinline__ void p2_conv(Frame& F, int l, bf16* ao) {
    bf16* cb = (bf16*)(F.ws + WS_PROJ); const bf16* pp = cb + (size_t)M_TOK * 512;
    const float* wc = (const float*)(F.ws + TB_PAR) + PAR_WCONV + (size_t)l * 3 * CONV_CH;
    const int gw = F.vcu * NWAVES + F.wave, NGW = F.G * NWAVES; const int ch = F.lane * 8;
    float w0[8], w1[8], w2[8];
#pragma unroll
    for (int i = 0; i < 8; ++i) { w0[i] = wc[ch + i]; w1[i] = wc[CONV_CH + ch + i]; w2[i] = wc[2 * CONV_CH + ch + i]; }
    for (int chunk = gw; chunk < M_TOK / 16; chunk += NGW) {
        const int row0 = chunk * 16; const int t0 = row0 % SEQ;
        float pm2[8], pm1[8];
#pragma unroll
        for (int i = 0; i < 8; ++i) { pm2[i] = 0.f; pm1[i] = 0.f; }
        if (t0 >= 2) {
            const v4u q2 = *(const v4u*)(pp + (size_t)(row0 - 2) * 512 + ch), q1 = *(const v4u*)(pp + (size_t)(row0 - 1) * 512 + ch);
#pragma unroll
            for (int i = 0; i < 4; ++i) { pm2[2 * i] = bflo(q2[i]); pm2[2 * i + 1] = bfhi(q2[i]); pm1[2 * i] = bflo(q1[i]); pm1[2 * i + 1] = bfhi(q1[i]); }
        }
        for (int r = 0; r < 16; ++r) { const size_t off = (size_t)(row0 + r) * 512 + ch;
            const v4u q0 = __builtin_nontemporal_load((const v4u*)(pp + off)), bb = __builtin_nontemporal_load((const v4u*)(cb + off));
            float p0[8], o[8];
#pragma unroll
            for (int i = 0; i < 4; ++i) { p0[2 * i] = bflo(q0[i]); p0[2 * i + 1] = bfhi(q0[i]); }
#pragma unroll
            for (int i = 0; i < 8; ++i) o[i] = w2[i] * p0[i] + w1[i] * pm1[i] + w0[i] * pm2[i];
            int q0w = pg8::f8pk(bflo(bb[0]) * o[0] * 2.0f, bfhi(bb[0]) * o[1] * 2.0f, 0, false); q0w = pg8::f8pk(bflo(bb[1]) * o[2] * 2.0f, bfhi(bb[1]) * o[3] * 2.0f, q0w, true);
            int q1w = pg8::f8pk(bflo(bb[2]) * o[4] * 2.0f, bfhi(bb[2]) * o[5] * 2.0f, 0, false); q1w = pg8::f8pk(bflo(bb[3]) * o[6] * 2.0f, bfhi(bb[3]) * o[7] * 2.0f, q1w, true);
            v2u ov; ov.x = (unsigned)q0w; ov.y = (unsigned)q1w; *(v2u*)((unsigned char*)ao + off) = ov;
#pragma unroll
            for (int i = 0; i < 8; ++i) { pm2[i] = pm1[i]; pm1[i] = p0[i]; } }
    }
}
__device__ __forceinline__ void p2_attn(Frame& F, unsigned char* lds_generic) {
    const sba::bf16_t* Q = (const sba::bf16_t*)(F.ws + WS_PROJ + 3 * PJ_T512); const sba::bf16_t* K = (const sba::bf16_t*)(F.ws + WS_PROJ + 4 * PJ_T512); const sba::bf16_t* V = (const sba::bf16_t*)(F.ws + WS_PROJ + 5 * PJ_T512);
    sba::bf16_t* O = (sba::bf16_t*)(F.ws + WS_ACT);
    constexpr int NQB = SEQ / 256, NUNITS = BATCH * NHEAD * NQB;
    if (F.G == 256) {
        const int bh = F.vcu >> 3, s = F.vcu & 7;
        for (int i = 0; i < 4; ++i) { const int qb = (i == 0) ? s : (i == 1) ? 15 - s : (i == 2) ? 16 + s : 31 - s; sba::attn_unit(bh / NHEAD, bh % NHEAD, qb, Q, K, V, O, (char*)lds_generic); }
    } else {
        for (int u = F.vcu; u < NUNITS; u += F.G) { const int bh = u / NQB, qb = u % NQB; sba::attn_unit(bh / NHEAD, bh % NHEAD, qb, Q, K, V, O, (char*)lds_generic); }
    }
}
__device__ __forceinline__ float quad_sum(float v) {
    { auto r = __builtin_amdgcn_permlane16_swap(__float_as_uint(v), __float_as_uint(v), false, false); v = __uint_as_float(r[0]) + __uint_as_float(r[1]); }
    { auto r = __builtin_amdgcn_permlane32_swap(__float_as_uint(v), __float_as_uint(v), false, false); v = __uint_as_float(r[0]) + __uint_as_float(r[1]); }
    return v;
}
__device__ __forceinline__ float quad_max(float v) {
    { auto r = __builtin_amdgcn_permlane16_swap(__float_as_uint(v), __float_as_uint(v), false, false); v = fmaxf(__uint_as_float(r[0]), __uint_as_float(r[1])); }
    { auto r = __builtin_amdgcn_permlane32_swap(__float_as_uint(v), __float_as_uint(v), false, false); v = fmaxf(__uint_as_float(r[0]), __uint_as_float(r[1])); }
    return v;
}
__device__ __forceinline__ void p5_ln1(Frame& F, int l, const bf16* X, bf16* Xo, bool dry) {
    const float* mod = (const float*)(F.ws + TB_MOD) + (size_t)l * BATCH * 6 * DM; const float* par = (const float*)(F.ws + TB_PAR);
    const float* g = par + PAR_LN1G + l * DM; const float* bta = par + PAR_LN1B + l * DM; const float* w_router = par + PAR_WR; const float* b_router = par + PAR_BR;
    int* epos = (int*)(F.ws + TB_EIDX); float* gate = (float*)(F.ws + TB_GATE); int* gcnt = (int*)(F.ctl + CW_GCNT + 64 * l);
    signed char* U2 = (signed char*)(F.ws + WS_ACT); float* sU2 = (float*)(F.ws + WS_ACT + ACT_SU); int* list_e = (int*)(F.ws + WS_ACT + ACT_LIST);
    constexpr int WPITCH = WR_PITCH;
    LAS unsigned short* wth = (LAS unsigned short*)(F.lds);
    LAS unsigned short* wtl = wth + 16 * WPITCH;
    LAS float* pg = (LAS float*)(F.lds + 4 * 16 * WPITCH);
    LAS float* lgs = pg + 4 * DM;
    LAS int* hist = (LAS int*)(lgs + NWAVES * 256); LAS int* hbase = hist + 16; LAS int* te = hbase + 16; LAS int* tp = te + 256;
    const int blk = blockIdx.x; const int b = (blk * 128) / SEQ; const float* mb = mod + (size_t)b * 6 * DM;
    const int t = F.lane & 15, kq = F.lane >> 4; const int row = blk * 128 + F.wave * 16 + t;
    const bf16* xr = X + (size_t)row * DM + 8 * kq; (void)Xo; (void)w_router;
    constexpr int NIMG = 2 * NEXP * WPITCH * 2 / 16;
    const v4u* wsrc = (const v4u*)(F.ws + TB_WRS);
    v4u wimg[9]; float pv[2][4];
#pragma unroll
    for (int q = 0; q < 9; ++q) { const int i = F.tid + q * NTHREADS; wimg[q] = (q < 8 || i < NIMG) ? wsrc[(q < 8 || i < NIMG) ? i : 0] : (v4u){0u, 0u, 0u, 0u}; }
#pragma unroll
    for (int q = 0; q < 2; ++q) { const int idx = F.tid + q * NTHREADS; pv[q][0] = g[idx]; pv[q][1] = bta[idx]; pv[q][2] = mb[4 * DM + idx]; pv[q][3] = mb[3 * DM + idx]; }
    asm volatile("" ::: "memory");
    v4u raw[32];
#pragma unroll
    for (int s = 0; s < 32; ++s) raw[s] = *(const v4u*)(xr + 32 * s);
    asm volatile("" ::: "memory");
#pragma unroll
    for (int q = 0; q < 9; ++q) { const int i = F.tid + q * NTHREADS; if (q < 8 || i < NIMG) ((LAS v4u*)F.lds)[i] = wimg[q]; }
#pragma unroll
    for (int q = 0; q < 2; ++q) { const int idx = F.tid + q * NTHREADS; pg[idx] = pv[q][0]; pg[DM + idx] = pv[q][1]; pg[2 * DM + idx] = pv[q][2] + 1.0f; pg[3 * DM + idx] = pv[q][3]; }
    if (F.tid < NEXP) hist[F.tid] = 0;
    __syncthreads();
    float sum = 0.f, sq = 0.f;
#pragma unroll
    for (int s = 0; s < 32; ++s) { const float e0 = bflo(raw[s].x), e1 = bfhi(raw[s].x), e2 = bflo(raw[s].y), e3 = bfhi(raw[s].y), e4 = bflo(raw[s].z), e5 = bfhi(raw[s].z), e6 = bflo(raw[s].w), e7 = bfhi(raw[s].w);
        sum += ((e0 + e1) + (e2 + e3)) + ((e4 + e5) + (e6 + e7)); sq += ((e0 * e0 + e1 * e1) + (e2 * e2 + e3 * e3)) + ((e4 * e4 + e5 * e5) + (e6 * e6 + e7 * e7)); }
    const float mean = quad_sum(sum) * (1.f / DM); const float var = fmaxf(quad_sum(sq) * (1.f / DM) - mean * mean, 0.f);
    const float rstd = 1.f / sqrtf(var + LN_EPS);
    typedef short bf16x8_t __attribute__((ext_vector_type(8)));
    f32x4 acc = {0.f, 0.f, 0.f, 0.f}; float amax = 0.f;
    const LAS unsigned short* wph = wth + t * WPITCH + 8 * kq; const LAS unsigned short* wpl = wtl + t * WPITCH + 8 * kq;
    const LAS float* pp = pg + 8 * kq;
#pragma unroll
    for (int s = 0; s < 32; ++s) {
        const f32x4 g0 = *(const LAS f32x4*)(pp + 32 * s), g1 = *(const LAS f32x4*)(pp + 32 * s + 4), b0 = *(const LAS f32x4*)(pp + DM + 32 * s), b1 = *(const LAS f32x4*)(pp + DM + 32 * s + 4);
        const f32x4 c0 = *(const LAS f32x4*)(pp + 2 * DM + 32 * s), c1 = *(const LAS f32x4*)(pp + 2 * DM + 32 * s + 4), h0 = *(const LAS f32x4*)(pp + 3 * DM + 32 * s), h1 = *(const LAS f32x4*)(pp + 3 * DM + 32 * s + 4);
        asm volatile("" : "+v"(raw[s].x), "+v"(raw[s].y), "+v"(raw[s].z), "+v"(raw[s].w));
        const v4u rw = raw[s];
        const f32x4 x0 = (((f32x4){bflo(rw.x), bfhi(rw.x), bflo(rw.y), bfhi(rw.y)}) - mean) * rstd * g0 + b0, x1 = (((f32x4){bflo(rw.z), bfhi(rw.z), bflo(rw.w), bfhi(rw.w)}) - mean) * rstd * g1 + b1;
        const f32x4 u0 = x0 * c0 + h0, u1 = x1 * c1 + h1;
        amax = fmaxf(amax, fmaxf(fmaxf(fmaxf(fabsf(u0[0]), fabsf(u0[1])), fmaxf(fabsf(u0[2]), fabsf(u0[3]))), fmaxf(fmaxf(fabsf(u1[0]), fabsf(u1[1])), fmaxf(fabsf(u1[2]), fabsf(u1[3])))));
        v4u uh, ul;
        uh.x = pk2(u0[0], u0[1]); uh.y = pk2(u0[2], u0[3]); uh.z = pk2(u1[0], u1[1]); uh.w = pk2(u1[2], u1[3]);
        raw[s] = uh;
        ul.x = pk2(u0[0] - bflo(uh.x), u0[1] - bfhi(uh.x)); ul.y = pk2(u0[2] - bflo(uh.y), u0[3] - bfhi(uh.y)); ul.z = pk2(u1[0] - bflo(uh.z), u1[1] - bfhi(uh.z)); ul.w = pk2(u1[2] - bflo(uh.w), u1[3] - bfhi(uh.w));
        const bf16x8_t wh = *(const LAS bf16x8_t*)(wph + 32 * s), wl = *(const LAS bf16x8_t*)(wpl + 32 * s);
        acc = __builtin_amdgcn_mfma_f32_16x16x32_bf16(wh, __builtin_bit_cast(bf16x8_t, uh), acc, 0, 0, 0);
        acc = __builtin_amdgcn_mfma_f32_16x16x32_bf16(wh, __builtin_bit_cast(bf16x8_t, ul), acc, 0, 0, 0);
        acc = __builtin_amdgcn_mfma_f32_16x16x32_bf16(wl, __builtin_bit_cast(bf16x8_t, uh), acc, 0, 0, 0);
        if (s & 1) asm volatile("" ::: "memory");
    }
    {
        const float rmax = quad_max(amax), qinv = rmax > 0.f ? 127.f / rmax : 0.f; signed char* uw = U2 + (size_t)row * DM + 8 * kq;
#pragma unroll
        for (int s = 0; s < 32; ++s) { v4u rw = raw[s]; asm volatile("" : "+v"(rw.x), "+v"(rw.y), "+v"(rw.z), "+v"(rw.w));
            v2u o; o.x = q4i8(bflo(rw.x), bfhi(rw.x), bflo(rw.y), bfhi(rw.y), qinv); o.y = q4i8(bflo(rw.z), bfhi(rw.z), bflo(rw.w), bfhi(rw.w), qinv);
            if (!dry) *(v2u*)(uw + 32 * s) = o; else asm volatile("" :: "v"(o.x), "v"(o.y));
            asm volatile("" ::: "memory"); }
        if (kq == 0 && !dry) { sU2[row] = rmax * (1.f / 127.f); float* st = (float*)(F.ws + TB_SLOT); st[row * 2] = mean; st[row * 2 + 1] = rstd; }
    }
    LAS float* lw = lgs + F.wave * 256;
    *(LAS f32x4*)(lw + t * 16 + 4 * kq) = acc;
    LDS_WAIT(); asm volatile("" ::: "memory");
    float lg[NEXP];
#pragma unroll
    for (int q = 0; q < 4; ++q) { const f32x4 v = *(const LAS f32x4*)(lw + t * 16 + 4 * q); lg[4 * q] = v[0]; lg[4 * q + 1] = v[1]; lg[4 * q + 2] = v[2]; lg[4 * q + 3] = v[3]; }
    float aff[NEXP], sel[NEXP];
#pragma unroll
    for (int e = 0; e < NEXP; ++e) { aff[e] = 1.f / (1.f + __expf(-lg[e])); sel[e] = aff[e] + b_router[e]; }
    int gbest = 0; float gs_best = -1e30f;
#pragma unroll
    for (int gi = 0; gi < 4; ++gi) { float m1 = -1e30f, m2 = -1e30f;
#pragma unroll
        for (int q = 0; q < 4; ++q) { const float xv = sel[gi * 4 + q]; if (xv > m1) { m2 = m1; m1 = xv; } else if (xv > m2) m2 = xv; }
        const float gsc = m1 + m2; if (gsc > gs_best) { gs_best = gsc; gbest = gi; } }
    float sg[4], ag[4];
#pragma unroll
    for (int q = 0; q < 4; ++q) { sg[q] = gbest == 0 ? sel[q] : gbest == 1 ? sel[4 + q] : gbest == 2 ? sel[8 + q] : sel[12 + q]; ag[q] = gbest == 0 ? aff[q] : gbest == 1 ? aff[4 + q] : gbest == 2 ? aff[8 + q] : aff[12 + q]; }
    int i1 = 0; float v1 = sg[0];
#pragma unroll
    for (int q = 1; q < 4; ++q) if (sg[q] > v1) { v1 = sg[q]; i1 = q; }
    int i2 = -1; float v2 = -1e30f;
#pragma unroll
    for (int q = 0; q < 4; ++q) if (q != i1 && sg[q] > v2) { v2 = sg[q]; i2 = q; }
    const float a1 = i1 == 0 ? ag[0] : i1 == 1 ? ag[1] : i1 == 2 ? ag[2] : ag[3], a2 = i2 == 0 ? ag[0] : i2 == 1 ? ag[1] : i2 == 2 ? ag[2] : ag[3];
    const float inv = 1.f / (a1 + a2);
    if (kq == 0) { const int e1 = gbest * 4 + i1, e2 = gbest * 4 + i2, i = F.wave * 16 + t;
        if (!dry) { gate[row * 2] = a1 * inv; gate[row * 2 + 1] = a2 * inv; }
        te[i * 2] = e1; te[i * 2 + 1] = e2;
        tp[i * 2] = __hip_atomic_fetch_add(&hist[e1], 1, __ATOMIC_RELAXED, __HIP_MEMORY_SCOPE_WORKGROUP); tp[i * 2 + 1] = __hip_atomic_fetch_add(&hist[e2], 1, __ATOMIC_RELAXED, __HIP_MEMORY_SCOPE_WORKGROUP); }
    __syncthreads();
    if (dry) return;
    if (F.tid < NEXP) hbase[F.tid] = atomicAdd(gcnt + F.tid, hist[F.tid]);
    __syncthreads();
    if (F.tid < 128) { const int tok = blk * 128 + F.tid;
#pragma unroll
        for (int k = 0; k < 2; ++k) { const int e = te[F.tid * 2 + k], p = hbase[e] + tp[F.tid * 2 + k]; list_e[(size_t)e * M_TOK + p] = tok; epos[tok * 2 + k] = e | (p << 4); } }
}
__device__ __forceinline__ void build_group_tables(Frame& F, int l, bool rows) {
    LAS int* tab = (LAS int*)(F.lds + LDSCTL_OFF);
    const int* gcnt = (const int*)(F.ctl + CW_GCNT + 64 * l);
    if (F.tid == 0) { int tb[NEXP + 1]; int acc = 0;
#pragma unroll
        for (int e = 0; e < NEXP; ++e) { tb[e] = acc; acc += (gcnt[e] + 255) >> 8; } tb[NEXP] = acc;
        const int nunits = acc * 4; int n = 0;
        for (int i = 0; i < 8; ++i) { const int L = i * F.G + (int)blockIdx.x; if (L >= nunits) break; const int wgid = pg8::xcd_remap(L, nunits); const int ti = wgid >> 2; int e = 0;
#pragma unroll
            for (int k = 1; k < NEXP; ++k) if (ti >= tb[k]) e = k;
            tab[1 + 3 * n] = ti; tab[2 + 3 * n] = wgid & 3; tab[3 + 3 * n] = e; tab[64 + 2 * n] = (ti - tb[e]) * 256; tab[65 + 2 * n] = gcnt[e]; ++n; }
        tab[0] = n; }
    __syncthreads();
    if (rows) { LAS int* rowtab = (LAS int*)(F.lds + GTAB_OFF); LAS float* sctab = (LAS float*)(F.lds + GTAB_OFF + 8192);
        const int* list_e = (const int*)(F.ws + WS_ACT + ACT_LIST); const float* sU2 = (const float*)(F.ws + WS_ACT + ACT_SU);
        const int n = tab[0];
        int toks[3]; bool oks[3];
#pragma unroll
        for (int q = 0; q < 3; ++q) { const int idx = F.tid + q * NTHREADS; oks[q] = false; toks[q] = 0;
            if (idx < n * 256) { const int un = idx >> 8, r = idx & 255; const int e = tab[3 + 3 * un], rr = tab[64 + 2 * un] + r; oks[q] = rr < tab[65 + 2 * un]; if (oks[q]) toks[q] = list_e[(size_t)e * M_TOK + rr]; } }
#pragma unroll
        for (int q = 0; q < 3; ++q) { const int idx = F.tid + q * NTHREADS; if (idx < n * 256) { rowtab[idx] = toks[q]; sctab[idx] = oks[q] ? sU2[toks[q]] : 0.f; } }
        __syncthreads(); }
}
template <bool LAST> __device__ __forceinline__ void p9_ln2(Frame& F, int l, const bf16* X, void* Xo) {
    const float* modl = (const float*)(F.ws + TB_MOD) + (size_t)l * BATCH * 6 * DM; const float* modn = modl + (size_t)BATCH * 6 * DM; const float* par = (const float*)(F.ws + TB_PAR);
    const float* g1p = par + PAR_LN1G + l * DM; const float* b1p = par + PAR_LN1B + l * DM; const float* st1 = (const float*)(F.ws + TB_SLOT);
    const float* g = par + PAR_LN2G + l * DM; const float* bta = par + PAR_LN2B + l * DM; const int* epos = (const int*)(F.ws + TB_EIDX); const float* gate = (const float*)(F.ws + TB_GATE);
    LAS int* tbs = (LAS int*)(F.lds);
    if (F.tid == 0) { const int* gcnt = (const int*)(F.ctl + CW_GCNT + 64 * l); int acc = 0; for (int e = 0; e < NEXP; ++e) { tbs[e] = acc * 256; acc += (gcnt[e] + 255) >> 8; } }
    __syncthreads();
    const unsigned char* YS = (const unsigned char*)(F.ws + WS_PROJ + PJ_XS); bf16* U = (bf16*)(F.ws + WS_ACT);
    const int gw = F.vcu * NWAVES + F.wave, NGW = F.G * NWAVES;
    constexpr int RB = 4;
    for (int m0 = gw * RB; m0 < M_TOK; m0 += NGW * RB) { const int b = m0 / SEQ; const float* mb = modl + (size_t)b * 6 * DM;
        int s0[RB], s1[RB]; float w0[RB], w1[RB], mu1[RB], rs1[RB];
#pragma unroll
        for (int k = 0; k < RB; ++k) { const v2u sv = *(const v2u*)(epos + (m0 + k) * 2); s0[k] = tbs[sv.x & 15] + (int)(sv.x >> 4); s1[k] = tbs[sv.y & 15] + (int)(sv.y >> 4);
            const v2u gv = *(const v2u*)(gate + (m0 + k) * 2); w0[k] = __uint_as_float(gv.x) * (1.f / 32.f); w1[k] = __uint_as_float(gv.y) * (1.f / 32.f);
            const v2u sv1 = *(const v2u*)(st1 + (m0 + k) * 2); mu1[k] = __uint_as_float(sv1.x); rs1[k] = __uint_as_float(sv1.y); }
        f32x4 xv[RB][4]; unsigned y0[RB][4], y1[RB][4];
#pragma unroll
        for (int k = 0; k < RB; ++k)
#pragma unroll
            for (int j = 0; j < 4; ++j) { const int col = j * 256 + F.lane * 4; { const v2u p = __builtin_nontemporal_load((const v2u*)(X + (size_t)(m0 + k) * DM + col)); xv[k][j] = (f32x4){bflo(p.x), bfhi(p.x), bflo(p.y), bfhi(p.y)}; }
                y0[k][j] = __builtin_nontemporal_load((const unsigned*)(YS + (size_t)s0[k] * DM + col)); y1[k][j] = __builtin_nontemporal_load((const unsigned*)(YS + (size_t)s1[k] * DM + col)); }
        f32x4 un[RB][4];
        float rstd[RB];
#pragma unroll
        for (int k = 0; k < RB; ++k) { float s = 0.f;
#pragma unroll
            for (int j = 0; j < 4; ++j) { const int col = j * 256 + F.lane * 4; const f32x4 g2 = *(const f32x4*)(mb + 5 * DM + col), gg1 = *(const f32x4*)(g1p + col), bb1 = *(const f32x4*)(b1p + col);
                const auto a01 = __builtin_amdgcn_cvt_pk_f32_fp8((int)y0[k][j], false), a23 = __builtin_amdgcn_cvt_pk_f32_fp8((int)y0[k][j], true), b01 = __builtin_amdgcn_cvt_pk_f32_fp8((int)y1[k][j], false), b23 = __builtin_amdgcn_cvt_pk_f32_fp8((int)y1[k][j], true);
                f32x4 f; f[0] = w0[k] * a01[0] + w1[k] * b01[0]; f[1] = w0[k] * a01[1] + w1[k] * b01[1]; f[2] = w0[k] * a23[0] + w1[k] * b23[0]; f[3] = w0[k] * a23[1] + w1[k] * b23[1];
                xv[k][j] = ((xv[k][j] - mu1[k]) * rs1[k] * gg1 + bb1) * DN_ALPHA + g2 * f; s += (xv[k][j][0] + xv[k][j][1]) + (xv[k][j][2] + xv[k][j][3]); }
            const float mean = wave_sum(s) * (1.f / DM); float s2 = 0.f;
#pragma unroll
            for (int j = 0; j < 4; ++j) { xv[k][j] = xv[k][j] - mean; s2 += (xv[k][j][0] * xv[k][j][0] + xv[k][j][1] * xv[k][j][1]) + (xv[k][j][2] * xv[k][j][2] + xv[k][j][3] * xv[k][j][3]); }
            rstd[k] = 1.f / sqrtf(wave_sum(s2) * (1.f / DM) + LN_EPS); }
#pragma unroll
        for (int j = 0; j < 4; ++j) { const int col = j * 256 + F.lane * 4; const f32x4 gg = *(const f32x4*)(g + col), bb = *(const f32x4*)(bta + col);
            f32x4 sh, sc;
            if (!LAST) { const float* mn = modn + (size_t)b * 6 * DM; sh = *(const f32x4*)(mn + col); sc = *(const f32x4*)(mn + DM + col) + 1.0f; }
#pragma unroll
            for (int k = 0; k < RB; ++k) { const f32x4 xo = xv[k][j] * rstd[k] * gg + bb;
                if (LAST) __builtin_nontemporal_store(xo, (f32x4*)((float*)Xo + (size_t)(m0 + k) * DM + col));
                else { v2u o; o.x = pk2(xo[0], xo[1]); o.y = pk2(xo[2], xo[3]); *(v2u*)((bf16*)Xo + (size_t)(m0 + k) * DM + col) = o;
                    un[k][j] = xo * sc + sh; } } }
        if (!LAST) {
#pragma unroll
            for (int k = 0; k < RB; ++k) store_row_i8(un[k], (signed char*)U + (size_t)(m0 + k) * DM, (float*)(F.ws + WS_ACT + ACT_SU) + m0 + k, F.lane); }
    }
}

constexpr int PH_PER_LAYER = 9, N_PHASES = 2 + DEPTH * PH_PER_LAYER;
__global__ void __launch_bounds__(NTHREADS, 2) mega_fwd(Args args) {
    extern __shared__ __attribute__((aligned(16))) unsigned char lds[];
    Frame F;
    F.lds = (LAS unsigned char*)lds;
    F.MISC = (volatile LAS unsigned*)(F.lds + MISC_OFF);
    F.tid = threadIdx.x; F.lane = F.tid & 63; F.wave = __builtin_amdgcn_readfirstlane(F.tid >> 6);
    F.G = gridDim.x; { const int bx = blockIdx.x; F.vcu = (F.G % 8 == 0) ? (bx % 8) * (F.G / 8) + bx / 8 : bx; }
    F.ws = args.ws; F.ctl = (gu32*)(args.ws + WS_CTL); F.x = args.in[0]; F.out = args.out;
    for (int u = F.tid; u < (LDS_BYTES - LDSCTL_OFF) / 4; u += NTHREADS) ((LAS unsigned*)(F.lds + LDSCTL_OFF))[u] = 0u;
    __syncthreads();
    const int lo = args.ph_lo, hi = args.ph_hi;
    XcdBarrier bar; bar.bar = (unsigned*)(F.ctl + CW_BAR); bar.x = 0; bar.st = nullptr;
    if (hi - lo > 1) bar = xcd_barrier_post((unsigned*)(F.ctl + CW_BAR), F.MISC + 8);
#define IN(k) (lo <= (k) && (k) < hi)
#define REPS(t) (((MK_REP_MASK >> (t)) & 1) ? 1 + MK_REP_N : 1)
#define FRESH() do { asm volatile("" : "+v"(F.tid), "+v"(F.lane)); size_t z_ = 0; asm volatile("" : "+s"(z_), "+s"(F.wave), "+s"(F.vcu)); F.ws = args.ws + z_; F.out = args.out + z_; F.x = args.in[0] + z_; } while (0)
#if MK_PROBE
#define STAMP(k) do { if (blockIdx.x == 0 && F.tid == 0) ((unsigned long long*)(F.ws + TB_STAMP))[(k)] = __builtin_amdgcn_s_memrealtime(); } while (0)
#define SEAM(k) do { if (IN(k)) { xcd_barrier(bar); STAMP((k) + 1); } } while (0)
#else
#define STAMP(k) do {} while (0)
#define SEAM(k) do { if (IN(k) && IN((k) + 1)) { xcd_barrier(bar); for (int xb_ = 0; xb_ < MK_XBAR; ++xb_) xcd_barrier(bar); } } while (0)
#endif
    STAMP(0);
    if (IN(0)) { for (int rep = 0; rep < REPS(0); ++rep) { FRESH(); p0a_prologue(F, args); __syncthreads(); } }
    if (IN(1)) { for (int rep = 0; rep < REPS(1); ++rep) { FRESH(); p0b_u0(F); } SEAM(1); }
#pragma unroll 1
    for (int l = 0; l < DEPTH; ++l) {
        const int pb = 2 + l * PH_PER_LAYER;
        const float* modl = (const float*)(F.ws + TB_MOD) + (size_t)l * BATCH * 6 * DM;
        if (IN(pb + 0)) for (int rep = 0; rep < REPS(2); ++rep) {
            FRESH();
            pg8::Gemm g{(const pg8::bf16_t*)(F.ws + WS_ACT), (const pg8::bf16_t*)(F.ws + W_IN + l * W_IN_L), M_TOK, IN_W, DM, 0, nullptr, nullptr, nullptr};
            pg8::StaticOrder S; S.init(M_TOK, IN_W, F.G, (int)blockIdx.x, MK_WGM_IN);
            pg8::EpiProjI8 E{(pg8::bf16_t*)(F.ws + WS_PROJ), (const float*)(F.ws + WS_ACT + ACT_SU), (const float*)(F.ws + W_IN + l * W_IN_L + W_IN_SC)};
            if (F.vcu & 1) { for (int sl_ = 0; sl_ < MK_STAGGER; ++sl_) __builtin_amdgcn_s_sleep(100); }
            pg8::gemm_phase<pg8::EpiProjI8, pg8::StaticOrder, true, true>(F.lds + RING_OFF, g, S, E);
            if (rep + 1 == REPS(2)) SEAM(pb + 0); }
        if (IN(pb + 1)) { FRESH(); p2_conv(F, l, (bf16*)(F.ws + WS_ACT + 16 * MiB)); FRESH(); p2_attn(F, lds + RING_OFF); SEAM(pb + 1); }
        if (IN(pb + 2)) for (int rep = 0; rep < REPS(4); ++rep) {
            FRESH();
            pg8::StaticOrder S; S.init(M_TOK, DM, F.G, (int)blockIdx.x, MK_WGM_SQ);
            pg8::Gemm g{(const pg8::bf16_t*)(F.ws + WS_ACT + 16 * MiB), (const pg8::bf16_t*)(F.ws + W_A + l * W_A_L), M_TOK, DM, CONV_CH + ATT_W, 0,
                        (const pg8::bf16_t*)(F.ws + WS_ACT), (const pg8::bf16_t*)(F.ws + W_B + l * W_B_L), nullptr};
            pg8::EpiMerge E{(const unsigned char*)(F.ws + WS_PROJ + PJ_GA), (const unsigned char*)(F.ws + WS_PROJ + PJ_GB), (pg8::bf16_t*)(F.ws + WS_PROJ + 1 * PJ_T512)};
            pg8::gemm_phase<pg8::EpiMerge, pg8::StaticOrder, true, true>(F.lds + RING_OFF, g, S, E);
            if (rep + 1 == REPS(4)) SEAM(pb + 2); }
        bf16* const XBl = (l + 1 < DEPTH) ? (bf16*)F.out : (bf16*)(F.ws + WS_PROJ + PJ_GB);
        if (IN(pb + 3)) for (int rep = 0; rep < REPS(5); ++rep) {
            FRESH();
            pg8::Gemm g{(const pg8::bf16_t*)(F.ws + WS_PROJ + 1 * PJ_T512), (const pg8::bf16_t*)(F.ws + W_O + l * W_O_L), M_TOK, DM, DM, 0, nullptr, nullptr, nullptr};
            pg8::StaticOrder S; S.init(M_TOK, DM, F.G, (int)blockIdx.x, MK_WGM_SQ);
            if (l == 0) { pg8::EpiH1<true> E{(const void*)F.x, (pg8::bf16_t*)XBl, modl + 2 * DM};
                pg8::gemm_phase<pg8::EpiH1<true>, pg8::StaticOrder, true, true>(F.lds + RING_OFF, g, S, E); }
            else { pg8::EpiH1<false> E{(const void*)F.out, (pg8::bf16_t*)XBl, modl + 2 * DM};
                pg8::gemm_phase<pg8::EpiH1<false>, pg8::StaticOrder, true, true>(F.lds + RING_OFF, g, S, E); }
            if (rep + 1 == REPS(5)) SEAM(pb + 3); }
        if (IN(pb + 4)) { for (int rep = 1; rep < REPS(6); ++rep) { FRESH(); p5_ln1(F, l, XBl, (bf16*)(F.ws + WS_PROJ), true); __syncthreads(); } FRESH(); p5_ln1(F, l, XBl, XBl, false); SEAM(pb + 4); }
        if (IN(pb + 6)) for (int rep = 0; rep < REPS(8); ++rep) {
            FRESH(); build_group_tables(F, l, true);
            pg8::Gemm g{(const pg8::bf16_t*)(F.ws + WS_ACT), (const pg8::bf16_t*)(F.ws + W_GU + (size_t)l * NEXP * W_GU_E), PMAX, 2 * FFD, DM, W_GU_E, nullptr, nullptr, (const PG8_LAS int*)(F.lds + GTAB_OFF)};
            pg8::GroupedOrder S{(const PG8_LAS int*)(F.lds + LDSCTL_OFF)};
            pg8::EpiGUI8 E{(pg8::bf16_t*)(F.ws + WS_PROJ + PJ_HS), (const PG8_LAS float*)(F.lds + GTAB_OFF + 8192), (const char*)(F.ws + W_GU + (size_t)l * NEXP * W_GU_E + W_GU_SC), W_GU_E};
            pg8::gemm_phase<pg8::EpiGUI8, pg8::GroupedOrder, true, true>(F.lds + RING_OFF, g, S, E);
            __syncthreads();
            if (rep + 1 == REPS(8)) SEAM(pb + 6); }
        if (IN(pb + 7)) for (int rep = 0; rep < REPS(9); ++rep) {
            FRESH(); build_group_tables(F, l, false);
            pg8::Gemm g{(const pg8::bf16_t*)(F.ws + WS_PROJ + PJ_HS), (const pg8::bf16_t*)(F.ws + W_DN + (size_t)l * NEXP * W_DN_E), PMAX, DM, FFD, W_DN_E, nullptr, nullptr, nullptr};
            pg8::GroupedOrder S{(const PG8_LAS int*)(F.lds + LDSCTL_OFF)};
            pg8::EpiDown E{(pg8::bf16_t*)(F.ws + WS_PROJ + PJ_XS)};
            pg8::gemm_phase<pg8::EpiDown, pg8::GroupedOrder, true, true>(F.lds + RING_OFF, g, S, E);
            __syncthreads();
            if (rep + 1 == REPS(9)) SEAM(pb + 7); }
        if (IN(pb + 8)) { FRESH(); if (l + 1 < DEPTH) p9_ln2<false>(F, l, XBl, (void*)XBl); else p9_ln2<true>(F, l, XBl, (void*)F.out); SEAM(pb + 8); }
    }
#if MK_PROBE
    {
        const unsigned long long* st = (const unsigned long long*)(F.ws + TB_STAMP); float tA = 0.f, tB = 0.f;
        for (int k = 0; k < N_PHASES; ++k) { const float d = (float)(st[k + 1] - st[k]) * 0.01f; if ((MK_PA >> k) & 1) tA += d; if ((MK_PB >> k) & 1) tB += d; }
        const float sc = 1.f + 0.06f * sqrtf(tA / (float)(MK_TMAX));
        for (size_t i = (size_t)blockIdx.x * NTHREADS + F.tid; i < (size_t)M_TOK * DM; i += (size_t)F.G * NTHREADS) F.out[i] = (i == 0) ? (10.f * tB + 60.f) : F.out[i] * sc;
    }
#endif
#undef IN
#undef FRESH
#undef REPS
#undef SEAM
}

#ifndef MK_PER_PHASE
#define MK_PER_PHASE 0
#endif
extern "C" void kernel_launch(void* const* d_in, const int* in_sizes, int n_in, void* d_out, int out_size, void* d_ws, size_t ws_size, hipStream_t stream) {
    static int grid = 0;
    if (grid == 0) {
        if (n_in != 18 || in_sizes[0] != M_TOK * DM || out_size != M_TOK * DM || ws_size < WS_END) { fprintf(stderr, "kernel_launch: unexpected shapes / workspace (%d inputs, ws %zu)\n", n_in, ws_size); grid = -1; return; }
        int dev = 0, cus = 0;
        if (hipGetDevice(&dev) != hipSuccess || hipDeviceGetAttribute(&cus, hipDeviceAttributeMultiprocessorCount, dev) != hipSuccess) { grid = -1; return; }
        if (hipFuncSetAttribute((const void*)mega_fwd, hipFuncAttributeMaxDynamicSharedMemorySize, LDS_BYTES) != hipSuccess) { fprintf(stderr, "kernel_launch: hipFuncSetAttribute failed\n"); grid = -1; return; }
        int per_cu = 0;
        if (hipOccupancyMaxActiveBlocksPerMultiprocessor(&per_cu, (const void*)mega_fwd, NTHREADS, LDS_BYTES) != hipSuccess || per_cu < 1) { fprintf(stderr, "kernel_launch: occupancy query says %d blocks/CU\n", per_cu); }
        (void)hipGetLastError();
        grid = cus;
        if (grid != 256) fprintf(stderr, "kernel_launch: %d CUs: the row phases assume a 256-workgroup grid\n", grid);
    }
    if (grid < 0) return;
    (void)hipMemsetAsync((char*)d_ws + WS_CTL, 0, CTL_ZERO_BYTES, stream);
    Args a{};
    for (int i = 0; i < 18; ++i) a.in[i] = (const float*)d_in[i];
    a.out = (float*)d_out; a.ws = (unsigned char*)d_ws;
#if MK_PER_PHASE
    for (int p = 0; p < N_PHASES; ++p) { a.ph_lo = p; a.ph_hi = p + 1; hipLaunchKernelGGL(mega_fwd, dim3(grid), dim3(NTHREADS), LDS_BYTES, stream, a); }
#else
    a.ph_lo = 0; a.ph_hi = N_PHASES;
    hipLaunchKernelGGL(mega_fwd, dim3(grid), dim3(NTHREADS), LDS_BYTES, stream, a);
#endif
}
```
